# Optimizing an MI355X kernel written in HIP

```python
import math, functools
import jax, jax.numpy as jnp
from jax import lax
import numpy as np

D_MODEL = 2048
BATCH = 4
SEQ = 2048
DEPTH = 2
DEC_BATCH = 8
DEC_SEQ = 4
PAST_LEN = 16384
PAGE_SIZE = 128

D_MIX = D_MODEL
RWKV_WIDTH = D_MIX // 4
RWKV_HEAD = 64
RWKV_HEADS = RWKV_WIDTH // RWKV_HEAD
DECAY_LORA = 64
ICLR_LORA = 64
GATE_LORA = 128
RWKV_PROJ = 3 * RWKV_WIDTH + DECAY_LORA + ICLR_LORA + GATE_LORA
RWKV_SPLITS = (RWKV_WIDTH, 2 * RWKV_WIDTH, 3 * RWKV_WIDTH, 3 * RWKV_WIDTH + DECAY_LORA, 3 * RWKV_WIDTH + DECAY_LORA + ICLR_LORA)
GN_EPS = 64e-5
LRU_WIDTH = D_MIX // 4
LRU_BLOCKS = 8
LRU_BLOCK = LRU_WIDTH // LRU_BLOCKS
CONV_W = 4
RG_C = 8.0
ATTN_WIDTH = D_MIX - RWKV_WIDTH - LRU_WIDTH
ATTN_HEAD = 128
ATTN_HEADS = ATTN_WIDTH // ATTN_HEAD
DIL_PAIRS = ((128, 1), (512, 4), (2048, 16))
ATTN_WINDOW = 2048
N_BUCKETS = 32
REL_MAX_DIST = ATTN_WINDOW
N_IN = RWKV_PROJ + 2 * LRU_WIDTH + 3 * ATTN_WIDTH
IN_SPLITS = (RWKV_PROJ, RWKV_PROJ + LRU_WIDTH, RWKV_PROJ + 2 * LRU_WIDTH, RWKV_PROJ + 2 * LRU_WIDTH + ATTN_WIDTH, RWKV_PROJ + 2 * LRU_WIDTH + 2 * ATTN_WIDTH)
D_FF = 4 * D_MODEL
RMS_EPS = 1e-6
NEG = -1e30

kernel_name = 'hybrid_rwkv7_rglru_dilated_attn_step'


def rms_norm(x, g):
    xf = x.astype(jnp.float32)
    y = xf * lax.rsqrt(jnp.mean(xf * xf, axis=-1, keepdims=True) + RMS_EPS)
    return (y * g.astype(jnp.float32)).astype(x.dtype)


def t5_bucket(dist):
    exact = N_BUCKETS // 2
    d = jnp.maximum(dist, 1).astype(jnp.float32)
    large = exact + (jnp.log(d / exact) / math.log(REL_MAX_DIST / exact) * (N_BUCKETS - exact)).astype(jnp.int32)
    return jnp.where(dist < exact, dist, jnp.minimum(large, N_BUCKETS - 1))


def rwkv7_mix(p, shift_prev, s0, mu, w0, w_up, a0, a_up, g_up, k_k, k_a, r_k, lnx_g, lnx_b):
    f32 = jnp.float32
    B, T, _ = p.shape
    shifted = jnp.concatenate([shift_prev[:, None].astype(p.dtype), p[:, :-1]], axis=1)
    m = p + (shifted - p) * mu
    r, k, v, wd, ad, gd = jnp.split(m, RWKV_SPLITS, axis=-1)
    w_log = -jax.nn.softplus(-(w0 + jnp.tanh(wd) @ w_up)) - 0.5
    decay = jnp.exp(-jnp.exp(w_log.astype(f32)))
    a = jax.nn.sigmoid(a0 + ad @ a_up)
    g = jax.nn.sigmoid(gd) @ g_up

    def heads(t):
        return t.reshape(B, T, RWKV_HEADS, RWKV_HEAD).astype(f32)

    kk = heads(k * k_k)
    kk = kk / jnp.maximum(jnp.sqrt(jnp.sum(kk * kk, axis=-1, keepdims=True)), 1e-12)
    k = k * (1.0 + (a - 1.0) * k_a)
    rh, wh, kh, vh, ah = heads(r), heads(decay), heads(k), heads(v), heads(a)

    def step(S, inp):
        r_t, w_t, k_t, v_t, kk_t, a_t = inp
        sa = jnp.einsum('bhvk,bhk->bhv', S, -kk_t)
        S = S * w_t[:, :, None, :] + sa[..., None] * (kk_t * a_t)[:, :, None, :] + v_t[..., None] * k_t[:, :, None, :]
        return S, jnp.einsum('bhvk,bhk->bhv', S, r_t)

    seq = tuple(jnp.moveaxis(t, 1, 0) for t in (rh, wh, kh, vh, kk, ah))
    s_fin, y = lax.scan(step, s0.astype(f32), seq)
    y = jnp.moveaxis(y, 0, 1)
    mean = jnp.mean(y, axis=-1, keepdims=True)
    var = jnp.mean(jnp.square(y - mean), axis=-1, keepdims=True)
    y = ((y - mean) * lax.rsqrt(var + GN_EPS)).reshape(B, T, RWKV_WIDTH) * lnx_g + lnx_b
    bonus = jnp.sum(rh * kh * r_k.astype(f32), axis=-1, keepdims=True) * vh
    y = (y + bonus.reshape(B, T, RWKV_WIDTH)) * g
    return y.astype(p.dtype), p[:, -1], s_fin


def rglru_mix(xb, gb, conv_prev, h0, conv_w, conv_b, wa, ba, wx, bx, lam):
    f32 = jnp.float32
    B, T, C = xb.shape
    xp = jnp.concatenate([conv_prev.astype(xb.dtype), xb], axis=1)
    xc = conv_b + sum(xp[:, i:i + T] * conv_w[i] for i in range(CONV_W))
    xh = xc.reshape(B, T, LRU_BLOCKS, LRU_BLOCK)
    gate_r = jax.nn.sigmoid(jnp.einsum('btnc,ncd->btnd', xh, wa).reshape(B, T, C) + ba)
    gate_i = jax.nn.sigmoid(jnp.einsum('btnc,ncd->btnd', xh, wx).reshape(B, T, C) + bx)
    log_a = (-RG_C * gate_r * jax.nn.softplus(-lam)).astype(f32)
    a = jnp.exp(log_a)
    u = jnp.sqrt(-jnp.expm1(2.0 * log_a)) * (gate_i * xc).astype(f32)

    def combine(left, right):
        a_l, u_l = left
        a_r, u_r = right
        return a_l * a_r, a_r * u_l + u_r

    a_cum, u_cum = lax.associative_scan(combine, (a, u), axis=1)
    h = a_cum * h0[:, None].astype(f32) + u_cum
    y = h * jax.nn.gelu(gb.astype(f32))
    return y.astype(xb.dtype), h[:, -1], xp[:, -(CONV_W - 1):]


def _banded_dilated(q, k, v, rel_bias, win, dil):
    B, S, H, Dh = q.shape
    span = win // dil
    L = S // dil
    nblk = -(-L // span)
    Lp = nblk * span

    def to_blocks(t):
        t = t.reshape(B, L, dil, H, Dh).transpose(0, 2, 1, 3, 4)
        t = jnp.pad(t, ((0, 0), (0, 0), (0, Lp - L), (0, 0), (0, 0)))
        return t.reshape(B, dil, nblk, span, H, Dh)

    def with_prev(t):
        prev = jnp.pad(t, ((0, 0), (0, 0), (1, 0), (0, 0), (0, 0), (0, 0)))[:, :, :-1]
        return jnp.concatenate([prev, t], axis=3)

    qb = to_blocks(q)
    kb = with_prev(to_blocks(k))
    vb = with_prev(to_blocks(v))
    qi = jnp.arange(span)[:, None]
    kj = jnp.arange(2 * span)[None, :]
    delta = qi + span - kj
    key_sub = jnp.arange(nblk)[:, None, None] * span + kj[None] - span
    valid = (delta >= 0) & (delta <= span) & (key_sub >= 0)
    bias = rel_bias[t5_bucket(jnp.clip(delta, 0, span) * dil)].astype(jnp.float32)
    s = jnp.einsum('bcnqhd,bcnkhd->bcnhqk', qb, kb) * (Dh ** -0.5) + jnp.moveaxis(bias, -1, 0)
    s = jnp.where(valid[:, None], s, NEG)
    m = jnp.max(s, axis=-1, keepdims=True)
    pr = jnp.exp(s - m)
    den = jnp.sum(pr, axis=-1, keepdims=True)
    o = jnp.einsum('bcnhqk,bcnkhd->bcnqhd', pr / den, vb)
    lse = jnp.moveaxis((m + jnp.log(den))[..., 0], 3, 4)

    def from_blocks(t):
        t = t.reshape((B, dil, Lp) + t.shape[4:])[:, :, :L]
        t = jnp.swapaxes(t, 1, 2)
        return t.reshape((B, S) + t.shape[3:])

    return from_blocks(o), from_blocks(lse)


def merge_groups(outs, lses):
    wts = jax.nn.softmax(jnp.stack(lses, axis=0), axis=0)
    return jnp.einsum('gbth,gbthd->bthd', wts, jnp.stack(outs, axis=0))


def attn_prompt(q, k, v, rel_bias):
    dt = q.dtype
    q, k, v = (t.astype(jnp.float32) for t in (q, k, v))
    outs, lses = [], []
    for win, dil in DIL_PAIRS:
        o, lse = _banded_dilated(q, k, v, rel_bias, win, dil)
        outs.append(o)
        lses.append(lse)
    return merge_groups(outs, lses).astype(dt)


def attn_sample(q, k, v, k_buf, v_buf, rel_bias):
    dt = q.dtype
    q, k, v, k_buf, v_buf = (t.astype(jnp.float32) for t in (q, k, v, k_buf, v_buf))
    T, Dh = q.shape[1], q.shape[-1]
    Wb = k_buf.shape[1]
    k_all = jnp.concatenate([k_buf, k], axis=1)
    v_all = jnp.concatenate([v_buf, v], axis=1)
    outs, lses = [], []
    for win, dil in DIL_PAIRS:
        span = win // dil
        steps = jnp.arange(span + 1)
        idx = Wb + jnp.arange(T)[:, None] - dil * steps[None, :]
        valid = idx >= 0
        idx = jnp.maximum(idx, 0)
        kg = k_all[:, idx]
        vg = v_all[:, idx]
        bias = rel_bias[t5_bucket(dil * steps)].astype(jnp.float32).T
        s = jnp.einsum('bthd,btshd->bths', q, kg) * (Dh ** -0.5) + bias
        s = jnp.where(valid[:, None, :], s, NEG)
        m = jnp.max(s, axis=-1, keepdims=True)
        pr = jnp.exp(s - m)
        den = jnp.sum(pr, axis=-1, keepdims=True)
        outs.append(jnp.einsum('bths,btshd->bthd', pr / den, vg))
        lses.append((m + jnp.log(den))[..., 0])
    return merge_groups(outs, lses).astype(dt)


def decoder_layer(x, l, prm, shift_prev, wkv0, conv_prev, h0, attend):
    B, T, _ = x.shape
    h = rms_norm(x, prm['norm_mix_pre'][l])
    proj = h @ prm['w_in'][l]
    p_rwkv, lru_x, lru_g, q, k, v = jnp.split(proj, IN_SPLITS, axis=-1)
    y_a, shift_new, wkv_new = rwkv7_mix(p_rwkv, shift_prev, wkv0, prm['rwkv_mu'][l], prm['rwkv_w0'][l], prm['rwkv_w_up'][l], prm['rwkv_a0'][l], prm['rwkv_a_up'][l], prm['rwkv_g_up'][l], prm['rwkv_k_k'][l], prm['rwkv_k_a'][l], prm['rwkv_r_k'][l], prm['rwkv_lnx_g'][l], prm['rwkv_lnx_b'][l])
    y_b, h_new, conv_new = rglru_mix(lru_x, lru_g, conv_prev, h0, prm['lru_conv_w'][l], prm['lru_conv_b'][l], prm['lru_wa'][l], prm['lru_ba'][l], prm['lru_wx'][l], prm['lru_bx'][l], prm['lru_lambda'][l])
    q, k, v = (t.reshape(B, T, ATTN_HEADS, ATTN_HEAD) for t in (q, k, v))
    y_c = attend(q, k, v).reshape(B, T, ATTN_WIDTH)
    mixed = jnp.concatenate([y_a, y_b, y_c], axis=-1) @ prm['w_out'][l]
    x = x + rms_norm(mixed, prm['norm_mix_post'][l])
    hf = rms_norm(x, prm['norm_ffn_pre'][l])
    f = jnp.square(jax.nn.relu(hf @ prm['ffn_w1'][l])) @ prm['ffn_w2'][l]
    x = x + rms_norm(f, prm['norm_ffn_post'][l])
    return x, (shift_new, wkv_new, conv_new, h_new, k, v)


def setup_inputs(seed: int = 0) -> dict:
    key = jax.random.key(seed)
    ks = list(jax.random.split(key, 48))

    def nrm(shape, scale=1.0):
        return scale * jax.random.normal(ks.pop(), shape, jnp.float32)

    def unif(shape, lo, hi):
        return jax.random.uniform(ks.pop(), shape, jnp.float32, lo, hi)

    cache_win = min(ATTN_WINDOW, PAST_LEN)
    a_init = unif((DEPTH, LRU_WIDTH), 0.9, 0.999) ** (1.0 / RG_C)
    return {
        'x_prompt': nrm((BATCH, SEQ, D_MODEL)),
        'x_sample': nrm((DEC_BATCH, DEC_SEQ, D_MODEL)),
        'state_rwkv_wkv': nrm((DEPTH, DEC_BATCH, RWKV_HEADS, RWKV_HEAD, RWKV_HEAD), 0.5),
        'state_rwkv_shift': nrm((DEPTH, DEC_BATCH, RWKV_PROJ)),
        'state_lru_h': nrm((DEPTH, DEC_BATCH, LRU_WIDTH), 0.5),
        'state_lru_conv': nrm((DEPTH, DEC_BATCH, CONV_W - 1, LRU_WIDTH)),
        'cache_attn_k': nrm((DEPTH, DEC_BATCH, cache_win, ATTN_HEADS, ATTN_HEAD)),
        'cache_attn_v': nrm((DEPTH, DEC_BATCH, cache_win, ATTN_HEADS, ATTN_HEAD)),
        'rel_bias': nrm((N_BUCKETS, ATTN_HEADS), 0.5),
        'norm_mix_pre': 1.0 + nrm((DEPTH, D_MODEL), 0.05),
        'norm_mix_post': 1.0 + nrm((DEPTH, D_MODEL), 0.05),
        'norm_ffn_pre': 1.0 + nrm((DEPTH, D_MODEL), 0.05),
        'norm_ffn_post': 1.0 + nrm((DEPTH, D_MODEL), 0.05),
        'w_in': nrm((DEPTH, D_MODEL, N_IN), D_MODEL ** -0.5),
        'w_out': nrm((DEPTH, D_MIX, D_MODEL), D_MIX ** -0.5),
        'rwkv_mu': unif((DEPTH, RWKV_PROJ), 0.0, 1.0),
        'rwkv_w0': unif((DEPTH, RWKV_WIDTH), -6.0, 0.0),
        'rwkv_w_up': nrm((DEPTH, DECAY_LORA, RWKV_WIDTH), 0.1),
        'rwkv_a0': nrm((DEPTH, RWKV_WIDTH), 0.5),
        'rwkv_a_up': nrm((DEPTH, ICLR_LORA, RWKV_WIDTH), 0.1),
        'rwkv_g_up': nrm((DEPTH, GATE_LORA, RWKV_WIDTH), GATE_LORA ** -0.5),
        'rwkv_k_k': 0.85 + nrm((DEPTH, RWKV_WIDTH), 0.05),
        'rwkv_k_a': 1.0 + nrm((DEPTH, RWKV_WIDTH), 0.05),
        'rwkv_r_k': nrm((DEPTH, RWKV_HEADS, RWKV_HEAD), 0.1),
        'rwkv_lnx_g': 1.0 + nrm((DEPTH, RWKV_WIDTH), 0.05),
        'rwkv_lnx_b': nrm((DEPTH, RWKV_WIDTH), 0.02),
        'lru_conv_w': nrm((DEPTH, CONV_W, LRU_WIDTH), CONV_W ** -0.5),
        'lru_conv_b': nrm((DEPTH, LRU_WIDTH), 0.02),
        'lru_wa': nrm((DEPTH, LRU_BLOCKS, LRU_BLOCK, LRU_BLOCK), LRU_BLOCK ** -0.5),
        'lru_ba': nrm((DEPTH, LRU_WIDTH), 0.02),
        'lru_wx': nrm((DEPTH, LRU_BLOCKS, LRU_BLOCK, LRU_BLOCK), LRU_BLOCK ** -0.5),
        'lru_bx': nrm((DEPTH, LRU_WIDTH), 0.02),
        'lru_lambda': jnp.log(a_init / (1.0 - a_init)),
        'ffn_w1': nrm((DEPTH, D_MODEL, D_FF), D_MODEL ** -0.5),
        'ffn_w2': nrm((DEPTH, D_FF, D_MODEL), D_FF ** -0.5),
    }


def reference(x_prompt, x_sample, state_rwkv_wkv, state_rwkv_shift, state_lru_h, state_lru_conv, cache_attn_k, cache_attn_v, rel_bias, norm_mix_pre, norm_mix_post, norm_ffn_pre, norm_ffn_post, w_in, w_out, rwkv_mu, rwkv_w0, rwkv_w_up, rwkv_a0, rwkv_a_up, rwkv_g_up, rwkv_k_k, rwkv_k_a, rwkv_r_k, rwkv_lnx_g, rwkv_lnx_b, lru_conv_w, lru_conv_b, lru_wa, lru_ba, lru_wx, lru_bx, lru_lambda, ffn_w1, ffn_w2):
    prm = {'norm_mix_pre': norm_mix_pre, 'norm_mix_post': norm_mix_post, 'norm_ffn_pre': norm_ffn_pre, 'norm_ffn_post': norm_ffn_post, 'w_in': w_in, 'w_out': w_out, 'rwkv_mu': rwkv_mu, 'rwkv_w0': rwkv_w0, 'rwkv_w_up': rwkv_w_up, 'rwkv_a0': rwkv_a0, 'rwkv_a_up': rwkv_a_up, 'rwkv_g_up': rwkv_g_up, 'rwkv_k_k': rwkv_k_k, 'rwkv_k_a': rwkv_k_a, 'rwkv_r_k': rwkv_r_k, 'rwkv_lnx_g': rwkv_lnx_g, 'rwkv_lnx_b': rwkv_lnx_b, 'lru_conv_w': lru_conv_w, 'lru_conv_b': lru_conv_b, 'lru_wa': lru_wa, 'lru_ba': lru_ba, 'lru_wx': lru_wx, 'lru_bx': lru_bx, 'lru_lambda': lru_lambda, 'ffn_w1': ffn_w1, 'ffn_w2': ffn_w2}
    B = x_prompt.shape[0]
    keep = min(ATTN_WINDOW, x_prompt.shape[1])
    attend_prompt = functools.partial(attn_prompt, rel_bias=rel_bias)
    xp, xs = x_prompt, x_sample
    new_p, new_s = [], []
    for l in range(DEPTH):
        xp, st_p = decoder_layer(xp, l, prm, jnp.zeros((B, RWKV_PROJ), xp.dtype), jnp.zeros((B, RWKV_HEADS, RWKV_HEAD, RWKV_HEAD), jnp.float32), jnp.zeros((B, CONV_W - 1, LRU_WIDTH), xp.dtype), jnp.zeros((B, LRU_WIDTH), jnp.float32), attend_prompt)
        attend_sample = functools.partial(attn_sample, k_buf=cache_attn_k[l], v_buf=cache_attn_v[l], rel_bias=rel_bias)
        xs, st_s = decoder_layer(xs, l, prm, state_rwkv_shift[l], state_rwkv_wkv[l], state_lru_conv[l], state_lru_h[l], attend_sample)
        new_p.append(st_p)
        new_s.append(st_s)
    shift_p = jnp.stack([s[0] for s in new_p])
    shift_s = jnp.stack([s[0] for s in new_s])
    wkv_p = jnp.stack([s[1] for s in new_p])
    wkv_s = jnp.stack([s[1] for s in new_s])
    conv_p = jnp.stack([s[2] for s in new_p])
    conv_s = jnp.stack([s[2] for s in new_s])
    h_p = jnp.stack([s[3] for s in new_p])
    h_s = jnp.stack([s[3] for s in new_s])
    k_p = jnp.stack([s[4][:, -keep:] for s in new_p])
    k_s = jnp.stack([s[4] for s in new_s])
    v_p = jnp.stack([s[5][:, -keep:] for s in new_p])
    v_s = jnp.stack([s[5] for s in new_s])
    return (xp, xs, wkv_p, wkv_s, shift_p, shift_s, h_p, h_s, conv_p, conv_s, k_p, k_s, v_p, v_s)
```

```cpp
#include <hip/hip_runtime.h>
#include <cstdio>
#include <cstdint>

#ifndef MK_MULTI
#define MK_MULTI 1
#endif

constexpr int D = 2048, NB = 4, SEQ = 2048, DEPTH = 2, DB = 8, DS = 4;
constexpr int MP = NB * SEQ, MS = DB * DS, MT = MP + MS, MT_PAD = 8448;
constexpr int RWW = 512, RPROJ = 1792;
constexpr int NIN = 5888, DFF = 8192;
constexpr int C_LX = 1792, C_LG = 2304, C_Q = 2816, C_K = 3840, C_V = 4864;
constexpr int NSEQ = NB + DB;
constexpr int CACHE_W = 2048;
constexpr float RMS_EPS = 1e-6f, GN_EPS = 64e-5f;
constexpr float ATT_SCALE = 0.08838834764831845f;

constexpr size_t O_Y = 0;
constexpr size_t O_WKV_P = (size_t)MT * D;
constexpr size_t O_WKV_S = O_WKV_P + (size_t)DEPTH * NB * 8 * 64 * 64;
constexpr size_t O_SHIFT_P = O_WKV_S + (size_t)DEPTH * DB * 8 * 64 * 64;
constexpr size_t O_SHIFT_S = O_SHIFT_P + (size_t)DEPTH * NB * RPROJ;
constexpr size_t O_LRUH_P = O_SHIFT_S + (size_t)DEPTH * DB * RPROJ;
constexpr size_t O_LRUH_S = O_LRUH_P + (size_t)DEPTH * NB * 512;
constexpr size_t O_CONV_P = O_LRUH_S + (size_t)DEPTH * DB * 512;
constexpr size_t O_CONV_S = O_CONV_P + (size_t)DEPTH * NB * 3 * 512;
constexpr size_t O_K_P = O_CONV_S + (size_t)DEPTH * DB * 3 * 512;
constexpr size_t O_K_S = O_K_P + (size_t)DEPTH * MP * 1024;
constexpr size_t O_V_P = O_K_S + (size_t)DEPTH * MS * 1024;
constexpr size_t O_V_S = O_V_P + (size_t)DEPTH * MP * 1024;
constexpr size_t O_END = O_V_S + (size_t)DEPTH * MS * 1024;
static_assert(O_END == 51406848, "output size");

constexpr size_t MiB = 1u << 20;
constexpr size_t WS_CTL = 0, CTL_ZERO_BYTES = 1 * MiB;
constexpr size_t WS_H = 2 * MiB;
constexpr size_t WS_MIX = WS_H + 66 * MiB;
constexpr size_t WS_Y1 = WS_MIX + 66 * MiB;
constexpr size_t WS_PROJ = WS_Y1 + 66 * MiB;
constexpr size_t WS_RWB = WS_PROJ + 190 * MiB;
constexpr size_t WS_U = WS_PROJ;
constexpr size_t WS_END = WS_RWB + 113 * MiB;
static_assert((size_t)MT_PAD * DFF * 4 <= WS_END - WS_U, "U overlay");

constexpr int CW_BAR = 4096;

constexpr int NWAVES = 8;
constexpr int LDS_BYTES = 147456;
constexpr int MISC_OFF = 131072 + 320;

#define GAS __attribute__((address_space(1)))
#define LAS __attribute__((address_space(3)))
typedef float f32x4 __attribute__((ext_vector_type(4)));
typedef float f32x2 __attribute__((ext_vector_type(2)));
typedef GAS unsigned gu32;

#define XB_TMO      128
#define XB_XCNT(j)  (256  + 64 * (j))
#define XB_XSUB(j)  (1280 + 64 * (j))
#define XB_XGEN(j)  (2304 + 64 * (j))
#define XB_TOP      3328
#define XB_TOPGEN   3392
#define XCD_BAR_WORDS 3456
#define XB_SPIN_CAP (1u << 22)

__device__ __forceinline__ unsigned xb_ld(unsigned* p)              { return __hip_atomic_load(p, __ATOMIC_RELAXED, __HIP_MEMORY_SCOPE_AGENT); }
__device__ __forceinline__ unsigned xb_add(unsigned* p, unsigned v) { return __hip_atomic_fetch_add(p, v, __ATOMIC_RELAXED, __HIP_MEMORY_SCOPE_AGENT); }
__device__ __forceinline__ unsigned xb_xcc_id() { return (unsigned)__builtin_amdgcn_s_getreg((3 << 11) | 20) & 0xFu; }
#define XB_SPIN(cond, bar) do { unsigned _sp = 0; while (cond) { __builtin_amdgcn_s_sleep(1); \
    if ((++_sp & 255u) == 0u) { if (xb_ld(&(bar)[XB_TMO])) break; if (_sp > XB_SPIN_CAP) { atomicAdd(&(bar)[XB_TMO], 1u); break; } } } } while (0)

struct XcdBarrier { unsigned* bar; unsigned x; volatile LAS unsigned* st; };

__device__ __forceinline__ XcdBarrier xcd_barrier_post(unsigned* bar, volatile LAS unsigned* st) {
    XcdBarrier b; b.bar = bar; b.x = xb_xcc_id(); b.st = st;
    if (threadIdx.x == 0) (void)xb_add(&bar[XB_XCNT(b.x)], 1u);
    return b;
}
__device__ __forceinline__ void xcd_barrier_complete(unsigned* bar, unsigned x, unsigned& nloc, unsigned& nx) {
    const unsigned G = gridDim.x * gridDim.y * gridDim.z;
    unsigned sum, cnt, mine, sp = 0u;
    for (;;) {
        sum = 0u; cnt = 0u; mine = 0u;
#pragma unroll
        for (unsigned j = 0; j < 16; ++j) { const unsigned c = xb_ld(&bar[XB_XCNT(j)]); sum += c; cnt += (c > 0u) ? 1u : 0u; mine = (j == x) ? c : mine; }
        if (sum == G) break;
        __builtin_amdgcn_s_sleep(1);
        if ((++sp & 255u) == 0u) { if (xb_ld(&bar[XB_TMO])) break; if (sp > XB_SPIN_CAP) { atomicAdd(&bar[XB_TMO], 1u); break; } }
    }
    nloc = mine > 0u ? mine : 1u; nx = cnt > 0u ? cnt : 1u;
}
__device__ __forceinline__ void xcd_barrier(const XcdBarrier& b) {
    asm volatile("s_waitcnt vmcnt(0)" ::: "memory");
    __syncthreads();
    if (threadIdx.x == 0) {
        unsigned* bar = b.bar;
        __builtin_amdgcn_s_waitcnt(0);
        unsigned nloc = b.st[0], nx = b.st[1];
        if (nloc == 0u) { xcd_barrier_complete(bar, b.x, nloc, nx); b.st[0] = nloc; b.st[1] = nx; }
        const unsigned old = xb_add(&bar[XB_XSUB(b.x)], 1u);
        const unsigned gen = old / nloc;
        if (old + 1u == (gen + 1u) * nloc) {
            __builtin_amdgcn_fence(__ATOMIC_RELEASE, "agent");
            asm volatile("s_waitcnt vmcnt(0)" ::: "memory");
            const unsigned og = xb_add(&bar[XB_TOP], 1u);
            const unsigned tg = og / nx;
            if (og + 1u == (tg + 1u) * nx) xb_add(&bar[XB_TOPGEN], 1u);
            else XB_SPIN(xb_ld(&bar[XB_TOPGEN]) == tg, bar);
            __builtin_amdgcn_fence(__ATOMIC_ACQUIRE, "agent");
            xb_add(&bar[XB_XGEN(b.x)], 1u);
            asm volatile("s_waitcnt vmcnt(0)" ::: "memory");
        } else {
            XB_SPIN(xb_ld(&bar[XB_XGEN(b.x)]) == gen, bar);
            __builtin_amdgcn_fence(__ATOMIC_ACQUIRE, "agent");
            asm volatile("s_waitcnt vmcnt(0)" ::: "memory");
        }
    }
    __syncthreads();
}

struct Params { const float* in[35]; float* out; unsigned char* ws; int ph_lo, ph_hi; };

__device__ __forceinline__ float wave_sum(float v) {
#pragma unroll
    for (int o = 1; o < 64; o <<= 1) v += __shfl_xor(v, o);
    return v;
}
__device__ __forceinline__ float wave_max(float v) {
#pragma unroll
    for (int o = 1; o < 64; o <<= 1) v = fmaxf(v, __shfl_xor(v, o));
    return v;
}
__device__ __forceinline__ float rdl(float x, int k) { return __int_as_float(__builtin_amdgcn_readlane(__float_as_int(x), k)); }
__device__ __forceinline__ float sigmoidf_(float x) { return 1.0f / (1.0f + expf(-x)); }
__device__ __forceinline__ float softplusf_(float x) { return fmaxf(x, 0.f) + log1pf(expf(-fabsf(x))); }
__device__ __forceinline__ float gelu_tanh(float x) { return 0.5f * x * (1.0f + tanhf(0.7978845608028654f * (x + 0.044715f * x * x * x))); }
#define WAVE_LDS_SYNC() asm volatile("s_waitcnt lgkmcnt(0)" ::: "memory")

__device__ __forceinline__ void seq_of(int s, int& row0, int& T) { if (s < NB) { row0 = s * SEQ; T = SEQ; } else { row0 = MP + (s - NB) * DS; T = DS; } }
__device__ __forceinline__ void row_to_seq(int r, int& s, int& t) { if (r < MP) { s = r >> 11; t = r & (SEQ - 1); } else { s = NB + ((r - MP) >> 2); t = (r - MP) & 3; } }

__device__ __forceinline__ void ph_norm1(const Params& P, int gw, int ngw, int lane) {
    const float* g = P.in[9];
    float* H = (float*)(P.ws + WS_H);
    for (int r = gw; r < MT; r += ngw) {
        const float* x = r < MP ? P.in[0] + (size_t)r * D : P.in[1] + (size_t)(r - MP) * D;
        f32x4 v[8]; float ss = 0.f;
#pragma unroll
        for (int j = 0; j < 8; ++j) { v[j] = *(const f32x4*)(x + lane * 4 + j * 256); ss += v[j].x * v[j].x + v[j].y * v[j].y + v[j].z * v[j].z + v[j].w * v[j].w; }
        ss = wave_sum(ss);
        const float rs = rsqrtf(ss * (1.f / D) + RMS_EPS);
#pragma unroll
        for (int j = 0; j < 8; ++j) { const f32x4 gv = *(const f32x4*)(g + lane * 4 + j * 256); *(f32x4*)(H + (size_t)r * D + lane * 4 + j * 256) = v[j] * rs * gv; }
    }
}

template <int EPI>
__device__ __forceinline__ void ph_gemm_naive(const float* A, int lda, const float* W, float* C, int ldc, int M, int N, int K, int bid, int nb, int tid, LAS float* lds) {
    LAS float* As = lds;
    LAS float* Bs = lds + 16 * 132;
    const int ty = tid >> 4, tx = tid & 15;
    const int ntm = (M + 127) / 128, ntn = N / 64;
    for (int tile = bid; tile < ntm * ntn; tile += nb) {
        const int tm = tile / ntn, tn = tile % ntn, m0 = tm * 128, n0 = tn * 64;
        float acc[4][4];
#pragma unroll
        for (int i = 0; i < 4; ++i)
#pragma unroll
            for (int j = 0; j < 4; ++j) acc[i][j] = 0.f;
        const int ar = m0 + (tid >> 2), ak = (tid & 3) * 4, bk = tid >> 5, bc = (tid & 31) * 2;
        for (int k0 = 0; k0 < K; k0 += 16) {
            f32x4 av = (f32x4){0.f, 0.f, 0.f, 0.f};
            if (ar < M) av = *(const f32x4*)(A + (size_t)ar * lda + k0 + ak);
            const f32x2 bv = *(const f32x2*)(W + (size_t)(k0 + bk) * N + n0 + bc);
            __syncthreads();
            As[(ak + 0) * 132 + (tid >> 2)] = av.x; As[(ak + 1) * 132 + (tid >> 2)] = av.y; As[(ak + 2) * 132 + (tid >> 2)] = av.z; As[(ak + 3) * 132 + (tid >> 2)] = av.w;
            Bs[bk * 64 + bc] = bv.x; Bs[bk * 64 + bc + 1] = bv.y;
            __syncthreads();
#pragma unroll
            for (int k = 0; k < 16; ++k) {
                const f32x4 a = *(const LAS f32x4*)(As + k * 132 + ty * 4);
                const f32x4 b = *(const LAS f32x4*)(Bs + k * 64 + tx * 4);
#pragma unroll
                for (int i = 0; i < 4; ++i)
#pragma unroll
                    for (int j = 0; j < 4; ++j) acc[i][j] += a[i] * b[j];
            }
        }
#pragma unroll
        for (int i = 0; i < 4; ++i) {
            const int row = m0 + ty * 4 + i;
            if (row < M) {
                f32x4 o = (f32x4){acc[i][0], acc[i][1], acc[i][2], acc[i][3]};
                if (EPI == 1) { o.x = fmaxf(o.x, 0.f); o.y = fmaxf(o.y, 0.f); o.z = fmaxf(o.z, 0.f); o.w = fmaxf(o.w, 0.f); o = o * o; }
                *(f32x4*)(C + (size_t)row * ldc + n0 + tx * 4) = o;
            }
        }
    }
}

__device__ __forceinline__ void ph_post_in(const Params& P, int l, int bid, int nb, int tid, LAS float* lds) {
    const float* PROJ = (const float*)(P.ws + WS_PROJ);
    float* RWB = (float*)(P.ws + WS_RWB);
    float* out = P.out;
    const size_t gtid = (size_t)bid * 512 + tid, nthr = (size_t)nb * 512;
#pragma unroll 1
    for (size_t i = gtid; i < (size_t)MT * 512; i += nthr) {
        const int r = (int)(i >> 9), c4 = (int)(i & 511) * 4;
        const f32x4 val = *(const f32x4*)(PROJ + (size_t)r * NIN + C_K + c4);
        const int cc = c4 & 1023; const bool isv = c4 >= 1024;
        float* dst;
        if (r < MP) dst = out + (isv ? O_V_P : O_K_P) + ((size_t)l * MP + r) * 1024 + cc;
        else dst = out + (isv ? O_V_S : O_K_S) + ((size_t)l * MS + (r - MP)) * 1024 + cc;
        *(f32x4*)dst = val;
    }
#pragma unroll 1
    for (size_t i = gtid; i < (size_t)NSEQ * RPROJ; i += nthr) {
        const int s = (int)(i / RPROJ), c = (int)(i % RPROJ); int row0, T; seq_of(s, row0, T);
        const float v = PROJ[(size_t)(row0 + T - 1) * NIN + c];
        if (s < NB) out[O_SHIFT_P + ((size_t)l * NB + s) * RPROJ + c] = v; else out[O_SHIFT_S + ((size_t)l * DB + (s - NB)) * RPROJ + c] = v;
    }
#pragma unroll 1
    for (size_t i = gtid; i < (size_t)NSEQ * 3 * 512; i += nthr) {
        const int s = (int)(i / 1536), j = (int)((i % 1536) / 512), c = (int)(i % 512); int row0, T; seq_of(s, row0, T);
        const float v = PROJ[(size_t)(row0 + T - 3 + j) * NIN + C_LX + c];
        if (s < NB) out[O_CONV_P + (((size_t)l * NB + s) * 3 + j) * 512 + c] = v; else out[O_CONV_S + (((size_t)l * DB + (s - NB)) * 3 + j) * 512 + c] = v;
    }
    LAS float* mL = lds;
    LAS float* act = lds + 1792;
    const float* mu = P.in[15] + (size_t)l * RPROJ;
    const float* w0 = P.in[16] + l * 512; const float* w_up = P.in[17] + (size_t)l * 64 * 512;
    const float* a0 = P.in[18] + l * 512; const float* a_up = P.in[19] + (size_t)l * 64 * 512;
    const float* g_up = P.in[20] + (size_t)l * 128 * 512;
    const float* k_k = P.in[21] + l * 512; const float* k_a = P.in[22] + l * 512;
    for (int r = bid; r < MT; r += nb) {
        int s, t; row_to_seq(r, s, t);
        const float* prev = t > 0 ? PROJ + (size_t)(r - 1) * NIN : (s >= NB ? P.in[3] + ((size_t)l * DB + (s - NB)) * RPROJ : nullptr);
#pragma unroll 1
        for (int ch = tid; ch < RPROJ; ch += 512) {
            const float p = PROJ[(size_t)r * NIN + ch]; const float pv = prev ? prev[ch] : 0.f;
            mL[ch] = p + (pv - p) * mu[ch];
        }
        __syncthreads();
        if (tid < 64) act[tid] = tanhf(mL[1536 + tid]);
        else if (tid < 128) act[tid] = mL[1600 + tid - 64];
        else if (tid < 256) act[tid] = sigmoidf_(mL[1664 + tid - 128]);
        __syncthreads();
        const int c = tid;
        float wl = 0.f, al = 0.f, gl = 0.f;
#pragma unroll 4
        for (int j = 0; j < 64; ++j) { wl += act[j] * w_up[j * 512 + c]; al += act[64 + j] * a_up[j * 512 + c]; }
#pragma unroll 4
        for (int j = 0; j < 128; ++j) gl += act[128 + j] * g_up[j * 512 + c];
        const float z = w0[c] + wl;
        const float w_log = -softplusf_(-z) - 0.5f;
        const float decay = expf(-expf(w_log));
        const float a = sigmoidf_(a0[c] + al);
        const float k = mL[512 + c];
        const float kkv = k * k_k[c];
        const float ss = wave_sum(kkv * kkv);
        const float kkn = kkv / fmaxf(sqrtf(ss), 1e-12f);
        const float kp = k * (1.0f + (a - 1.0f) * k_a[c]);
        float* o = RWB + (size_t)r * 3584 + c;
        o[0] = mL[c]; o[512] = decay; o[1024] = kp; o[1536] = mL[1024 + c]; o[2048] = kkn; o[2560] = a; o[3072] = gl;
        __syncthreads();
    }
}

__device__ __forceinline__ float att_bias(const float* rel_bias, int dist, int h) {
    int b;
    if (dist < 16) b = dist;
    else { b = 16 + (int)(logf((float)dist / 16.0f) / 4.852030263919617f * 16.0f); b = b > 31 ? 31 : b; }
    return rel_bias[b * 8 + h];
}

__device__ __forceinline__ void ph_mix(const Params& P, int l, int bid, int nb, int wave, int lane, LAS float* lds) {
    const float* PROJ = (const float*)(P.ws + WS_PROJ);
    const float* RWB = (const float*)(P.ws + WS_RWB);
    float* MIX = (float*)(P.ws + WS_MIX);
    float* out = P.out;
    if (wave == 0) {
        for (int item = bid; item < NSEQ * 8; item += nb) {
            const int s = item >> 3, h = item & 7; int row0, T; seq_of(s, row0, T);
            float S[64];
            if (s >= NB) {
                const float* st = P.in[2] + ((((size_t)l * DB + (s - NB)) * 8 + h) * 64 + lane) * 64;
#pragma unroll
                for (int k = 0; k < 64; ++k) S[k] = st[k];
            } else {
#pragma unroll
                for (int k = 0; k < 64; ++k) S[k] = 0.f;
            }
            const int c = h * 64 + lane;
            const float lg = P.in[24][l * 512 + c], lb = P.in[25][l * 512 + c], rk = P.in[23][(l * 8 + h) * 64 + lane];
            for (int t = 0; t < T; ++t) {
                const int r = row0 + t;
                const float* base = RWB + (size_t)r * 3584 + c;
                const float rl = base[0], wl = base[512], kl = base[1024], vl = base[1536], kkl = base[2048], al = base[2560], gl = base[3072];
                const float bl = kkl * al;
                float sa = 0.f;
#pragma unroll
                for (int k0 = 0; k0 < 64; k0 += 8) {
#pragma unroll
                    for (int k = k0; k < k0 + 8; ++k) sa -= S[k] * rdl(kkl, k);
                    __builtin_amdgcn_sched_barrier(0);
                }
                float y = 0.f;
#pragma unroll
                for (int k0 = 0; k0 < 64; k0 += 4) {
#pragma unroll
                    for (int k = k0; k < k0 + 4; ++k) { S[k] = S[k] * rdl(wl, k) + sa * rdl(bl, k) + vl * rdl(kl, k); y += S[k] * rdl(rl, k); }
                    __builtin_amdgcn_sched_barrier(0);
                }
                const float mean = wave_sum(y) * (1.f / 64.f);
                const float d = y - mean;
                const float var = wave_sum(d * d) * (1.f / 64.f);
                float yn = d * rsqrtf(var + GN_EPS) * lg + lb;
                const float bonus = wave_sum(rl * kl * rk) * vl;
                MIX[(size_t)r * D + c] = (yn + bonus) * gl;
            }
            float* so = (s < NB) ? out + O_WKV_P + ((((size_t)l * NB + s) * 8 + h) * 64 + lane) * 64
                                 : out + O_WKV_S + ((((size_t)l * DB + (s - NB)) * 8 + h) * 64 + lane) * 64;
#pragma unroll
            for (int k = 0; k < 64; ++k) so[k] = S[k];
        }
    } else if (wave == 1) {
        for (int item = bid; item < NSEQ * 8; item += nb) {
            const int s = item >> 3, n = item & 7; int row0, T; seq_of(s, row0, T);
            const int c = n * 64 + lane;
            LAS float* wa = lds + 8192; LAS float* wx = lds + 8192 + 4096;
#pragma unroll 4
            for (int j = 0; j < 64; ++j) { wa[j * 64 + lane] = P.in[28][(((size_t)l * 8 + n) * 64 + j) * 64 + lane]; wx[j * 64 + lane] = P.in[30][(((size_t)l * 8 + n) * 64 + j) * 64 + lane]; }
            WAVE_LDS_SYNC();
            float x1 = 0.f, x2 = 0.f, x3 = 0.f, h = 0.f;
            if (s >= NB) {
                const float* cs = P.in[5] + (((size_t)l * DB + (s - NB)) * 3) * 512 + c;
                x1 = cs[0]; x2 = cs[512]; x3 = cs[1024];
                h = P.in[4][((size_t)l * DB + (s - NB)) * 512 + c];
            }
            const float cw0 = P.in[26][(l * 4 + 0) * 512 + c], cw1 = P.in[26][(l * 4 + 1) * 512 + c], cw2 = P.in[26][(l * 4 + 2) * 512 + c], cw3 = P.in[26][(l * 4 + 3) * 512 + c];
            const float cb = P.in[27][l * 512 + c], ba = P.in[29][l * 512 + c], bx = P.in[31][l * 512 + c];
            const float sp = softplusf_(-P.in[32][l * 512 + c]);
            for (int t = 0; t < T; ++t) {
                const int r = row0 + t;
                const float xb = PROJ[(size_t)r * NIN + C_LX + c], gb = PROJ[(size_t)r * NIN + C_LG + c];
                const float xc = cb + cw0 * x1 + cw1 * x2 + cw2 * x3 + cw3 * xb;
                float gr = 0.f, gi = 0.f;
#pragma unroll
                for (int j0 = 0; j0 < 64; j0 += 8) {
#pragma unroll
                    for (int j = j0; j < j0 + 8; ++j) { const float xj = rdl(xc, j); gr += xj * wa[j * 64 + lane]; gi += xj * wx[j * 64 + lane]; }
                    __builtin_amdgcn_sched_barrier(0);
                }
                gr = sigmoidf_(gr + ba); gi = sigmoidf_(gi + bx);
                const float log_a = -8.0f * gr * sp;
                const float a = expf(log_a);
                const float u = sqrtf(-expm1f(2.0f * log_a)) * (gi * xc);
                h = a * h + u;
                MIX[(size_t)r * D + 512 + c] = h * gelu_tanh(gb);
                x1 = x2; x2 = x3; x3 = xb;
            }
            if (s < NB) out[O_LRUH_P + ((size_t)l * NB + s) * 512 + c] = h; else out[O_LRUH_S + ((size_t)l * DB + (s - NB)) * 512 + c] = h;
        }
    }
    LAS float* qs = lds + wave * 1024;
    LAS float* ps = qs + 128;
    const float* rel_bias = P.in[8];
    const int gw = bid * NWAVES + wave, ngw = nb * NWAVES;
    for (int item = gw; item < MT * 8; item += ngw) {
        const int r = item >> 3, h = item & 7; int s, t; row_to_seq(r, s, t); int row0, T; seq_of(s, row0, T);
        const bool prompt = s < NB; const int b = s - NB;
        const float* qrow = PROJ + (size_t)r * NIN + C_Q + h * 128;
        qs[lane] = qrow[lane]; qs[64 + lane] = qrow[64 + lane];
        WAVE_LDS_SYNC();
        float sc[9]; float mx = -INFINITY;
#pragma unroll
        for (int g = 0; g < 3; ++g) {
            const int dil = g == 0 ? 1 : (g == 1 ? 4 : 16);
#pragma unroll
            for (int jj = 0; jj < 3; ++jj) {
                const int j = jj * 64 + lane;
                const float* krow = nullptr;
                if (j <= 128) {
                    if (prompt) { const int pos = t - dil * j; if (pos >= 0) krow = PROJ + (size_t)(row0 + pos) * NIN + C_K + h * 128; }
                    else { const int idx = CACHE_W + t - dil * j;
                        if (idx < CACHE_W) krow = P.in[6] + ((((size_t)l * DB + b) * CACHE_W + idx) * 8 + h) * 128;
                        else krow = PROJ + (size_t)(row0 + idx - CACHE_W) * NIN + C_K + h * 128; }
                }
                float sv = -INFINITY;
                if (krow) {
                    float acc = 0.f;
#pragma unroll 4
                    for (int i = 0; i < 32; ++i) { const f32x4 kq = *(const f32x4*)(krow + 4 * i); const f32x4 qq = *(const LAS f32x4*)(qs + 4 * i);
                        acc += kq.x * qq.x + kq.y * qq.y + kq.z * qq.z + kq.w * qq.w; }
                    sv = acc * ATT_SCALE + att_bias(rel_bias, j * dil, h);
                }
                sc[g * 3 + jj] = sv; mx = fmaxf(mx, sv);
            }
        }
        mx = wave_max(mx);
        float sum = 0.f;
#pragma unroll
        for (int g = 0; g < 3; ++g)
#pragma unroll
            for (int jj = 0; jj < 3; ++jj) {
                const int j = jj * 64 + lane; const float sv = sc[g * 3 + jj];
                const float p = (sv == -INFINITY) ? 0.f : expf(sv - mx);
                sum += p;
                if (j <= 128) ps[g * 129 + j] = p;
            }
        sum = wave_sum(sum);
        const float inv = 1.0f / sum;
        WAVE_LDS_SYNC();
        float o0 = 0.f, o1 = 0.f;
        for (int g = 0; g < 3; ++g) {
            const int dil = g == 0 ? 1 : (g == 1 ? 4 : 16);
            for (int j = 0; j <= 128; ++j) {
                const float p = ps[g * 129 + j];
                if (p != 0.f) {
                    const float* vrow;
                    if (prompt) vrow = PROJ + (size_t)(row0 + t - dil * j) * NIN + C_V + h * 128;
                    else { const int idx = CACHE_W + t - dil * j;
                        if (idx < CACHE_W) vrow = P.in[7] + ((((size_t)l * DB + b) * CACHE_W + idx) * 8 + h) * 128;
                        else vrow = PROJ + (size_t)(row0 + idx - CACHE_W) * NIN + C_V + h * 128; }
                    const f32x2 vv = *(const f32x2*)(vrow + 2 * lane);
                    o0 += p * vv.x; o1 += p * vv.y;
                }
            }
        }
        *(f32x2*)(MIX + (size_t)r * D + 1024 + h * 128 + 2 * lane) = (f32x2){o0 * inv, o1 * inv};
        WAVE_LDS_SYNC();
    }
}

__device__ __forceinline__ void ph_norm2(const Params& P, int l, int gw, int ngw, int lane) {
    const float* gp = P.in[10] + (size_t)l * D; const float* gf = P.in[11] + (size_t)l * D;
    const float* Y1 = (const float*)(P.ws + WS_Y1);
    float* H = (float*)(P.ws + WS_H);
    float* X = P.out;
    for (int r = gw; r < MT; r += ngw) {
        const float* xin = (l == 0) ? (r < MP ? P.in[0] + (size_t)r * D : P.in[1] + (size_t)(r - MP) * D) : X + (size_t)r * D;
        f32x4 y[8], x[8]; float ss = 0.f;
#pragma unroll
        for (int j = 0; j < 8; ++j) { y[j] = *(const f32x4*)(Y1 + (size_t)r * D + lane * 4 + j * 256); x[j] = *(const f32x4*)(xin + lane * 4 + j * 256);
            ss += y[j].x * y[j].x + y[j].y * y[j].y + y[j].z * y[j].z + y[j].w * y[j].w; }
        ss = wave_sum(ss);
        const float rs = rsqrtf(ss * (1.f / D) + RMS_EPS);
        float s2 = 0.f;
#pragma unroll
        for (int j = 0; j < 8; ++j) { const f32x4 g = *(const f32x4*)(gp + lane * 4 + j * 256); x[j] = x[j] + y[j] * rs * g;
            s2 += x[j].x * x[j].x + x[j].y * x[j].y + x[j].z * x[j].z + x[j].w * x[j].w;
            *(f32x4*)(X + (size_t)r * D + lane * 4 + j * 256) = x[j]; }
        s2 = wave_sum(s2);
        const float rs2 = rsqrtf(s2 * (1.f / D) + RMS_EPS);
#pragma unroll
        for (int j = 0; j < 8; ++j) { const f32x4 g = *(const f32x4*)(gf + lane * 4 + j * 256); *(f32x4*)(H + (size_t)r * D + lane * 4 + j * 256) = x[j] * rs2 * g; }
    }
}
__device__ __forceinline__ void ph_norm3(const Params& P, int l, int gw, int ngw, int lane) {
    const float* gp = P.in[12] + (size_t)l * D;
    const float* Y1 = (const float*)(P.ws + WS_Y1);
    float* H = (float*)(P.ws + WS_H);
    float* X = P.out;
    for (int r = gw; r < MT; r += ngw) {
        f32x4 y[8], x[8]; float ss = 0.f;
#pragma unroll
        for (int j = 0; j < 8; ++j) { y[j] = *(const f32x4*)(Y1 + (size_t)r * D + lane * 4 + j * 256); x[j] = *(const f32x4*)(X + (size_t)r * D + lane * 4 + j * 256);
            ss += y[j].x * y[j].x + y[j].y * y[j].y + y[j].z * y[j].z + y[j].w * y[j].w; }
        ss = wave_sum(ss);
        const float rs = rsqrtf(ss * (1.f / D) + RMS_EPS);
        float s2 = 0.f;
#pragma unroll
        for (int j = 0; j < 8; ++j) { const f32x4 g = *(const f32x4*)(gp + lane * 4 + j * 256); x[j] = x[j] + y[j] * rs * g;
            s2 += x[j].x * x[j].x + x[j].y * x[j].y + x[j].z * x[j].z + x[j].w * x[j].w;
            *(f32x4*)(X + (size_t)r * D + lane * 4 + j * 256) = x[j]; }
        if (l + 1 < DEPTH) {
            s2 = wave_sum(s2);
            const float rs2 = rsqrtf(s2 * (1.f / D) + RMS_EPS);
            const float* gn = P.in[9] + (size_t)(l + 1) * D;
#pragma unroll
            for (int j = 0; j < 8; ++j) { const f32x4 g = *(const f32x4*)(gn + lane * 4 + j * 256); *(f32x4*)(H + (size_t)r * D + lane * 4 + j * 256) = x[j] * rs2 * g; }
        }
    }
}

constexpr int NPHASE = 1 + 8 * DEPTH;
__global__ void __launch_bounds__(NWAVES * 64, 2) mega_fwd(Params P) {
    extern __shared__ __attribute__((aligned(16))) unsigned char lds_raw[];
    LAS unsigned char* lds = (LAS unsigned char*)lds_raw;
    LAS float* ldsf = (LAS float*)lds;
    volatile LAS unsigned* MISC = (volatile LAS unsigned*)(lds + MISC_OFF);
    const int tid = threadIdx.x, lane = tid & 63, wave = __builtin_amdgcn_readfirstlane(tid >> 6);
    const int bid = blockIdx.x, nb = gridDim.x;
    const int gw = bid * NWAVES + wave, ngw = nb * NWAVES;
    for (int u = tid; u < 64; u += NWAVES * 64) ((LAS unsigned*)(lds + MISC_OFF))[u] = 0u;
    __syncthreads();
    XcdBarrier bar; bar.bar = (unsigned*)(P.ws + WS_CTL) + CW_BAR; bar.x = 0; bar.st = nullptr;
    const bool multi = (P.ph_hi - P.ph_lo) > 1;
    if (multi) bar = xcd_barrier_post((unsigned*)(P.ws + WS_CTL) + CW_BAR, MISC + 8);
    float* H = (float*)(P.ws + WS_H); float* MIXb = (float*)(P.ws + WS_MIX); float* Y1 = (float*)(P.ws + WS_Y1);
    float* PROJ = (float*)(P.ws + WS_PROJ); float* U = (float*)(P.ws + WS_U);
    for (int ph = P.ph_lo; ph < P.ph_hi; ++ph) {
        int lane_v = lane, tid_v = tid;
        asm volatile("" : "+v"(lane_v), "+v"(tid_v));
        if (ph == 0) ph_norm1(P, gw, ngw, lane_v);
        else {
            const int l = (ph - 1) / 8, sub = (ph - 1) % 8;
            switch (sub) {
                case 0: ph_gemm_naive<0>(H, D, P.in[13] + (size_t)l * D * NIN, PROJ, NIN, MT, NIN, D, bid, nb, tid_v, ldsf); break;
                case 1: ph_post_in(P, l, bid, nb, tid_v, ldsf); break;
                case 2: ph_mix(P, l, bid, nb, wave, lane_v, ldsf); break;
                case 3: ph_gemm_naive<0>(MIXb, D, P.in[14] + (size_t)l * D * D, Y1, D, MT, D, D, bid, nb, tid_v, ldsf); break;
                case 4: ph_norm2(P, l, gw, ngw, lane_v); break;
                case 5: ph_gemm_naive<1>(H, D, P.in[33] + (size_t)l * D * DFF, U, DFF, MT, DFF, D, bid, nb, tid_v, ldsf); break;
                case 6: ph_gemm_naive<0>(U, DFF, P.in[34] + (size_t)l * DFF * D, Y1, D, MT, D, DFF, bid, nb, tid_v, ldsf); break;
                case 7: ph_norm3(P, l, gw, ngw, lane_v); break;
            }
        }
        if (ph + 1 < P.ph_hi) xcd_barrier(bar);
    }
}

extern "C" void kernel_launch(void* const* d_in, const int* in_sizes, int n_in, void* d_out, int out_size, void* d_ws, size_t ws_size, hipStream_t stream) {
    static int grid = 0;
    if (grid == 0) {
        if (n_in != 35 || (size_t)out_size != O_END || ws_size < WS_END) {
            fprintf(stderr, "kernel_launch: unexpected shapes: n_in %d out %d ws %zu (need %zu)\n", n_in, out_size, ws_size, (size_t)WS_END); grid = -1; return; }
        int dev = 0, cus = 0, per_cu = 0;
        if (hipGetDevice(&dev) != hipSuccess || hipDeviceGetAttribute(&cus, hipDeviceAttributeMultiprocessorCount, dev) != hipSuccess) { grid = -1; return; }
        if (hipFuncSetAttribute((const void*)mega_fwd, hipFuncAttributeMaxDynamicSharedMemorySize, LDS_BYTES) != hipSuccess) { fprintf(stderr, "kernel_launch: hipFuncSetAttribute failed\n"); grid = -1; return; }
        if (hipOccupancyMaxActiveBlocksPerMultiprocessor(&per_cu, (const void*)mega_fwd, NWAVES * 64, LDS_BYTES) != hipSuccess || per_cu < 1) { fprintf(stderr, "kernel_launch: occupancy query says %d\n", per_cu); per_cu = 1; }
        (void)hipGetLastError();
        grid = cus;
    }
    if (grid < 0) return;
    (void)hipMemsetAsync((char*)d_ws + WS_CTL, 0, CTL_ZERO_BYTES, stream);
    Params p{};
    for (int i = 0; i < 35; ++i) p.in[i] = (const float*)d_in[i];
    p.out = (float*)d_out; p.ws = (unsigned char*)d_ws;
#if MK_MULTI
    for (int ph = 0; ph < NPHASE; ++ph) { p.ph_lo = ph; p.ph_hi = ph + 1; hipLaunchKernelGGL(mega_fwd, dim3(grid), dim3(NWAVES * 64), LDS_BYTES, stream, p); }
#else
    p.ph_lo = 0; p.ph_hi = NPHASE;
    hipLaunchKernelGGL(mega_fwd, dim3(grid), dim3(NWAVES * 64), LDS_BYTES, stream, p);
#endif
}
```

```cpp
#include <hip/hip_runtime.h>
#include <cstdio>
#include <cstdint>

#ifndef MK_MULTI
#define MK_MULTI 0
#endif

constexpr int D = 2048, NB = 4, SEQ = 2048, DEPTH = 2, DB = 8, DS = 4;
constexpr int MP = NB * SEQ, MS = DB * DS, MT = MP + MS, MT_PAD = 8448;
constexpr int RWW = 512, RPROJ = 1792;
constexpr int NIN = 5888, DFF = 8192;
constexpr int C_LX = 1792, C_LG = 2304, C_Q = 2816, C_K = 3840, C_V = 4864;
constexpr int NSEQ = NB + DB;
constexpr int CACHE_W = 2048;
constexpr float RMS_EPS = 1e-6f, GN_EPS = 64e-5f;
constexpr float ATT_SCALE = 0.08838834764831845f;

constexpr size_t O_Y = 0;
constexpr size_t O_WKV_P = (size_t)MT * D;
constexpr size_t O_WKV_S = O_WKV_P + (size_t)DEPTH * NB * 8 * 64 * 64;
constexpr size_t O_SHIFT_P = O_WKV_S + (size_t)DEPTH * DB * 8 * 64 * 64;
constexpr size_t O_SHIFT_S = O_SHIFT_P + (size_t)DEPTH * NB * RPROJ;
constexpr size_t O_LRUH_P = O_SHIFT_S + (size_t)DEPTH * DB * RPROJ;
constexpr size_t O_LRUH_S = O_LRUH_P + (size_t)DEPTH * NB * 512;
constexpr size_t O_CONV_P = O_LRUH_S + (size_t)DEPTH * DB * 512;
constexpr size_t O_CONV_S = O_CONV_P + (size_t)DEPTH * NB * 3 * 512;
constexpr size_t O_K_P = O_CONV_S + (size_t)DEPTH * DB * 3 * 512;
constexpr size_t O_K_S = O_K_P + (size_t)DEPTH * MP * 1024;
constexpr size_t O_V_P = O_K_S + (size_t)DEPTH * MS * 1024;
constexpr size_t O_V_S = O_V_P + (size_t)DEPTH * MP * 1024;
constexpr size_t O_END = O_V_S + (size_t)DEPTH * MS * 1024;
static_assert(O_END == 51406848, "output size");

constexpr size_t MiB = 1u << 20;
constexpr size_t WS_CTL = 0, CTL_ZERO_BYTES = 1 * MiB;
constexpr size_t WS_WIN = 2 * MiB;
constexpr size_t WS_WOUT = 48 * MiB;
constexpr size_t WS_W1 = 64 * MiB;
constexpr size_t WS_W2 = 128 * MiB;
constexpr size_t WS_HB = 192 * MiB;
constexpr size_t WS_MIXB = 225 * MiB;
constexpr size_t WS_Y1 = 258 * MiB;
constexpr int PW = 2816;
constexpr size_t WS_QKVB = WS_Y1;
constexpr size_t WS_LSE = WS_Y1 + 51 * MiB;
constexpr size_t WS_SUMM = WS_Y1 + 53 * MiB;
constexpr size_t WS_PROJ = 324 * MiB;
constexpr size_t WS_OPART = 415 * MiB;
constexpr size_t WS_UB = WS_PROJ;
constexpr size_t WS_RWB = 464 * MiB;
constexpr size_t WS_YRAW = 577 * MiB;
constexpr size_t WS_HLOC = 594 * MiB;
constexpr size_t WS_CUMA = 611 * MiB;
constexpr size_t WS_CHKA = WS_HB;
constexpr size_t WS_CHKB = 628 * MiB;
constexpr size_t WS_XH = 678 * MiB;
constexpr size_t WS_END = 712 * MiB;
static_assert((size_t)NB * 128 * 8 * 2048 * 4 <= (size_t)MP * D * 2 && (size_t)NB * 128 * 8 * 3136 * 4 <= WS_END - WS_CHKB, "chunk matrices");
static_assert((size_t)MT_PAD * DFF * 2 <= WS_RWB - WS_UB, "U overlay");
static_assert((size_t)DEPTH * NIN * D * 2 <= WS_WOUT - WS_WIN && (size_t)MT_PAD * D * 2 <= WS_MIXB - WS_HB && (size_t)MT_PAD * PW * 4 <= WS_OPART - WS_PROJ && (size_t)3 * MP * 1024 * 2 <= WS_RWB - WS_OPART &&
              (size_t)MT * 3584 * 4 <= WS_YRAW - WS_RWB && (size_t)MT * 512 * 4 <= WS_HLOC - WS_YRAW && (size_t)MT_PAD * 3072 * 2 <= 51 * MiB && WS_SUMM + 1088 * 512 <= WS_PROJ, "ws map");

constexpr int CW_BAR = 4096;

constexpr int NWAVES = 8;
constexpr int LDS_BYTES = 147456;
constexpr int MISC_OFF = 147456 - 512;

#define GAS __attribute__((address_space(1)))
#define LAS __attribute__((address_space(3)))
typedef float f32x4 __attribute__((ext_vector_type(4)));
typedef float f32x2 __attribute__((ext_vector_type(2)));
typedef GAS unsigned gu32;

#define XB_TMO      128
#define XB_XCNT(j)  (256  + 64 * (j))
#define XB_XSUB(j)  (1280 + 64 * (j))
#define XB_XGEN(j)  (2304 + 64 * (j))
#define XB_TOP      3328
#define XB_TOPGEN   3392
#define XCD_BAR_WORDS 3456
#define XB_SPIN_CAP (1u << 22)

__device__ __forceinline__ unsigned xb_ld(unsigned* p)              { return __hip_atomic_load(p, __ATOMIC_RELAXED, __HIP_MEMORY_SCOPE_AGENT); }
__device__ __forceinline__ unsigned xb_add(unsigned* p, unsigned v) { return __hip_atomic_fetch_add(p, v, __ATOMIC_RELAXED, __HIP_MEMORY_SCOPE_AGENT); }
__device__ __forceinline__ unsigned xb_xcc_id() { return (unsigned)__builtin_amdgcn_s_getreg((3 << 11) | 20) & 0xFu; }
#define XB_SPIN(cond, bar) do { unsigned _sp = 0; while (cond) { __builtin_amdgcn_s_sleep(1); \
    if ((++_sp & 255u) == 0u) { if (xb_ld(&(bar)[XB_TMO])) break; if (_sp > XB_SPIN_CAP) { atomicAdd(&(bar)[XB_TMO], 1u); break; } } } } while (0)

struct XcdBarrier { unsigned* bar; unsigned x; volatile LAS unsigned* st; };

__device__ __forceinline__ XcdBarrier xcd_barrier_post(unsigned* bar, volatile LAS unsigned* st) {
    XcdBarrier b; b.bar = bar; b.x = xb_xcc_id(); b.st = st;
    if (threadIdx.x == 0) (void)xb_add(&bar[XB_XCNT(b.x)], 1u);
    return b;
}
__device__ __forceinline__ void xcd_barrier_complete(unsigned* bar, unsigned x, unsigned& nloc, unsigned& nx) {
    const unsigned G = gridDim.x * gridDim.y * gridDim.z;
    unsigned sum, cnt, mine, sp = 0u;
    for (;;) {
        sum = 0u; cnt = 0u; mine = 0u;
#pragma unroll
        for (unsigned j = 0; j < 16; ++j) { const unsigned c = xb_ld(&bar[XB_XCNT(j)]); sum += c; cnt += (c > 0u) ? 1u : 0u; mine = (j == x) ? c : mine; }
        if (sum == G) break;
        __builtin_amdgcn_s_sleep(1);
        if ((++sp & 255u) == 0u) { if (xb_ld(&bar[XB_TMO])) break; if (sp > XB_SPIN_CAP) { atomicAdd(&bar[XB_TMO], 1u); break; } }
    }
    nloc = mine > 0u ? mine : 1u; nx = cnt > 0u ? cnt : 1u;
}
__device__ __forceinline__ void xcd_barrier(const XcdBarrier& b) {
    asm volatile("s_waitcnt vmcnt(0)" ::: "memory");
    __syncthreads();
    if (threadIdx.x == 0) {
        unsigned* bar = b.bar;
        __builtin_amdgcn_s_waitcnt(0);
        unsigned nloc = b.st[0], nx = b.st[1];
        if (nloc == 0u) { xcd_barrier_complete(bar, b.x, nloc, nx); b.st[0] = nloc; b.st[1] = nx; }
        const unsigned old = xb_add(&bar[XB_XSUB(b.x)], 1u);
        const unsigned gen = old / nloc;
        if (old + 1u == (gen + 1u) * nloc) {
            __builtin_amdgcn_fence(__ATOMIC_RELEASE, "agent");
            asm volatile("s_waitcnt vmcnt(0)" ::: "memory");
            const unsigned og = xb_add(&bar[XB_TOP], 1u);
            const unsigned tg = og / nx;
            if (og + 1u == (tg + 1u) * nx) xb_add(&bar[XB_TOPGEN], 1u);
            else XB_SPIN(xb_ld(&bar[XB_TOPGEN]) == tg, bar);
            __builtin_amdgcn_fence(__ATOMIC_ACQUIRE, "agent");
            xb_add(&bar[XB_XGEN(b.x)], 1u);
            asm volatile("s_waitcnt vmcnt(0)" ::: "memory");
        } else {
            XB_SPIN(xb_ld(&bar[XB_XGEN(b.x)]) == gen, bar);
            __builtin_amdgcn_fence(__ATOMIC_ACQUIRE, "agent");
            asm volatile("s_waitcnt vmcnt(0)" ::: "memory");
        }
    }
    __syncthreads();
}

struct Params { const float* in[35]; float* out; unsigned char* ws; int ph_lo, ph_hi; };

__device__ __forceinline__ float wave_sum(float v) {
#pragma unroll
    for (int o = 1; o < 64; o <<= 1) v += __shfl_xor(v, o);
    return v;
}
__device__ __forceinline__ float wave_max(float v) {
#pragma unroll
    for (int o = 1; o < 64; o <<= 1) v = fmaxf(v, __shfl_xor(v, o));
    return v;
}
__device__ __forceinline__ float rdl(float x, int k) { return __int_as_float(__builtin_amdgcn_readlane(__float_as_int(x), k)); }
__device__ __forceinline__ float sigmoidf_(float x) { return 1.0f / (1.0f + expf(-x)); }
__device__ __forceinline__ float softplusf_(float x) { return fmaxf(x, 0.f) + log1pf(expf(-fabsf(x))); }
__device__ __forceinline__ float fexp_(float x) { return __builtin_amdgcn_exp2f(x * 1.4426950408889634f); }
__device__ __forceinline__ float fsigmoid_(float x) { return __builtin_amdgcn_rcpf(1.0f + fexp_(-x)); }
__device__ __forceinline__ float ftanh_(float x) { return 1.0f - 2.0f * __builtin_amdgcn_rcpf(1.0f + fexp_(2.0f * x)); }
__device__ __forceinline__ float fsoftplus_(float x) { return fmaxf(x, 0.f) + __builtin_amdgcn_logf(1.0f + fexp_(-fabsf(x))) * 0.6931471805599453f; }
__device__ __forceinline__ float gelu_tanh(float x) { return 0.5f * x * (1.0f + ftanh_(0.7978845608028654f * (x + 0.044715f * x * x * x))); }
#define WAVE_LDS_SYNC() asm volatile("s_waitcnt lgkmcnt(0)" ::: "memory")

__device__ __forceinline__ void seq_of(int s, int& row0, int& T) { if (s < NB) { row0 = s * SEQ; T = SEQ; } else { row0 = MP + (s - NB) * DS; T = DS; } }
__device__ __forceinline__ void row_to_seq(int r, int& s, int& t) { if (r < MP) { s = r >> 11; t = r & (SEQ - 1); } else { s = NB + ((r - MP) >> 2); t = (r - MP) & 3; } }

namespace pg8 {
#define PG8_LAS __attribute__((address_space(3)))
typedef unsigned short bf16_t;
typedef short bf16x8 __attribute__((ext_vector_type(8)));
typedef float f32x4 __attribute__((ext_vector_type(4)));
typedef unsigned u32x4 __attribute__((ext_vector_type(4)));
constexpr int BM = 256, BK = 64, HALF = 128, HTB = HALF * BK * 2  , STAGE_BYTES = 8 * HTB, NXCD = 8, WGM = 8;

__host__ __device__ __forceinline__ int lds_byte(int r, int c) { const int st = (r >> 4) * 2 + (c >> 5), rr = r & 15, cc = c & 31, ob = rr * 64 + cc * 2; return st * 1024 + (ob ^ (((ob >> 9) & 1) << 5)); }
__host__ __device__ __forceinline__ void stage_rc(int b, int& R, int& C) { const int st = b / 1024, sb = b % 1024, swz = sb ^ (((sb >> 9) & 1) << 5); R = (st >> 1) * 16 + swz / 64; C = (st & 1) * 32 + (swz % 64) / 2; }
__host__ __device__ __forceinline__ int perm32(int rho) { const int n = rho >> 4, i = rho & 15; return 8 * (i >> 2) + 4 * n + (i & 3); }

struct Unit { int pm, pn; };
struct Gemm { const bf16_t* A; const bf16_t* Bt; int M, N, K; };

struct StaticOrder {
    int nM, nN, nwg, G, c;
    __host__ __device__ void init(int M, int N, int G_, int c_) { nM = M / BM; nN = N / BM; nwg = nM * nN; G = G_; c = c_; }
    __host__ __device__ bool next(int i, Unit& u) const {
        const long L = (long)i * G + c; if (L >= nwg) return false;
        int wgid = (int)L; { const int q = nwg / NXCD, r = nwg % NXCD, xcd = wgid % NXCD, off = wgid / NXCD; wgid = (xcd < r ? xcd * (q + 1) : r * (q + 1) + (xcd - r) * q) + off; }
        const int nig = WGM * nN, gid = wgid / nig, fm = gid * WGM, gsz = (nM - fm) < WGM ? (nM - fm) : WGM;
        u.pm = fm + ((wgid % nig) % gsz); u.pn = (wgid % nig) / gsz; return true;
    }
    __device__ __forceinline__ void a_ready(const Unit&) const {}
    __device__ __forceinline__ void done(const Unit&) const {}
};
__device__ __forceinline__ unsigned cvt_pk_bf16(float lo, float hi) { unsigned r; asm volatile("v_cvt_pk_bf16_f32 %0, %1, %2" : "=v"(r) : "v"(lo), "v"(hi)); return r; }
typedef float f32x2 __attribute__((ext_vector_type(2)));

struct EpiF32 {
    static constexpr bool PERM = false, AFTER_DRAIN = false;
    float* C; int ldc;
    __device__ __forceinline__ void operator()(const f32x4 (&acc)[2][2][4][2], const Unit& u, int wr, int wc, int fr, int fq) const {
        const int row0 = u.pm * BM + wr * 64 + fr, col0 = u.pn * BM + wc * 32 + 4 * fq;
#pragma unroll
        for (int ai = 0; ai < 2; ++ai)
#pragma unroll
            for (int m = 0; m < 4; ++m) { float* rowp = C + (size_t)(row0 + ai * HALF + m * 16) * ldc + col0;
#pragma unroll
                for (int bj = 0; bj < 2; ++bj)
#pragma unroll
                    for (int n = 0; n < 2; ++n) *(f32x4*)(rowp + bj * HALF + n * 16) = acc[ai][bj][m][n]; }
    }
};
struct EpiF32P {
    static constexpr bool PERM = true, AFTER_DRAIN = false;
    float* C; int ldc;
    __device__ __forceinline__ void operator()(const f32x4 (&acc)[2][2][4][2], const Unit& u, int wr, int wc, int fr, int fq) const {
        const int row0 = u.pm * BM + wr * 64 + fr, col0 = u.pn * BM + wc * 32 + 8 * fq;
#pragma unroll
        for (int ai = 0; ai < 2; ++ai)
#pragma unroll
            for (int m = 0; m < 4; ++m) { float* rowp = C + (size_t)(row0 + ai * HALF + m * 16) * ldc + col0;
#pragma unroll
                for (int bj = 0; bj < 2; ++bj)
#pragma unroll
                    for (int n = 0; n < 2; ++n) *(f32x4*)(rowp + bj * HALF + n * 4) = acc[ai][bj][m][n]; }
    }
};
struct EpiIn {
    static constexpr bool PERM = true, AFTER_DRAIN = false;
    float* C; bf16_t* QKV; float* kp; float* ks; float* vp; float* vs; int mp, mt;
    __device__ __forceinline__ void operator()(const f32x4 (&acc)[2][2][4][2], const Unit& u, int wr, int wc, int fr, int fq) const {
        const int row0 = u.pm * BM + wr * 64 + fr;
        if (u.pn < 11) {
            const int col0 = u.pn * BM + wc * 32 + 8 * fq;
#pragma unroll
            for (int ai = 0; ai < 2; ++ai)
#pragma unroll
                for (int m = 0; m < 4; ++m) { float* rowp = C + (size_t)(row0 + ai * HALF + m * 16) * 2816 + col0;
#pragma unroll
                    for (int bj = 0; bj < 2; ++bj)
#pragma unroll
                        for (int n = 0; n < 2; ++n) *(f32x4*)(rowp + bj * HALF + n * 4) = acc[ai][bj][m][n]; }
        } else {
            const int colq = (u.pn - 11) * BM + wc * 32 + 8 * fq;
            const int sect = colq >> 10, cc = colq & 1023;
#pragma unroll
            for (int ai = 0; ai < 2; ++ai)
#pragma unroll
                for (int m = 0; m < 4; ++m) { const int row = row0 + ai * HALF + m * 16; bf16_t* rowp = QKV + (size_t)row * 3072 + colq;
                    float* fo = nullptr;
                    if (sect == 1) fo = row < mp ? kp + (size_t)row * 1024 + cc : (row < mt ? ks + (size_t)(row - mp) * 1024 + cc : nullptr);
                    if (sect == 2) fo = row < mp ? vp + (size_t)row * 1024 + cc : (row < mt ? vs + (size_t)(row - mp) * 1024 + cc : nullptr);
#pragma unroll
                    for (int bj = 0; bj < 2; ++bj) { const f32x4 v0 = acc[ai][bj][m][0], v1 = acc[ai][bj][m][1];
                        u32x4 w; w.x = cvt_pk_bf16(v0[0], v0[1]); w.y = cvt_pk_bf16(v0[2], v0[3]); w.z = cvt_pk_bf16(v1[0], v1[1]); w.w = cvt_pk_bf16(v1[2], v1[3]);
                        *(u32x4*)(rowp + bj * HALF) = w;
                        if (fo) { *(f32x4*)(fo + bj * HALF) = v0; *(f32x4*)(fo + bj * HALF + 4) = v1; } } }
        }
    }
};
template <bool RELU2> struct EpiBf16T {
    static constexpr bool PERM = true, AFTER_DRAIN = false;
    bf16_t* O; int ldc;
    __device__ __forceinline__ void operator()(const f32x4 (&acc)[2][2][4][2], const Unit& u, int wr, int wc, int fr, int fq) const {
        const int row0 = u.pm * BM + wr * 64 + fr, col0 = u.pn * BM + wc * 32 + 8 * fq;
#pragma unroll
        for (int ai = 0; ai < 2; ++ai)
#pragma unroll
            for (int m = 0; m < 4; ++m) { bf16_t* rowp = O + (size_t)(row0 + ai * HALF + m * 16) * ldc + col0;
#pragma unroll
                for (int bj = 0; bj < 2; ++bj) { f32x4 v0 = acc[ai][bj][m][0], v1 = acc[ai][bj][m][1];
                    if (RELU2) { v0 = __builtin_elementwise_max(v0, (f32x4){0.f, 0.f, 0.f, 0.f}); v1 = __builtin_elementwise_max(v1, (f32x4){0.f, 0.f, 0.f, 0.f}); v0 = v0 * v0; v1 = v1 * v1; }
                    u32x4 w; w.x = cvt_pk_bf16(v0[0], v0[1]); w.y = cvt_pk_bf16(v0[2], v0[3]); w.z = cvt_pk_bf16(v1[0], v1[1]); w.w = cvt_pk_bf16(v1[2], v1[3]);
                    *(u32x4*)(rowp + bj * HALF) = w; } }
    }
};

template <class Epi, class Sched, bool ALIGN_EPI = false, bool SP2 = false>
__device__ __forceinline__ void gemm_phase(PG8_LAS unsigned char* lds, const Gemm g, const Sched& S, const Epi& E, const int tid) {
    const int wid = __builtin_amdgcn_readfirstlane(tid >> 6), lane = tid & 63, wr = wid >> 2, wc = wid & 3, fr = lane & 15, fq = lane >> 4;
    const int K = g.K, nt = K / BK;
    unsigned voffA[2], voffB[2];
#pragma unroll
    for (int i = 0; i < 2; ++i) { int R, C; stage_rc(tid * 16 + i * 8192, R, C); const int Rb = Epi::PERM ? ((R & ~31) + perm32(R & 31)) : R;
        voffA[i] = (unsigned)(R * K + C) * 2u; voffB[i] = (unsigned)(Rb * K + C) * 2u; }
    const size_t kstep = (size_t)(BK * 2);
    const size_t hstep = (size_t)HALF * K * 2;
    const size_t tstep = 2 * hstep;
    const unsigned ldsw = (unsigned)wid * 1024u;
    const int aoff = lds_byte(wr * 64 + fr, fq * 8), boff = lds_byte(wc * 32 + fr, fq * 8);
#define PG8_SA(b, h) (((b) * 2 + (h)) * HTB)
#define PG8_SB(b, h) ((4 + (b) * 2 + (h)) * HTB)
#define PG8_STAGE(bufoff, gbase, voff) do { _Pragma("unroll") for (int _i = 0; _i < 2; ++_i) \
        __builtin_amdgcn_global_load_lds((const unsigned*)((const char*)(gbase) + (voff)[_i]), (PG8_LAS unsigned*)(lds + (bufoff) + ldsw + _i * 8192), 16, 0, 0); } while (0)
#define PG8_LDA(dst, b, h) do { _Pragma("unroll") for (int m = 0; m < 4; ++m) _Pragma("unroll") for (int k = 0; k < 2; ++k) dst[m][k] = *(const PG8_LAS bf16x8*)(lds + PG8_SA(b, h) + aoff + m * 2048 + k * 1024); } while (0)
#define PG8_LDB(dst, b, h) do { _Pragma("unroll") for (int n = 0; n < 2; ++n) _Pragma("unroll") for (int k = 0; k < 2; ++k) dst[n][k] = *(const PG8_LAS bf16x8*)(lds + PG8_SB(b, h) + boff + n * 2048 + k * 1024); } while (0)
#define PG8_MMA(ai, bj, At, Bt) do { __builtin_amdgcn_s_setprio(1); _Pragma("unroll") for (int m = 0; m < 4; ++m) _Pragma("unroll") for (int n = 0; n < 2; ++n) _Pragma("unroll") for (int k = 0; k < 2; ++k) \
        acc[ai][bj][m][n] = __builtin_amdgcn_mfma_f32_16x16x32_bf16(Bt[n][k], At[m][k], acc[ai][bj][m][n], 0, 0, 0); __builtin_amdgcn_s_setprio(0); } while (0)
#define PG8_WAIT_V(n) asm volatile("s_waitcnt vmcnt(" #n ")" ::: "memory")
#define PG8_WAIT_L(n) asm volatile("s_waitcnt lgkmcnt(" #n ")" ::: "memory")
#define PG8_BAR __builtin_amdgcn_s_barrier()
#define PG8_SCHED __builtin_amdgcn_sched_barrier(0)
    Unit cur, nxt; int ui = 0;
    if (!S.next(0, cur)) return;
    f32x4 acc[2][2][4][2];
#pragma unroll
    for (int a = 0; a < 2; ++a)
#pragma unroll
        for (int b = 0; b < 2; ++b)
#pragma unroll
            for (int m = 0; m < 4; ++m)
#pragma unroll
                for (int n = 0; n < 2; ++n) acc[a][b][m][n] = (f32x4){0.f, 0.f, 0.f, 0.f};
    bf16x8 At[4][2], B0[2][2], B1[2][2];
    const char* cA = (const char*)g.A + (size_t)cur.pm * tstep; const char* cB = (const char*)g.Bt + (size_t)cur.pn * tstep;
    S.a_ready(cur);
    if constexpr (SP2) {
        PG8_STAGE(PG8_SB(0, 0), cB, voffB); PG8_STAGE(PG8_SB(0, 1), cB + hstep, voffB); PG8_STAGE(PG8_SA(0, 0), cA, voffA); PG8_STAGE(PG8_SA(0, 1), cA + hstep, voffA);
        if (wr == 1) PG8_BAR;
        PG8_WAIT_V(2); PG8_BAR;
        PG8_STAGE(PG8_SB(1, 0), cB + kstep, voffB); PG8_STAGE(PG8_SA(1, 0), cA + kstep, voffA); PG8_STAGE(PG8_SB(1, 1), cB + hstep + kstep, voffB);
        PG8_WAIT_V(6); PG8_BAR;
    } else {
        PG8_STAGE(PG8_SB(0, 0), cB, voffB); PG8_STAGE(PG8_SA(0, 0), cA, voffA); PG8_STAGE(PG8_SB(0, 1), cB + hstep, voffB); PG8_STAGE(PG8_SA(0, 1), cA + hstep, voffA);
        if (wr == 1) PG8_BAR;
        PG8_WAIT_V(4); PG8_BAR;
        PG8_STAGE(PG8_SB(1, 0), cB + kstep, voffB); PG8_STAGE(PG8_SA(1, 0), cA + kstep, voffA); PG8_STAGE(PG8_SB(1, 1), cB + hstep + kstep, voffB);
        PG8_WAIT_V(6); PG8_BAR;
    }
    for (;;) {
        const bool has_next = S.next(ui + 1, nxt);
        const char* nA = has_next ? (const char*)g.A + (size_t)nxt.pm * tstep : cA; const char* nB = has_next ? (const char*)g.Bt + (size_t)nxt.pn * tstep : cB;
        for (int t = 0; t < nt; t += 2) {
            const bool last = (t == nt - 2);
            const char* a1 = cA + (size_t)(t + 1) * kstep;
            const char* a2 = last ? nA : cA + (size_t)(t + 2) * kstep; const char* b2 = last ? nB : cB + (size_t)(t + 2) * kstep;
            const char* a3 = a2 + kstep; const char* b3 = b2 + kstep;
            if (last && has_next) S.a_ready(nxt);
            if constexpr (SP2) {
            PG8_LDB(B0, 0, 0); PG8_LDB(B1, 0, 1); PG8_SCHED; PG8_LDA(At, 0, 0); PG8_STAGE(PG8_SA(1, 1), a1 + hstep, voffA);
            PG8_WAIT_V(8); PG8_WAIT_L(0); PG8_BAR; PG8_MMA(0, 0, At, B0); PG8_MMA(0, 1, At, B1); PG8_BAR; PG8_SCHED;
            PG8_LDA(At, 0, 1); PG8_STAGE(PG8_SB(0, 0), b2, voffB); PG8_STAGE(PG8_SB(0, 1), b2 + hstep, voffB); PG8_STAGE(PG8_SA(0, 0), a2, voffA);
            PG8_WAIT_V(8); PG8_WAIT_L(0); PG8_BAR; PG8_MMA(1, 0, At, B0); PG8_MMA(1, 1, At, B1); PG8_BAR; PG8_SCHED;
            PG8_LDB(B0, 1, 0); PG8_LDB(B1, 1, 1); PG8_SCHED; PG8_LDA(At, 1, 0); PG8_STAGE(PG8_SA(0, 1), a2 + hstep, voffA);
            PG8_WAIT_V(8); PG8_WAIT_L(0); PG8_BAR; PG8_MMA(0, 0, At, B0); PG8_MMA(0, 1, At, B1); PG8_BAR; PG8_SCHED;
            PG8_LDA(At, 1, 1); PG8_STAGE(PG8_SB(1, 0), b3, voffB); PG8_STAGE(PG8_SB(1, 1), b3 + hstep, voffB); PG8_STAGE(PG8_SA(1, 0), a3, voffA);
            PG8_WAIT_V(8); PG8_WAIT_L(0); PG8_BAR; PG8_MMA(1, 0, At, B0); PG8_MMA(1, 1, At, B1); PG8_BAR; PG8_SCHED;
            } else {
            PG8_LDB(B0, 0, 0); PG8_SCHED; PG8_LDA(At, 0, 0); PG8_STAGE(PG8_SA(1, 1), a1 + hstep, voffA);
            PG8_WAIT_L(8); PG8_BAR; PG8_WAIT_L(0); PG8_MMA(0, 0, At, B0); PG8_BAR; PG8_SCHED;
            PG8_LDB(B1, 0, 1); PG8_STAGE(PG8_SB(0, 0), b2, voffB);
            PG8_BAR; PG8_WAIT_L(0); PG8_MMA(0, 1, At, B1); PG8_BAR;
            PG8_LDA(At, 0, 1); PG8_STAGE(PG8_SA(0, 0), a2, voffA);
            PG8_BAR; PG8_WAIT_L(0); PG8_MMA(1, 0, At, B0); PG8_BAR; PG8_SCHED;
            PG8_STAGE(PG8_SB(0, 1), b2 + hstep, voffB);
            PG8_WAIT_V(6); PG8_BAR; PG8_MMA(1, 1, At, B1); PG8_BAR;
            PG8_LDB(B0, 1, 0); PG8_SCHED; PG8_LDA(At, 1, 0); PG8_STAGE(PG8_SA(0, 1), a2 + hstep, voffA);
            PG8_WAIT_L(8); PG8_BAR; PG8_WAIT_L(0); PG8_MMA(0, 0, At, B0); PG8_BAR; PG8_SCHED;
            PG8_LDB(B1, 1, 1); PG8_STAGE(PG8_SB(1, 0), b3, voffB);
            PG8_BAR; PG8_WAIT_L(0); PG8_MMA(0, 1, At, B1); PG8_BAR;
            PG8_LDA(At, 1, 1); PG8_STAGE(PG8_SA(1, 0), a3, voffA);
            PG8_BAR; PG8_WAIT_L(0); PG8_MMA(1, 0, At, B0); PG8_BAR; PG8_SCHED;
            PG8_STAGE(PG8_SB(1, 1), b3 + hstep, voffB);
            PG8_WAIT_V(6); PG8_BAR; PG8_MMA(1, 1, At, B1); PG8_BAR;
            }
        }
        if constexpr (ALIGN_EPI) { if (wr == 0) PG8_BAR; }
        if constexpr (!Epi::AFTER_DRAIN) { E(acc, cur, wr, wc, fr, fq); S.done(cur); }
        if (!has_next) break;
#pragma unroll
        for (int a = 0; a < 2; ++a)
#pragma unroll
            for (int b = 0; b < 2; ++b)
#pragma unroll
                for (int m = 0; m < 4; ++m)
#pragma unroll
                    for (int n = 0; n < 2; ++n) acc[a][b][m][n] = (f32x4){0.f, 0.f, 0.f, 0.f};
        cur = nxt; cA = nA; cB = nB; ++ui;
        if constexpr (ALIGN_EPI) { if (wr == 1) PG8_BAR; }
    }
    PG8_WAIT_V(0);
    if constexpr (!ALIGN_EPI) { if (wr == 0) PG8_BAR; }
    PG8_BAR;
    if constexpr (Epi::AFTER_DRAIN) { E.fused(acc, cur, wr, wc, fr, fq, lds, wid, lane); S.done(cur); }
#undef PG8_SA
#undef PG8_SB
#undef PG8_STAGE
#undef PG8_LDA
#undef PG8_LDB
#undef PG8_MMA
#undef PG8_WAIT_V
#undef PG8_WAIT_L
#undef PG8_BAR
#undef PG8_SCHED
}
}


typedef unsigned short bf16;
typedef short bf16x8 __attribute__((ext_vector_type(8)));
typedef short s16x4 __attribute__((ext_vector_type(4)));
typedef float f32x16 __attribute__((ext_vector_type(16)));
constexpr int ATT_WLDS = 12800;
typedef unsigned v4u __attribute__((ext_vector_type(4)));
typedef unsigned v2u __attribute__((ext_vector_type(2)));
typedef float f32x2c_ __attribute__((ext_vector_type(2)));
typedef __bf16 bf16x2c_ __attribute__((ext_vector_type(2)));
__device__ __forceinline__ unsigned pk2(float lo, float hi) { const f32x2c_ v = {lo, hi}; return __builtin_bit_cast(unsigned, __builtin_convertvector(v, bf16x2c_)); }
__device__ __forceinline__ unsigned f2bf(float f) { return pk2(f, f) & 0xffffu; }
#define LDS_WAIT() asm volatile("s_waitcnt lgkmcnt(0)" ::: "memory")

__device__ __forceinline__ void p0_transpose_item(const float* W, int K, int N, bf16* WT, LAS float* scr, int item, int lane) {
    const int nblk = N / 32, kb = item / nblk, nb = item % nblk, k0 = 64 * kb, n0 = 32 * nb;
    float wv[32];
#pragma unroll
    for (int i = 0; i < 32; ++i) wv[i] = W[(size_t)(k0 + 2 * i + (lane >> 5)) * N + n0 + (lane & 31)];
#pragma unroll
    for (int i = 0; i < 32; ++i) scr[(2 * i + (lane >> 5)) * 33 + (lane & 31)] = wv[i];
    LDS_WAIT(); asm volatile("" ::: "memory");
    const int c = lane & 7;
#pragma unroll
    for (int j = 0; j < 4; ++j) { const int n = (lane >> 3) + 8 * j; const LAS float* s = scr + (8 * c) * 33 + n;
        v4u o; o.x = pk2(s[0 * 33], s[1 * 33]); o.y = pk2(s[2 * 33], s[3 * 33]); o.z = pk2(s[4 * 33], s[5 * 33]); o.w = pk2(s[6 * 33], s[7 * 33]);
        *(GAS v4u*)(WT + (size_t)(n0 + n) * K + k0 + 8 * c) = o; }
    LDS_WAIT(); asm volatile("" ::: "memory");
}
__device__ __forceinline__ void ph_weights(const Params& P, int gw, int ngw, int wave, int lane, LAS float* lds) {
    LAS float* scr = lds + wave * 4096;
    constexpr int I_IN = (D / 64) * (NIN / 32), I_OUT = (D / 64) * (D / 32), I_1 = (D / 64) * (DFF / 32), I_2 = (DFF / 64) * (D / 32);
    constexpr int PER_L = I_IN + I_OUT + I_1 + I_2;
    for (int it = gw; it < DEPTH * PER_L; it += ngw) {
        const int l = it / PER_L; int r = it % PER_L;
        if (r < I_IN) { p0_transpose_item(P.in[13] + (size_t)l * D * NIN, D, NIN, (bf16*)(P.ws + WS_WIN) + (size_t)l * NIN * D, scr, r, lane); continue; } r -= I_IN;
        if (r < I_OUT) { p0_transpose_item(P.in[14] + (size_t)l * D * D, D, D, (bf16*)(P.ws + WS_WOUT) + (size_t)l * D * D, scr, r, lane); continue; } r -= I_OUT;
        if (r < I_1) { p0_transpose_item(P.in[33] + (size_t)l * D * DFF, D, DFF, (bf16*)(P.ws + WS_W1) + (size_t)l * DFF * D, scr, r, lane); continue; } r -= I_1;
        p0_transpose_item(P.in[34] + (size_t)l * DFF * D, DFF, D, (bf16*)(P.ws + WS_W2) + (size_t)l * D * DFF, scr, r, lane);
    }
}

struct SEpiIn { float* C; bf16* QKV; float* ks; float* vs;
    __device__ __forceinline__ void operator()(int row, int col, float s) const {
        if (col < PW) C[(size_t)(MP + row) * PW + col] = s;
        else { const int cq = col - PW; QKV[(size_t)(MP + row) * 3072 + cq] = (bf16)f2bf(s);
            if (cq >= 2048) vs[(size_t)row * 1024 + (cq - 2048)] = s; else if (cq >= 1024) ks[(size_t)row * 1024 + (cq - 1024)] = s; } } };
struct SEpiF32 { float* C; int ldc;
    __device__ __forceinline__ void operator()(int row, int col, float s) const { C[(size_t)(MP + row) * ldc + col] = s; } };
struct SEpiBf16 { bf16* O; int ldc;
    __device__ __forceinline__ void operator()(int row, int col, float s) const { O[(size_t)(MP + row) * ldc + col] = (bf16)f2bf(s); } };
struct SEpiRelu2 { bf16* O; int ldc;
    __device__ __forceinline__ void operator()(int row, int col, float s) const { const float t = fmaxf(s, 0.f); O[(size_t)(MP + row) * ldc + col] = (bf16)f2bf(t * t); } };
template <class E>
__device__ __forceinline__ void gemm_small(const bf16* A, const bf16* Bt, int N, int K, int u0, int ustride, int tid, int wave, int lane, LAS float* lds, const E& epi) {
    const int kw = K >> 3, i32 = lane & 31, hi = lane >> 5;
    for (int u = u0; u < (N >> 5); u += ustride) {
        const int n0 = u * 32;
        f32x16 acc;
#pragma unroll
        for (int r = 0; r < 16; ++r) acc[r] = 0.f;
        const bf16* ap = A + (size_t)i32 * K + wave * kw + hi * 8;
        const bf16* bp = Bt + (size_t)(n0 + i32) * K + wave * kw + hi * 8;
#pragma unroll 8
        for (int k = 0; k < kw; k += 16) { const bf16x8 a = *(const bf16x8*)(ap + k); const bf16x8 b = *(const bf16x8*)(bp + k); acc = __builtin_amdgcn_mfma_f32_32x32x16_bf16(a, b, acc, 0, 0, 0); }
#pragma unroll
        for (int r = 0; r < 16; ++r) lds[wave * 1024 + r * 64 + lane] = acc[r];
        __syncthreads();
#pragma unroll
        for (int q = 0; q < 2; ++q) { const int idx = tid + 512 * q; float s = 0.f;
#pragma unroll
            for (int w = 0; w < 8; ++w) s += lds[w * 1024 + idx];
            const int ri = idx >> 6, ln = idx & 63;
            epi((ri & 3) + 8 * (ri >> 2) + 4 * (ln >> 5), n0 + (ln & 31), s); }
        __syncthreads();
    }
}

__device__ __forceinline__ void ph_norm1(const Params& P, int gw, int ngw, int lane) {
    const float* g = P.in[9];
    bf16* H = (bf16*)(P.ws + WS_HB);
    f32x4 g1v[8];
#pragma unroll
    for (int j = 0; j < 8; ++j) g1v[j] = *(const f32x4*)(g + lane * 4 + j * 256);
    for (int r = gw; r < MT; r += ngw) {
        const float* x = r < MP ? P.in[0] + (size_t)r * D : P.in[1] + (size_t)(r - MP) * D;
        f32x4 v[8]; float ss = 0.f;
#pragma unroll
        for (int j = 0; j < 8; ++j) { v[j] = *(const f32x4*)(x + lane * 4 + j * 256); ss += v[j].x * v[j].x + v[j].y * v[j].y + v[j].z * v[j].z + v[j].w * v[j].w; }
        ss = wave_sum(ss);
        const float rs = rsqrtf(ss * (1.f / D) + RMS_EPS);
#pragma unroll
        for (int j = 0; j < 8; ++j) { const f32x4 gv = g1v[j]; const f32x4 o = v[j] * rs * gv;
            *(v2u*)(H + (size_t)r * D + lane * 4 + j * 256) = (v2u){pk2(o.x, o.y), pk2(o.z, o.w)}; }
    }
}

template <int EPI>
__device__ __forceinline__ void ph_gemm_naive(const float* A, int lda, const float* W, float* C, int ldc, int M, int N, int K, int bid, int nb, int tid, LAS float* lds) {
    LAS float* As = lds;
    LAS float* Bs = lds + 16 * 132;
    const int ty = tid >> 4, tx = tid & 15;
    const int ntm = (M + 127) / 128, ntn = N / 64;
    for (int tile = bid; tile < ntm * ntn; tile += nb) {
        const int tm = tile / ntn, tn = tile % ntn, m0 = tm * 128, n0 = tn * 64;
        float acc[4][4];
#pragma unroll
        for (int i = 0; i < 4; ++i)
#pragma unroll
            for (int j = 0; j < 4; ++j) acc[i][j] = 0.f;
        const int ar = m0 + (tid >> 2), ak = (tid & 3) * 4, bk = tid >> 5, bc = (tid & 31) * 2;
        for (int k0 = 0; k0 < K; k0 += 16) {
            f32x4 av = (f32x4){0.f, 0.f, 0.f, 0.f};
            if (ar < M) av = *(const f32x4*)(A + (size_t)ar * lda + k0 + ak);
            const f32x2 bv = *(const f32x2*)(W + (size_t)(k0 + bk) * N + n0 + bc);
            __syncthreads();
            As[(ak + 0) * 132 + (tid >> 2)] = av.x; As[(ak + 1) * 132 + (tid >> 2)] = av.y; As[(ak + 2) * 132 + (tid >> 2)] = av.z; As[(ak + 3) * 132 + (tid >> 2)] = av.w;
            Bs[bk * 64 + bc] = bv.x; Bs[bk * 64 + bc + 1] = bv.y;
            __syncthreads();
#pragma unroll
            for (int k = 0; k < 16; ++k) {
                const f32x4 a = *(const LAS f32x4*)(As + k * 132 + ty * 4);
                const f32x4 b = *(const LAS f32x4*)(Bs + k * 64 + tx * 4);
#pragma unroll
                for (int i = 0; i < 4; ++i)
#pragma unroll
                    for (int j = 0; j < 4; ++j) acc[i][j] += a[i] * b[j];
            }
        }
#pragma unroll
        for (int i = 0; i < 4; ++i) {
            const int row = m0 + ty * 4 + i;
            if (row < M) {
                f32x4 o = (f32x4){acc[i][0], acc[i][1], acc[i][2], acc[i][3]};
                if (EPI == 1) { o.x = fmaxf(o.x, 0.f); o.y = fmaxf(o.y, 0.f); o.z = fmaxf(o.z, 0.f); o.w = fmaxf(o.w, 0.f); o = o * o; }
                *(f32x4*)(C + (size_t)row * ldc + n0 + tx * 4) = o;
            }
        }
    }
}

template <int NJ> __device__ __forceinline__ void lora_pass(f32x2 (&acc)[18], const LAS float* act, const float* wcol) {
#pragma unroll 1
    for (int j0 = 0; j0 < NJ; j0 += 8) {
        float wv[8];
#pragma unroll
        for (int q = 0; q < 8; ++q) wv[q] = wcol[(size_t)(j0 + q) * 512];
        f32x4 xa[9], xb[9];
#pragma unroll
        for (int t4 = 0; t4 < 9; ++t4) xa[t4] = *(const LAS f32x4*)(act + j0 * 36 + 4 * t4);
        __builtin_amdgcn_sched_barrier(0);
#pragma unroll
        for (int q = 0; q < 8; q += 2) {
#pragma unroll
            for (int t4 = 0; t4 < 9; ++t4) xb[t4] = *(const LAS f32x4*)(act + (j0 + q + 1) * 36 + 4 * t4);
            { const f32x2 w2 = (f32x2){wv[q], wv[q]};
#pragma unroll
              for (int t4 = 0; t4 < 9; ++t4) { acc[2 * t4] += xa[t4].xy * w2; acc[2 * t4 + 1] += xa[t4].zw * w2; } }
            __builtin_amdgcn_sched_barrier(0);
            if (q + 2 < 8) {
#pragma unroll
                for (int t4 = 0; t4 < 9; ++t4) xa[t4] = *(const LAS f32x4*)(act + (j0 + q + 2) * 36 + 4 * t4);
            }
            { const f32x2 w2 = (f32x2){wv[q + 1], wv[q + 1]};
#pragma unroll
              for (int t4 = 0; t4 < 9; ++t4) { acc[2 * t4] += xb[t4].xy * w2; acc[2 * t4 + 1] += xb[t4].zw * w2; } }
            __builtin_amdgcn_sched_barrier(0);
        }
    }
}
constexpr int LA_P = 264;
__device__ __forceinline__ void lora_mfma64(f32x4 (&acc)[3][2], const LAS unsigned short* AH, const LAS unsigned short* AL, int kofs, const float* wsl_, int half, int lane) {
    const float* wsl = wsl_ + 32 * half;
    const int n = lane & 15, kq = lane >> 4;
    unsigned wlo = (unsigned)(kq * 8 * 512 + n);
    asm volatile("" : "+s"(wsl), "+v"(wlo));
    float wf[2][2][8];
#pragma unroll
    for (int nt = 0; nt < 2; ++nt)
#pragma unroll
        for (int ks = 0; ks < 2; ++ks)
#pragma unroll
            for (int i = 0; i < 8; ++i) wf[nt][ks][i] = (wsl + (32 * ks + i) * 512 + 16 * nt)[wlo];
    bf16x8 ah[2][3], al[2][3];
    __builtin_amdgcn_sched_barrier(0);
#pragma unroll
    for (int ks = 0; ks < 2; ++ks)
#pragma unroll
        for (int mt = 0; mt < 3; ++mt) { ah[ks][mt] = *(const LAS bf16x8*)(AH + (16 * mt + n) * LA_P + kofs + 32 * ks + 8 * kq); al[ks][mt] = *(const LAS bf16x8*)(AL + (16 * mt + n) * LA_P + kofs + 32 * ks + 8 * kq); }
    WAVE_LDS_SYNC();
    __builtin_amdgcn_sched_barrier(0);
#pragma unroll
    for (int ks = 0; ks < 2; ++ks) {
#pragma unroll
        for (int nt = 0; nt < 2; ++nt) {
            bf16x8 bh, bl;
#pragma unroll
            for (int i = 0; i < 8; ++i) { const float wv_ = wf[nt][ks][i]; const unsigned h_ = f2bf(wv_); bh[i] = (short)h_; bl[i] = (short)f2bf(wv_ - __uint_as_float(h_ << 16)); }
#pragma unroll
            for (int mt = 0; mt < 3; ++mt) {
                acc[mt][nt] = __builtin_amdgcn_mfma_f32_16x16x32_bf16(ah[ks][mt], bh, acc[mt][nt], 0, 0, 0);
                acc[mt][nt] = __builtin_amdgcn_mfma_f32_16x16x32_bf16(al[ks][mt], bh, acc[mt][nt], 0, 0, 0);
                acc[mt][nt] = __builtin_amdgcn_mfma_f32_16x16x32_bf16(ah[ks][mt], bl, acc[mt][nt], 0, 0, 0);
            }
        }
    }
    __builtin_amdgcn_sched_barrier(0);
#pragma unroll
    for (int mt = 0; mt < 3; ++mt)
#pragma unroll
        for (int nt = 0; nt < 2; ++nt) acc[mt][nt][0] += 0.0f;
    __builtin_amdgcn_sched_barrier(0);
}
__device__ __forceinline__ void lora_store(const f32x4 (&acc)[3][2], LAS float* RES, int wave, int half, int lane) {
    const int n = lane & 15, kq = lane >> 4;
#pragma unroll
    for (int mt = 0; mt < 3; ++mt)
#pragma unroll
        for (int r = 0; r < 4; ++r) { const int row = 16 * mt + 4 * kq + r;
            if (row < 33) {
#pragma unroll
                for (int nt = 0; nt < 2; ++nt) RES[row * 512 + 64 * wave + 32 * half + 16 * nt + n] = acc[mt][nt][r]; } }
}
__device__ __forceinline__ void ph_post_in(const Params& P, int l, int bid, int nb, int tid, LAS float* lds) {
    const float* PROJ = (const float*)(P.ws + WS_PROJ);
    float* RWB = (float*)(P.ws + WS_RWB);
    float* out = P.out;
    const size_t gtid = (size_t)bid * 512 + tid, nthr = (size_t)nb * 512;
#pragma unroll 1
    for (size_t i = gtid; i < (size_t)NSEQ * RPROJ; i += nthr) {
        const int s = (int)(i / RPROJ), c = (int)(i % RPROJ); int row0, T; seq_of(s, row0, T);
        const float v = PROJ[(size_t)(row0 + T - 1) * PW + c];
        if (s < NB) out[O_SHIFT_P + ((size_t)l * NB + s) * RPROJ + c] = v; else out[O_SHIFT_S + ((size_t)l * DB + (s - NB)) * RPROJ + c] = v;
    }
#pragma unroll 1
    for (size_t i = gtid; i < (size_t)NSEQ * 3 * 512; i += nthr) {
        const int s = (int)(i / 1536), j = (int)((i % 1536) / 512), c = (int)(i % 512); int row0, T; seq_of(s, row0, T);
        const float v = PROJ[(size_t)(row0 + T - 3 + j) * PW + C_LX + c];
        if (s < NB) out[O_CONV_P + (((size_t)l * NB + s) * 3 + j) * 512 + c] = v; else out[O_CONV_S + (((size_t)l * DB + (s - NB)) * 3 + j) * 512 + c] = v;
    }
    constexpr int TT = 33, NTILE = (MT + TT - 1) / TT;
    LAS unsigned short* AH = (LAS unsigned short*)lds;
    LAS unsigned short* AL = AH + 48 * LA_P;
    LAS float* RES = (LAS float*)(AL + 48 * LA_P);
    static_assert(2 * 48 * LA_P * 2 + 33 * 512 * 4 <= 131072, "prep LDS");
    const float* mu = P.in[15] + (size_t)l * RPROJ;
    const float* w_up = P.in[17] + (size_t)l * 64 * 512; const float* a_up = P.in[19] + (size_t)l * 64 * 512; const float* g_up = P.in[20] + (size_t)l * 128 * 512;
    const int wave = __builtin_amdgcn_readfirstlane(tid >> 6), lane = tid & 63;
    for (int tile = bid; tile < NTILE; tile += nb) {
        int c = tid; asm volatile("" : "+v"(c));
        const int r0 = tile * TT;
        {
            const int j = tid & 255, th = tid >> 8;
            const float muj = mu[1536 + j];
            float pprev = 0.f;
            { const int r = r0 + th * 18; if (r > 0 && r < MT) pprev = PROJ[(size_t)(r - 1) * PW + 1536 + j]; }
#pragma unroll 9
            for (int i = 0; i < 18; ++i) {
                const int t = th * 18 + i, r = r0 + t;
                float av = 0.f;
                if (t < TT && r < MT) {
                    int s, ts; row_to_seq(r, s, ts);
                    const float p = PROJ[(size_t)r * PW + 1536 + j];
                    float pv = pprev;
                    if (ts == 0) pv = (s >= NB) ? P.in[3][((size_t)l * DB + (s - NB)) * RPROJ + 1536 + j] : 0.f;
                    const float m = p + (pv - p) * muj;
                    av = j < 64 ? ftanh_(m) : (j < 128 ? m : fsigmoid_(m));
                    pprev = p;
                }
                const unsigned hb = f2bf(av);
                AH[t * LA_P + j] = (unsigned short)hb; AL[t * LA_P + j] = (unsigned short)f2bf(av - __uint_as_float(hb << 16));
            }
            for (int i = tid; i < 12 * 256; i += 512) { AH[(36 + (i >> 8)) * LA_P + (i & 255)] = 0; AL[(36 + (i >> 8)) * LA_P + (i & 255)] = 0; }
        }
        __syncthreads();
        f32x4 acc[3][2];
#define LORA_ZERO() do { _Pragma("unroll") for (int mt = 0; mt < 3; ++mt) _Pragma("unroll") for (int nt = 0; nt < 2; ++nt) acc[mt][nt] = (f32x4){0.f, 0.f, 0.f, 0.f}; } while (0)
#pragma unroll 1
        for (int half = 0; half < 2; ++half) { LORA_ZERO(); lora_mfma64(acc, AH, AL, 0, w_up + 64 * wave, half, lane); lora_store(acc, RES, wave, half, lane); }
        __syncthreads();
        {
            const float w0c = P.in[16][l * 512 + c];
#pragma unroll
            for (int t = 0; t < TT; ++t) {
                if ((t & 7) == 0) __builtin_amdgcn_sched_barrier(0);
                const float z = w0c + RES[t * 512 + c];
                const float w_log = -fsoftplus_(-z) - 0.5f;
                if (r0 + t < MT) RWB[(size_t)(r0 + t) * 3584 + 512 + c] = fexp_(-fexp_(w_log));
            }
        }
        __syncthreads();
        asm volatile("" : "+v"(c));
#pragma unroll 1
        for (int half = 0; half < 2; ++half) { LORA_ZERO(); lora_mfma64(acc, AH, AL, 64, a_up + 64 * wave, half, lane); lora_store(acc, RES, wave, half, lane); }
        __syncthreads();
        float acc1[TT];
        {
            const float a0c = P.in[18][l * 512 + c];
#pragma unroll
            for (int t = 0; t < TT; ++t) acc1[t] = fsigmoid_(a0c + RES[t * 512 + c]);
        }
        __syncthreads();
        asm volatile("" : "+v"(c));
#pragma unroll 1
        for (int half = 0; half < 2; ++half) { LORA_ZERO(); lora_mfma64(acc, AH, AL, 128, g_up + 64 * wave, half, lane); lora_mfma64(acc, AH, AL, 192, g_up + (size_t)64 * 512 + 64 * wave, half, lane); lora_store(acc, RES, wave, half, lane); }
#undef LORA_ZERO
        __syncthreads();
        asm volatile("" : "+v"(c));
        {
            const float mur = mu[c], muk = mu[512 + c], muv = mu[1024 + c];
            const float kkc = P.in[21][l * 512 + c], kac = P.in[22][l * 512 + c];
            float pv0 = 0.f, pv1 = 0.f, pv2 = 0.f;
            if (r0 > 0) { const float* pp = PROJ + (size_t)(r0 - 1) * PW; pv0 = pp[c]; pv1 = pp[512 + c]; pv2 = pp[1024 + c]; }
#pragma unroll
            for (int t = 0; t < TT; ++t) {
                if (t % 11 == 0) __builtin_amdgcn_sched_barrier(0);
                const int r = (r0 + t < MT) ? r0 + t : MT - 1; int s, ts; row_to_seq(r, s, ts);
                const float* pr = PROJ + (size_t)r * PW;
                const float p0 = pr[c], p1 = pr[512 + c], p2 = pr[1024 + c];
                float q0 = pv0, q1 = pv1, q2 = pv2;
                if (ts == 0) { q0 = 0.f; q1 = 0.f; q2 = 0.f;
                    if (s >= NB) { const float* st = P.in[3] + ((size_t)l * DB + (s - NB)) * RPROJ; q0 = st[c]; q1 = st[512 + c]; q2 = st[1024 + c]; } }
                pv0 = p0; pv1 = p1; pv2 = p2;
                const float rr = p0 + (q0 - p0) * mur, k = p1 + (q1 - p1) * muk, vv = p2 + (q2 - p2) * muv;
                const float a = acc1[t];
                const float kkv = k * kkc;
                const float ss = wave_sum(kkv * kkv);
                const float kkn = kkv * __builtin_amdgcn_rsqf(fmaxf(ss, 1e-24f));
                if (r0 + t < MT) { float* o = RWB + (size_t)r * 3584 + c;
                    o[0] = rr; o[1024] = k * (1.0f + (a - 1.0f) * kac); o[1536] = vv; o[2048] = kkn; o[2560] = kkn * a; o[3072] = RES[t * 512 + c]; }
            }
        }
        __syncthreads();
    }
}

__device__ __forceinline__ float att_bias(const float* rel_bias, int dist, int h) {
    int b;
    if (dist < 16) b = dist;
    else { b = 16 + (int)(logf((float)dist / 16.0f) / 4.852030263919617f * 16.0f); b = b > 31 ? 31 : b; }
    return rel_bias[b * 8 + h];
}

__device__ __forceinline__ int qpop(unsigned* ctr, int lane) { unsigned v = 0u; if (lane == 0) v = atomicAdd(ctr, 1u); return (int)__builtin_amdgcn_readfirstlane(v); }
constexpr int CW_QUEUE = 1024;
constexpr int LRU_ITEMS = NB * 8 * 32 + DB * 8;
__device__ __forceinline__ void lru_item(int item, int& s, int& n, int& j, int& r0, int& nt) {
    if (item < NB * 8 * 32) { s = item >> 8; n = (item >> 5) & 7; j = item & 31; r0 = s * SEQ + j * 64; nt = 64; }
    else { const int q = item - NB * 8 * 32; s = NB + (q >> 3); n = q & 7; j = 0; r0 = MP + (q >> 3) * DS; nt = DS; }
}
__device__ __forceinline__ void ph_mix(const Params& P, int l, int bid, int nb, int wave, int lane, LAS float* lds) {
    const float* PROJ = (const float*)(P.ws + WS_PROJ);
    bf16* MIX = (bf16*)(P.ws + WS_MIXB);
    const int gw = bid * NWAVES + wave, ngw = nb * NWAVES;
    {
        float* HLOC = (float*)(P.ws + WS_HLOC); float* CUMA = (float*)(P.ws + WS_CUMA); float* SUMM = (float*)(P.ws + WS_SUMM);
        unsigned* qc = (unsigned*)(P.ws + WS_CTL) + CW_QUEUE + (l * 3 + 0) * 64;
        LAS float* XC = (LAS float*)((LAS unsigned char*)lds + 32768 + wave * ATT_WLDS);
        LAS float* GR = XC + 1040; LAS float* GI = GR + 1024;
        const int tl = lane & 15, kg = lane >> 4;
        for (int item = qpop(qc, lane); item < LRU_ITEMS; item = qpop(qc, lane)) {
            int s, n, j, r0, nt; lru_item(item, s, n, j, r0, nt);
            const int c = n * 64 + lane;
            const float* wab = P.in[28] + ((size_t)l * 8 + n) * 4096; const float* wxb = P.in[30] + ((size_t)l * 8 + n) * 4096;
            const unsigned wlo = (unsigned)(kg * 64 + 4 * tl);
            float x1 = 0.f, x2 = 0.f, x3 = 0.f;
            if (j > 0) { x1 = PROJ[(size_t)(r0 - 3) * PW + C_LX + c]; x2 = PROJ[(size_t)(r0 - 2) * PW + C_LX + c]; x3 = PROJ[(size_t)(r0 - 1) * PW + C_LX + c]; }
            else if (s >= NB) { const float* cs = P.in[5] + (((size_t)l * DB + (s - NB)) * 3) * 512 + c; x1 = cs[0]; x2 = cs[512]; x3 = cs[1024]; }
            const float cw0 = P.in[26][(l * 4 + 0) * 512 + c], cw1 = P.in[26][(l * 4 + 1) * 512 + c], cw2 = P.in[26][(l * 4 + 2) * 512 + c], cw3 = P.in[26][(l * 4 + 3) * 512 + c];
            const float cb = P.in[27][l * 512 + c], ba = P.in[29][l * 512 + c], bx = P.in[31][l * 512 + c];
            const float sp = softplusf_(-P.in[32][l * 512 + c]);
            float hl = 0.f, ca = 1.f;
            float xn[16];
#pragma unroll
            for (int q = 0; q < 16; ++q) xn[q] = (q < nt) ? PROJ[(size_t)(r0 + q) * PW + C_LX + c] : 0.f;
#pragma unroll 1
            for (int t0 = 0; t0 < nt; t0 += 16) {
                f32x4 wva[8], wvx[8];
#define LRU_LDW(S0) do { _Pragma("unroll") for (int s4 = 0; s4 < 8; ++s4) { wva[s4] = *(const f32x4*)(wab + ((S0) + s4) * 256 + wlo); wvx[s4] = *(const f32x4*)(wxb + ((S0) + s4) * 256 + wlo); } } while (0)
                LRU_LDW(0);
#pragma unroll
                for (int q = 0; q < 16; ++q) { const float xb = xn[q]; XC[q * 65 + lane] = cb + cw0 * x1 + cw1 * x2 + cw2 * x3 + cw3 * xb; x1 = x2; x2 = x3; x3 = xb; }
                WAVE_LDS_SYNC();
                float av[16];
#pragma unroll
                for (int s4 = 0; s4 < 16; ++s4) av[s4] = XC[tl * 65 + 4 * s4 + kg];
                WAVE_LDS_SYNC();
                __builtin_amdgcn_sched_barrier(0);
                f32x4 ar[4], ai[4];
#pragma unroll
                for (int ct = 0; ct < 4; ++ct) { ar[ct] = (f32x4){0.f, 0.f, 0.f, 0.f}; ai[ct] = ar[ct]; }
#pragma unroll
                for (int s4 = 0; s4 < 8; ++s4)
#pragma unroll
                    for (int ct = 0; ct < 4; ++ct) { ar[ct] = __builtin_amdgcn_mfma_f32_16x16x4f32(av[s4], wva[s4][ct], ar[ct], 0, 0, 0); ai[ct] = __builtin_amdgcn_mfma_f32_16x16x4f32(av[s4], wvx[s4][ct], ai[ct], 0, 0, 0); }
                __builtin_amdgcn_sched_barrier(0);
                LRU_LDW(8);
                __builtin_amdgcn_sched_barrier(0);
#pragma unroll
                for (int s4 = 0; s4 < 8; ++s4)
#pragma unroll
                    for (int ct = 0; ct < 4; ++ct) { ar[ct] = __builtin_amdgcn_mfma_f32_16x16x4f32(av[8 + s4], wva[s4][ct], ar[ct], 0, 0, 0); ai[ct] = __builtin_amdgcn_mfma_f32_16x16x4f32(av[8 + s4], wvx[s4][ct], ai[ct], 0, 0, 0); }
                __builtin_amdgcn_sched_barrier(0);
#undef LRU_LDW
#pragma unroll
                for (int ct = 0; ct < 4; ++ct)
#pragma unroll
                    for (int e = 0; e < 4; ++e) { GR[(4 * kg + e) * 64 + 4 * tl + ct] = ar[ct][e]; GI[(4 * kg + e) * 64 + 4 * tl + ct] = ai[ct][e]; }
                WAVE_LDS_SYNC();
                __builtin_amdgcn_sched_barrier(0);
#pragma unroll
                for (int q = 0; q < 16; ++q) xn[q] = (t0 + 16 + q < nt) ? PROJ[(size_t)(r0 + t0 + 16 + q) * PW + C_LX + c] : 0.f;
#pragma unroll
                for (int q = 0; q < 16; ++q) {
                    if (t0 + q < nt) {
                        const float xcv = XC[q * 65 + lane];
                        const float gr = sigmoidf_(GR[q * 64 + lane] + ba), gi = sigmoidf_(GI[q * 64 + lane] + bx);
                        const float log_a = -8.0f * gr * sp;
                        const float a = expf(log_a);
                        const float u = sqrtf(-expm1f(2.0f * log_a)) * (gi * xcv);
                        hl = a * hl + u; ca = ca * a;
                        HLOC[(size_t)(r0 + t0 + q) * 512 + c] = hl; CUMA[(size_t)(r0 + t0 + q) * 512 + c] = ca;
                    }
                }
                WAVE_LDS_SYNC();
            }
            SUMM[(size_t)item * 128 + lane] = ca; SUMM[(size_t)item * 128 + 64 + lane] = hl;
        }
    }
    LAS float* qs = (LAS float*)((LAS unsigned char*)lds + 32768 + wave * ATT_WLDS);
    LAS float* ps = qs + 128;
    const float* rel_bias = P.in[8];
    const bf16* QKVB = (const bf16*)(P.ws + WS_QKVB);
    unsigned* qc1 = (unsigned*)(P.ws + WS_CTL) + CW_QUEUE + (l * 3 + 1) * 64;
    for (int item = qpop(qc1, lane); item < MS * 8; item = qpop(qc1, lane)) {
        const int r = MP + (item >> 3), h = item & 7; int s, t; row_to_seq(r, s, t);
        const int b = s - NB;
        const float* knew = P.out + O_K_S + ((size_t)l * MS + b * DS) * 1024 + h * 128;
        const float* vnew = P.out + O_V_S + ((size_t)l * MS + b * DS) * 1024 + h * 128;
        const bf16* qrow = QKVB + (size_t)r * 3072 + h * 128;
        qs[lane] = __uint_as_float((unsigned)qrow[lane] << 16); qs[64 + lane] = __uint_as_float((unsigned)qrow[64 + lane] << 16);
        WAVE_LDS_SYNC();
        float sc[9]; float mx = -INFINITY;
#pragma unroll
        for (int g = 0; g < 3; ++g) {
            const int dil = g == 0 ? 1 : (g == 1 ? 4 : 16);
#pragma unroll
            for (int jj = 0; jj < 3; ++jj) {
                const int j = jj * 64 + lane;
                const float* krow = nullptr;
                if (j <= 128) { const int idx = CACHE_W + t - dil * j;
                    if (idx < CACHE_W) krow = P.in[6] + ((((size_t)l * DB + b) * CACHE_W + idx) * 8 + h) * 128;
                    else krow = knew + (size_t)(idx - CACHE_W) * 1024; }
                float sv = -INFINITY;
                if (krow) {
                    float acc = 0.f;
#pragma unroll 4
                    for (int i = 0; i < 32; ++i) { const f32x4 kq = *(const f32x4*)(krow + 4 * i); const f32x4 qq = *(const LAS f32x4*)(qs + 4 * i);
                        acc += kq.x * qq.x + kq.y * qq.y + kq.z * qq.z + kq.w * qq.w; }
                    sv = acc * ATT_SCALE + att_bias(rel_bias, j * dil, h);
                }
                sc[g * 3 + jj] = sv; mx = fmaxf(mx, sv);
            }
        }
        mx = wave_max(mx);
        float sum = 0.f;
#pragma unroll
        for (int g = 0; g < 3; ++g)
#pragma unroll
            for (int jj = 0; jj < 3; ++jj) {
                const int j = jj * 64 + lane; const float sv = sc[g * 3 + jj];
                const float p = (sv == -INFINITY) ? 0.f : expf(sv - mx);
                sum += p;
                if (j <= 128) ps[g * 129 + j] = p;
            }
        sum = wave_sum(sum);
        const float inv = 1.0f / sum;
        WAVE_LDS_SYNC();
        float o0 = 0.f, o1 = 0.f;
        for (int g = 0; g < 3; ++g) {
            const int dil = g == 0 ? 1 : (g == 1 ? 4 : 16);
#pragma unroll 1
            for (int j0 = 0; j0 < 136; j0 += 8) {
                float pq[8]; f32x2 vq[8];
#pragma unroll
                for (int q = 0; q < 8; ++q) {
                    const int j = j0 + q; const bool in = j <= 128;
                    pq[q] = in ? ps[g * 129 + j] : 0.f;
                    const int idx = CACHE_W + t - dil * (in ? j : 0);
                    const float* vrow = (idx < CACHE_W) ? P.in[7] + ((((size_t)l * DB + b) * CACHE_W + idx) * 8 + h) * 128 : vnew + (size_t)(idx - CACHE_W) * 1024;
                    vq[q] = *(const f32x2*)(vrow + 2 * lane);
                }
#pragma unroll
                for (int q = 0; q < 8; ++q) { o0 += pq[q] * vq[q].x; o1 += pq[q] * vq[q].y; }
            }
        }
        *(unsigned*)(MIX + (size_t)r * D + 1024 + h * 128 + 2 * lane) = pk2(o0 * inv, o1 * inv);
        WAVE_LDS_SYNC();
    }
    {
        bf16* OPART = (bf16*)(P.ws + WS_OPART); float* LSE = (float*)(P.ws + WS_LSE);
        LAS unsigned char* wl = (LAS unsigned char*)lds + 32768 + wave * ATT_WLDS;
        LAS float* btab = (LAS float*)wl;
        LAS float* fl = (LAS float*)(wl + 528);
        LAS unsigned char* vt = wl + 1024;
        const int i32 = lane & 31, hi = lane >> 5, i16 = lane & 15, q4 = i16 >> 2, p4 = i16 & 3, blk = (lane >> 4) & 1;
        const int xq = bid & 7;
        unsigned* qc2 = (unsigned*)(P.ws + WS_CTL) + CW_QUEUE + 512 + (l * 8 + xq) * 64;
        for (int item = qpop(qc2, lane); item < NB * 192; item = qpop(qc2, lane)) {
            const int bh = xq + 8 * (item / 192), rem = item % 192, g = rem >> 6, e = rem & 63;
            const int b = bh >> 3, h = bh & 7;
            const int dil = g == 0 ? 1 : (g == 1 ? 4 : 16), lgn = g == 0 ? 6 : (g == 1 ? 4 : 2);
            const int c = e >> lgn, l0 = (e & ((1 << lgn) - 1)) * 32;
            const bf16* base = QKVB + ((size_t)b * SEQ + c) * 3072 + h * 128;
            const size_t rstride = (size_t)dil * 3072;
            for (int d = lane; d < 129; d += 64) btab[d] = att_bias(rel_bias, d * dil, h) * 1.4426950408889634f;
            bf16x8 qf[8];
            { const bf16* qp = base + (size_t)(l0 + i32) * rstride + hi * 8;
#pragma unroll
              for (int ks = 0; ks < 8; ++ks) qf[ks] = *(const bf16x8*)(qp + ks * 16); }
            WAVE_LDS_SYNC();
            const int jmin = l0 >= 128 ? 0 : (128 - l0) >> 5;
            f32x16 sc[5];
            float mloc = -INFINITY;
            bf16x8 kf[1][8];
#define ATT_LDK(SET, J) do { const bf16* kp_ = base + (size_t)(l0 - 128 + 32 * (J) + i32) * rstride + 1024 + hi * 8; \
                _Pragma("unroll") for (int ks = 0; ks < 8; ++ks) kf[SET][ks] = *(const bf16x8*)(kp_ + ks * 16); } while (0)
#pragma unroll
            for (int j = 0; j < 5; ++j) {
                if (j >= jmin) {
                    ATT_LDK(0, j);
                    f32x16 acc;
#pragma unroll
                    for (int r = 0; r < 16; ++r) acc[r] = 0.f;
#pragma unroll
                    for (int ks = 0; ks < 8; ++ks) acc = __builtin_amdgcn_mfma_f32_32x32x16_bf16(kf[0][ks], qf[ks], acc, 0, 0, 0);
#pragma unroll
                    for (int r = 0; r < 16; ++r) {
                        const int kk = (r & 3) + 8 * (r >> 2) + 4 * hi;
                        const int delta = i32 + 128 - 32 * j - kk;
                        bool ok = true;
                        if (j == 0) ok = kk >= i32;
                        if (j == 4) ok = kk <= i32;
                        const float sv = ok ? acc[r] * (ATT_SCALE * 1.4426950408889634f) + btab[ok ? delta : 0] : -INFINITY;
                        acc[r] = sv; mloc = fmaxf(mloc, sv);
                    }
                    sc[j] = acc;
                } else {
#pragma unroll
                    for (int r = 0; r < 16; ++r) sc[j][r] = -INFINITY;
                }
            }
#undef ATT_LDK
            v4u vr[1][8];
#define ATT_LDV(SET, J) do { _Pragma("unroll") for (int i = 0; i < 8; ++i) vr[0][i] = *(const v4u*)(base + (size_t)(l0 - 128 + 32 * (J) + 4 * i + (lane >> 4)) * rstride + 2048 + i16 * 8); } while (0)
            if (jmin == 0) ATT_LDV(0, 0);
            const float m = fmaxf(mloc, __shfl_xor(mloc, 32));
            float lsum = 0.f;
            bf16x8 pf[5][2];
#pragma unroll
            for (int j = 0; j < 5; ++j) {
#pragma unroll
                for (int r = 0; r < 16; ++r) { const float p = __builtin_amdgcn_exp2f(sc[j][r] - m); sc[j][r] = p; lsum += p; }
#pragma unroll
                for (int s2 = 0; s2 < 2; ++s2) {
                    v4u w; w.x = pk2(sc[j][8 * s2 + 0], sc[j][8 * s2 + 1]); w.y = pk2(sc[j][8 * s2 + 2], sc[j][8 * s2 + 3]);
                    w.z = pk2(sc[j][8 * s2 + 4], sc[j][8 * s2 + 5]); w.w = pk2(sc[j][8 * s2 + 6], sc[j][8 * s2 + 7]);
                    pf[j][s2] = __builtin_bit_cast(bf16x8, w);
                }
            }
            const float lt = lsum + __shfl_xor(lsum, 32);
            if (hi == 0) fl[i32] = 1.0f / lt;
            f32x16 o[4];
#pragma unroll
            for (int db = 0; db < 4; ++db)
#pragma unroll
                for (int r = 0; r < 16; ++r) o[db][r] = 0.f;
#pragma unroll
            for (int j = 0; j < 5; ++j) {
                if (j >= jmin) {
                    WAVE_LDS_SYNC();
#pragma unroll
                    for (int i = 0; i < 8; ++i) *(LAS v4u*)(vt + (4 * i + (lane >> 4)) * 320 + i16 * 16) = vr[0][i];
                }
                if (j + 1 < 5 && j + 1 >= jmin) ATT_LDV((j + 1) & 1, j + 1);
                if (j >= jmin) {
                    WAVE_LDS_SYNC();
                    s16x4 vlo[8], vhv[8];
#pragma unroll
                    for (int db = 0; db < 4; ++db)
#pragma unroll
                        for (int s2 = 0; s2 < 2; ++s2) {
                            const LAS unsigned char* a0 = vt + (16 * s2 + 4 * hi + q4) * 320 + (32 * db + 16 * blk + 4 * p4) * 2;
                            vlo[db * 2 + s2] = __builtin_bit_cast(s16x4, __builtin_amdgcn_ds_read_tr16_b64_v4i16((LAS s16x4*)a0));
                            vhv[db * 2 + s2] = __builtin_bit_cast(s16x4, __builtin_amdgcn_ds_read_tr16_b64_v4i16((LAS s16x4*)(a0 + 8 * 320)));
                        }
                    WAVE_LDS_SYNC();
                    __builtin_amdgcn_sched_barrier(0);
#pragma unroll
                    for (int db = 0; db < 4; ++db)
#pragma unroll
                        for (int s2 = 0; s2 < 2; ++s2) {
                            const s16x4 lo = vlo[db * 2 + s2], hv = vhv[db * 2 + s2];
                            const bf16x8 vf = (bf16x8){lo[0], lo[1], lo[2], lo[3], hv[0], hv[1], hv[2], hv[3]};
                            o[db] = __builtin_amdgcn_mfma_f32_32x32x16_bf16(pf[j][s2], vf, o[db], 0, 0, 0);
                        }
                    __builtin_amdgcn_sched_barrier(0);
                }
            }
#undef ATT_LDV
            WAVE_LDS_SYNC();
            float li[16];
#pragma unroll
            for (int r = 0; r < 16; ++r) li[r] = fl[(r & 3) + 8 * (r >> 2) + 4 * hi];
#pragma unroll
            for (int db = 0; db < 4; ++db)
#pragma unroll
                for (int r = 0; r < 16; ++r) *(LAS unsigned short*)(vt + ((r & 3) + 8 * (r >> 2) + 4 * hi) * 272 + (32 * db + i32) * 2) = (unsigned short)f2bf(o[db][r] * li[r]);
            WAVE_LDS_SYNC();
            bf16* og = OPART + (size_t)g * MP * 1024;
#pragma unroll
            for (int i = 0; i < 8; ++i) { const int row = 4 * i + (lane >> 4);
                const v4u v = *(const LAS v4u*)(vt + row * 272 + i16 * 16);
                *(v4u*)(og + ((size_t)b * SEQ + (size_t)(l0 + row) * dil + c) * 1024 + h * 128 + i16 * 8) = v; }
            if (hi == 0) LSE[((size_t)g * MP + (size_t)b * SEQ + (size_t)(l0 + i32) * dil + c) * 8 + h] = (m + __builtin_amdgcn_logf(lt)) * 0.6931471805599453f;
            WAVE_LDS_SYNC();
        }
    }
}

template <int CTRL, int RM> __device__ __forceinline__ float dpp0(float x) { return __int_as_float(__builtin_amdgcn_update_dpp(0, __float_as_int(x), CTRL, RM, 0xF, false)); }
__device__ __forceinline__ float wave_total(float x) {
    x += dpp0<0xB1, 0xF>(x); x += dpp0<0x4E, 0xF>(x); x += dpp0<0x141, 0xF>(x); x += dpp0<0x140, 0xF>(x);
    x += dpp0<0x142, 0xA>(x); x += dpp0<0x143, 0xC>(x);
    return rdl(x, 63);
}
constexpr int SCAN_ITEMS = NSEQ * 8 * 8;
constexpr int SCAN_Q = 5 * 2048 + 256;
constexpr int SCAN_AB = SCAN_Q + 1024;
constexpr int SCAN_BUF = SCAN_AB + 32;
__device__ __forceinline__ void scan_stage_store(LAS float* buf, const f32x4 (&st)[6], int tid, int stt, int sk4) {
    LAS float* d = buf + stt * 64 + sk4;
#pragma unroll
    for (int a = 0; a < 5; ++a) *(LAS f32x4*)(d + a * 2048) = st[a];
    if (tid < 64) *(LAS f32x4*)(buf + 10240 + (tid >> 1) * 8 + (tid & 1) * 4) = st[5];
    f32x4 kn;
    kn.x = __shfl_down(st[0].x, 16); kn.y = __shfl_down(st[0].y, 16); kn.z = __shfl_down(st[0].z, 16); kn.w = __shfl_down(st[0].w, 16);
    float pa = st[2].x * kn.x + st[2].y * kn.y + st[2].z * kn.z + st[2].w * kn.w;
    float pb = st[3].x * kn.x + st[3].y * kn.y + st[3].z * kn.z + st[3].w * kn.w;
    pa += dpp0<0xB1, 0xF>(pa); pa += dpp0<0x4E, 0xF>(pa); pa += dpp0<0x141, 0xF>(pa); pa += dpp0<0x140, 0xF>(pa);
    pb += dpp0<0xB1, 0xF>(pb); pb += dpp0<0x4E, 0xF>(pb); pb += dpp0<0x141, 0xF>(pb); pb += dpp0<0x140, 0xF>(pb);
    if ((stt & 1) == 0) {
        *(LAS f32x4*)(buf + SCAN_Q + (stt >> 1) * 64 + sk4) = st[1] * kn;
        if (sk4 == 0) { buf[SCAN_AB + stt] = pa; buf[SCAN_AB + stt + 1] = pb; }
    }
}
template <int CTRL> __device__ __forceinline__ float dppa(float x) { return x + __int_as_float(__builtin_amdgcn_update_dpp(0, __float_as_int(x), CTRL, 0xF, 0xF, true)); }
__device__ __forceinline__ float row16_sum(float x) { x = dppa<0xB1>(x); x = dppa<0x4E>(x); x = dppa<0x141>(x); x = dppa<0x140>(x); return x; }
__device__ __forceinline__ void ph_scan(const Params& P, int l, int bid, int nb, int tid, int wave, int lane, LAS float* lds) {
    const float* RWB = (const float*)(P.ws + WS_RWB);
    float* YRAW = (float*)(P.ws + WS_YRAW);
    float* out = P.out;
    LAS float* Pw = lds + 2 * SCAN_BUF + wave * (16 * 68);
    const int stt = tid >> 4, sk4 = (tid & 15) * 4;
    const int rw = lane >> 4, kq4 = (lane & 15) * 4;
    for (int item = bid; item < SCAN_ITEMS; item += nb) {
        int s, h, rg;
        if (item < NB * 64) { s = item >> 6; h = (item >> 3) & 7; rg = item & 7; }
        else { const int q = item - NB * 64; s = NB + (q >> 6); h = (q >> 3) & 7; rg = q & 7; }
        int row0, T; seq_of(s, row0, T);
        const int v = rg * 8 + (wave & 1) * 4 + rw;
        f32x4 S = (f32x4){0.f, 0.f, 0.f, 0.f};
        if (s >= NB && wave < 2) S = *(const f32x4*)(P.in[2] + ((((size_t)l * DB + (s - NB)) * 8 + h) * 64 + v) * 64 + kq4);
        const int nchunk = (T + 31) >> 5;
        f32x4 st[6];
        {
            const bool ok = stt < T;
            const float* src = RWB + (size_t)(row0 + (ok ? stt : 0)) * 3584 + h * 64 + sk4;
            st[0] = *(const f32x4*)(src + 2048); st[1] = *(const f32x4*)(src + 512); st[2] = *(const f32x4*)(src + 2560); st[3] = *(const f32x4*)(src + 1024); st[4] = *(const f32x4*)(src);
            if (tid < 64) { const int vt = tid >> 1; st[5] = *(const f32x4*)(RWB + (size_t)(row0 + (vt < T ? vt : 0)) * 3584 + 1536 + h * 64 + rg * 8 + (tid & 1) * 4); }
            scan_stage_store(lds, st, tid, stt, sk4);
        }
        __syncthreads();
        for (int ch = 0; ch < nchunk; ++ch) {
            const LAS float* cur = lds + (ch & 1) * SCAN_BUF;
            const bool more = ch + 1 < nchunk;
            if (more) {
                const int t1 = (ch + 1) * 32;
                const bool ok = t1 + stt < T;
                const float* src = RWB + (size_t)(row0 + (ok ? t1 + stt : 0)) * 3584 + h * 64 + sk4;
                st[0] = *(const f32x4*)(src + 2048); st[1] = *(const f32x4*)(src + 512); st[2] = *(const f32x4*)(src + 2560); st[3] = *(const f32x4*)(src + 1024); st[4] = *(const f32x4*)(src);
                if (tid < 64) { const int vt = t1 + (tid >> 1); st[5] = *(const f32x4*)(RWB + (size_t)(row0 + (vt < T ? vt : 0)) * 3584 + 1536 + h * 64 + rg * 8 + (tid & 1) * 4); }
            }
            const int nsteps = (T - ch * 32) < 32 ? (T - ch * 32) : 32;
            if (wave < 2) {
                const LAS float* cl = cur + kq4;
                const LAS float* cvp = cur + 10240 + (wave & 1) * 4 + rw;
#define SCAN_DECL(X) f32x4 kk##X, qv##X, w0##X, b0##X, p0##X, r0##X, w1##X, b1##X, p1##X, r1##X; float v0##X, v1##X, al##X, be##X
#define SCAN_LD(T2, X) do { const int t_ = (T2); \
                    kk##X = *(const LAS f32x4*)(cl + t_ * 64); qv##X = *(const LAS f32x4*)(cur + SCAN_Q + (t_ >> 1) * 64 + kq4); \
                    w0##X = *(const LAS f32x4*)(cl + 2048 + t_ * 64); b0##X = *(const LAS f32x4*)(cl + 4096 + t_ * 64); p0##X = *(const LAS f32x4*)(cl + 6144 + t_ * 64); r0##X = *(const LAS f32x4*)(cl + 8192 + t_ * 64); \
                    w1##X = *(const LAS f32x4*)(cl + 2048 + t_ * 64 + 64); b1##X = *(const LAS f32x4*)(cl + 4096 + t_ * 64 + 64); p1##X = *(const LAS f32x4*)(cl + 6144 + t_ * 64 + 64); r1##X = *(const LAS f32x4*)(cl + 8192 + t_ * 64 + 64); \
                    v0##X = cvp[t_ * 8]; v1##X = cvp[t_ * 8 + 8]; al##X = cur[SCAN_AB + t_]; be##X = cur[SCAN_AB + t_ + 1]; } while (0)
#define LO(v) (v).xy
#define HI(v) (v).zw
#define SCAN_PAIR(T2, X) do { \
                    f32x2 e1 = Sa * LO(kk##X); e1 = Sb * HI(kk##X) + e1; f32x2 e2 = Sa * LO(qv##X); e2 = Sb * HI(qv##X) + e2; \
                    const float d1 = row16_sum(e1.x + e1.y), d2 = row16_sum(e2.x + e2.y); \
                    const float sa0 = -d1; const float sa1 = -d2 - v0##X * be##X - sa0 * al##X; \
                    const f32x2 vv0 = (f32x2){v0##X, v0##X}, vv1 = (f32x2){v1##X, v1##X}, ss0 = (f32x2){sa0, sa0}, ss1 = (f32x2){sa1, sa1}; \
                    Sa = Sa * LO(w0##X) + (LO(b0##X) * ss0 + LO(p0##X) * vv0); Sb = Sb * HI(w0##X) + (HI(b0##X) * ss0 + HI(p0##X) * vv0); \
                    f32x2 y0 = Sa * LO(r0##X); y0 = Sb * HI(r0##X) + y0; \
                    Sa = Sa * LO(w1##X) + (LO(b1##X) * ss1 + LO(p1##X) * vv1); Sb = Sb * HI(w1##X) + (HI(b1##X) * ss1 + HI(p1##X) * vv1); \
                    f32x2 y1 = Sa * LO(r1##X); y1 = Sb * HI(r1##X) + y1; \
                    Pw[((T2) & 15) * 68 + lane] = y0.x + y0.y; Pw[(((T2) & 15) + 1) * 68 + lane] = y1.x + y1.y; \
                    if ((((T2) + 2) & 15) == 0 || (T2) + 2 >= nsteps) { \
                        const int hb = (T2) & ~15, ns = (T2) + 2 - hb; \
                        WAVE_LDS_SYNC(); \
                        { const int t = lane >> 2, rr = lane & 3; \
                          const LAS f32x4* pp = (const LAS f32x4*)(Pw + t * 68 + rr * 16); \
                          const f32x4 a0 = pp[0], a1 = pp[1], a2 = pp[2], a3 = pp[3]; \
                          const float y = ((a0.x + a0.y) + (a0.z + a0.w)) + ((a1.x + a1.y) + (a1.z + a1.w)) + ((a2.x + a2.y) + (a2.z + a2.w)) + ((a3.x + a3.y) + (a3.z + a3.w)); \
                          if (t < ns) YRAW[(size_t)(row0 + ch * 32 + hb + t) * 512 + h * 64 + rg * 8 + (wave & 1) * 4 + rr] = y; } \
                        WAVE_LDS_SYNC(); } } while (0)
                f32x2 Sa = S.xy, Sb = S.zw;
                SCAN_DECL(A); SCAN_DECL(B);
                SCAN_LD(0, A);
#pragma unroll 1
                for (int t2 = 0; t2 < nsteps; t2 += 4) {
                    SCAN_LD(t2 + 2, B);
                    SCAN_PAIR(t2, A);
                    SCAN_LD((t2 + 4 < 32) ? t2 + 4 : t2, A);
                    SCAN_PAIR(t2 + 2, B);
                }
                S.xy = Sa; S.zw = Sb;
#undef SCAN_PAIR
#undef LO
#undef HI
#undef SCAN_DECL
            }
#undef SCAN_LD
            if (more) scan_stage_store(lds + ((ch + 1) & 1) * SCAN_BUF, st, tid, stt, sk4);
            __syncthreads();
        }
        if (wave < 2) {
            float* so = (s < NB) ? out + O_WKV_P + ((((size_t)l * NB + s) * 8 + h) * 64 + v) * 64
                                 : out + O_WKV_S + ((((size_t)l * DB + (s - NB)) * 8 + h) * 64 + v) * 64;
            *(f32x4*)(so + kq4) = S;
        }
    }
}
constexpr int S2_ARR = 16 * 64, S2_V = 5 * S2_ARR, S2_Q = S2_V + 128, S2_AB = S2_Q + 512, S2_BUF = S2_AB + 32;
struct Scan2St { f32x4 a[2][5]; f32x4 v; };
__device__ __forceinline__ void scan2_load(Scan2St& st, const float* RWB, int row0, int t0, int T, int h, int rg, int tid) {
    const int sk4 = (tid & 15) * 4;
#pragma unroll
    for (int i = 0; i < 2; ++i) { const int t = t0 + (tid >> 4) + 8 * i;
        const float* src = RWB + (size_t)(row0 + (t < T ? t : 0)) * 3584 + h * 64 + sk4;
        st.a[i][0] = *(const f32x4*)(src + 2048); st.a[i][1] = *(const f32x4*)(src + 512); st.a[i][2] = *(const f32x4*)(src + 2560); st.a[i][3] = *(const f32x4*)(src + 1024); st.a[i][4] = *(const f32x4*)(src); }
    if (tid < 32) { const int vt = t0 + (tid >> 1); st.v = *(const f32x4*)(RWB + (size_t)(row0 + (vt < T ? vt : 0)) * 3584 + 1536 + h * 64 + rg * 8 + (tid & 1) * 4); }
}
__device__ __forceinline__ void scan2_store(LAS float* buf, const Scan2St& st, int tid) {
    const int sk4 = (tid & 15) * 4;
#pragma unroll
    for (int i = 0; i < 2; ++i) { const int stt = (tid >> 4) + 8 * i;
        LAS float* d = buf + stt * 64 + sk4;
#pragma unroll
        for (int a = 0; a < 5; ++a) *(LAS f32x4*)(d + a * S2_ARR) = st.a[i][a];
        f32x4 kn;
        kn.x = __shfl_down(st.a[i][0].x, 16); kn.y = __shfl_down(st.a[i][0].y, 16); kn.z = __shfl_down(st.a[i][0].z, 16); kn.w = __shfl_down(st.a[i][0].w, 16);
        float pa = st.a[i][2].x * kn.x + st.a[i][2].y * kn.y + st.a[i][2].z * kn.z + st.a[i][2].w * kn.w;
        float pb = st.a[i][3].x * kn.x + st.a[i][3].y * kn.y + st.a[i][3].z * kn.z + st.a[i][3].w * kn.w;
        pa = row16_sum(pa); pb = row16_sum(pb);
        if ((stt & 1) == 0) {
            *(LAS f32x4*)(buf + S2_Q + (stt >> 1) * 64 + sk4) = st.a[i][1] * kn;
            if (sk4 == 0) { buf[S2_AB + stt] = pa; buf[S2_AB + stt + 1] = pb; }
        } }
    if (tid < 32) *(LAS f32x4*)(buf + S2_V + (tid >> 1) * 8 + (tid & 1) * 4) = st.v;
}
__device__ __forceinline__ void scan2_meet(volatile LAS unsigned* fl, int wave, unsigned seq, int lane) {
    WAVE_LDS_SYNC();
    if (lane == 0) fl[wave] = seq;
    while (fl[wave ^ 1] < seq) { }
    asm volatile("" ::: "memory");
}
__device__ __forceinline__ void ph_scan2(const Params& P, int l, int item0, int istride, int tid, int wave, int lane, LAS float* lds, volatile LAS unsigned* fl) {
    const float* RWB = (const float*)(P.ws + WS_RWB);
    float* YRAW = (float*)(P.ws + WS_YRAW);
    float* out = P.out;
    LAS float* Pw = lds + 2 * S2_BUF + wave * (16 * 68);
    const int rw = lane >> 4, kq4 = (lane & 15) * 4;
    unsigned seq = (unsigned)l * 1000000u + 1u;
    for (int item = item0; item < SCAN_ITEMS; item += istride) {
        int s, h, rg;
        if (item < NB * 64) { s = item >> 6; h = (item >> 3) & 7; rg = item & 7; }
        else { const int q = item - NB * 64; s = NB + (q >> 6); h = (q >> 3) & 7; rg = q & 7; }
        int row0, T; seq_of(s, row0, T);
        const int v = rg * 8 + wave * 4 + rw;
        f32x4 S = (f32x4){0.f, 0.f, 0.f, 0.f};
        if (s >= NB) S = *(const f32x4*)(P.in[2] + ((((size_t)l * DB + (s - NB)) * 8 + h) * 64 + v) * 64 + kq4);
        const int nchunk = (T + 15) >> 4;
        Scan2St st;
        scan2_load(st, RWB, row0, 0, T, h, rg, tid);
        scan2_store(lds, st, tid);
        scan2_meet(fl, wave, seq++, lane);
        for (int ch = 0; ch < nchunk; ++ch) {
            const LAS float* cur = lds + (ch & 1) * S2_BUF;
            const bool more = ch + 1 < nchunk;
            if (more) scan2_load(st, RWB, row0, (ch + 1) * 16, T, h, rg, tid);
            const int nsteps = (T - ch * 16) < 16 ? (T - ch * 16) : 16;
            const LAS float* cl = cur + kq4;
            const LAS float* cvp = cur + S2_V + wave * 4 + rw;
#define SCAN_DECL(X) f32x4 kk##X, qv##X, w0##X, b0##X, p0##X, r0##X, w1##X, b1##X, p1##X, r1##X; float v0##X, v1##X, al##X, be##X
#define SCAN_LD(T2, X) do { const int t_ = (T2); \
                kk##X = *(const LAS f32x4*)(cl + t_ * 64); qv##X = *(const LAS f32x4*)(cur + S2_Q + (t_ >> 1) * 64 + kq4); \
                w0##X = *(const LAS f32x4*)(cl + S2_ARR + t_ * 64); b0##X = *(const LAS f32x4*)(cl + 2 * S2_ARR + t_ * 64); p0##X = *(const LAS f32x4*)(cl + 3 * S2_ARR + t_ * 64); r0##X = *(const LAS f32x4*)(cl + 4 * S2_ARR + t_ * 64); \
                w1##X = *(const LAS f32x4*)(cl + S2_ARR + t_ * 64 + 64); b1##X = *(const LAS f32x4*)(cl + 2 * S2_ARR + t_ * 64 + 64); p1##X = *(const LAS f32x4*)(cl + 3 * S2_ARR + t_ * 64 + 64); r1##X = *(const LAS f32x4*)(cl + 4 * S2_ARR + t_ * 64 + 64); \
                v0##X = cvp[t_ * 8]; v1##X = cvp[t_ * 8 + 8]; al##X = cur[S2_AB + t_]; be##X = cur[S2_AB + t_ + 1]; } while (0)
#define LO(v) (v).xy
#define HI(v) (v).zw
#define SCAN_PAIR(T2, X) do { \
                f32x2 e1 = Sa * LO(kk##X); e1 = Sb * HI(kk##X) + e1; f32x2 e2 = Sa * LO(qv##X); e2 = Sb * HI(qv##X) + e2; \
                const float d1 = row16_sum(e1.x + e1.y), d2 = row16_sum(e2.x + e2.y); \
                const float sa0 = -d1; const float sa1 = -d2 - v0##X * be##X - sa0 * al##X; \
                const f32x2 vv0 = (f32x2){v0##X, v0##X}, vv1 = (f32x2){v1##X, v1##X}, ss0 = (f32x2){sa0, sa0}, ss1 = (f32x2){sa1, sa1}; \
                Sa = Sa * LO(w0##X) + (LO(b0##X) * ss0 + LO(p0##X) * vv0); Sb = Sb * HI(w0##X) + (HI(b0##X) * ss0 + HI(p0##X) * vv0); \
                f32x2 y0 = Sa * LO(r0##X); y0 = Sb * HI(r0##X) + y0; \
                Sa = Sa * LO(w1##X) + (LO(b1##X) * ss1 + LO(p1##X) * vv1); Sb = Sb * HI(w1##X) + (HI(b1##X) * ss1 + HI(p1##X) * vv1); \
                f32x2 y1 = Sa * LO(r1##X); y1 = Sb * HI(r1##X) + y1; \
                Pw[(T2) * 68 + lane] = y0.x + y0.y; Pw[((T2) + 1) * 68 + lane] = y1.x + y1.y; } while (0)
            f32x2 Sa = S.xy, Sb = S.zw;
            SCAN_DECL(A); SCAN_DECL(B);
            SCAN_LD(0, A);
#pragma unroll 1
            for (int t2 = 0; t2 < nsteps; t2 += 4) {
                SCAN_LD(t2 + 2, B);
                SCAN_PAIR(t2, A);
                SCAN_LD((t2 + 4 < 16) ? t2 + 4 : t2, A);
                SCAN_PAIR(t2 + 2, B);
            }
            S.xy = Sa; S.zw = Sb;
#undef SCAN_PAIR
#undef LO
#undef HI
#undef SCAN_LD
#undef SCAN_DECL
            WAVE_LDS_SYNC();
            {
                const int t = lane >> 2, rr = lane & 3;
                const LAS f32x4* pp = (const LAS f32x4*)(Pw + t * 68 + rr * 16);
                const f32x4 a0 = pp[0], a1 = pp[1], a2 = pp[2], a3 = pp[3];
                const float y = ((a0.x + a0.y) + (a0.z + a0.w)) + ((a1.x + a1.y) + (a1.z + a1.w)) + ((a2.x + a2.y) + (a2.z + a2.w)) + ((a3.x + a3.y) + (a3.z + a3.w));
                if (t < nsteps) YRAW[(size_t)(row0 + ch * 16 + t) * 512 + h * 64 + rg * 8 + wave * 4 + rr] = y;
            }
            if (more) scan2_store(lds + ((ch + 1) & 1) * S2_BUF, st, tid);
            scan2_meet(fl, wave, seq++, lane);
        }
        float* so = (s < NB) ? out + O_WKV_P + ((((size_t)l * NB + s) * 8 + h) * 64 + v) * 64
                             : out + O_WKV_S + ((((size_t)l * DB + (s - NB)) * 8 + h) * 64 + v) * 64;
        *(f32x4*)(so + kq4) = S;
    }
}
__device__ __forceinline__ f32x4 mfma4(float a, float b, f32x4 c) { return __builtin_amdgcn_mfma_f32_16x16x4f32(a, b, c, 0, 0, 0); }
template <int N> __device__ __forceinline__ float dpp_shr1(float x) {
    return __int_as_float(__builtin_amdgcn_update_dpp(0x3f800000, __float_as_int(x), 0x110 + N, 0xF, 0xF, false)); }
constexpr int CPRE_ITEMS = NB * 128 * 8;
__device__ __forceinline__ void ph_chunkpre(const Params& P, int l, int gw, int ngw, int wave, int lane, LAS float* lds) {
    const float* RWB = (const float*)(P.ws + WS_RWB);
    float* CHKA = (float*)(P.ws + WS_CHKA); float* CHKB = (float*)(P.ws + WS_CHKB);
    LAS float* M0 = lds + wave * 1152; LAS float* M1 = M0 + 272; LAS float* M2 = M1 + 272; LAS float* M3 = M2 + 272;
    const int tl = lane & 15, kg = lane >> 4;
    for (int it = gw; it < CPRE_ITEMS; it += ngw) {
        const int h = it & 7, ci = (it >> 3) & 127, s = it >> 10;
        const float* base = RWB + (size_t)(s * SEQ + ci * 16 + tl) * 3584 + h * 64 + 4 * kg;
        float w[16], kk[16], b[16], kp[16], r[16];
#pragma unroll
        for (int j = 0; j < 4; ++j) { const f32x4 v0 = *(const f32x4*)(base + 512 + 16 * j), v1 = *(const f32x4*)(base + 2048 + 16 * j), v2 = *(const f32x4*)(base + 2560 + 16 * j),
                                                  v3 = *(const f32x4*)(base + 1024 + 16 * j), v4 = *(const f32x4*)(base + 16 * j);
#pragma unroll
            for (int i = 0; i < 4; ++i) { w[4 * j + i] = v0[i]; kk[4 * j + i] = v1[i]; b[4 * j + i] = v2[i]; kp[4 * j + i] = v3[i]; r[4 * j + i] = v4[i]; } }
        f32x4 g1 = (f32x4){0.f, 0.f, 0.f, 0.f}, g2 = g1, g3 = g1, g4 = g1;
        float* ca = CHKA + (size_t)it * 2048; float* cb = CHKB + (size_t)it * 3136;
#pragma unroll
        for (int j = 0; j < 4; ++j) {
            f32x4 bwv, kwv, wcv;
#pragma unroll
            for (int i = 0; i < 4; ++i) { const int q = 4 * j + i;
                float x = w[q];
                x *= dpp_shr1<1>(x); x *= dpp_shr1<2>(x); x *= dpp_shr1<4>(x); x *= dpp_shr1<8>(x);
                const float wex = dpp_shr1<1>(x);
                const float wcq = __shfl(x, (lane & 48) | 15);
                const float inv = 1.0f / x;
                const float bt = b[q] * inv, kt = kp[q] * inv, qv = wex * kk[q], rho = x * r[q];
                g1 = mfma4(bt, qv, g1); g2 = mfma4(kt, qv, g2); g3 = mfma4(bt, rho, g3); g4 = mfma4(kt, rho, g4);
                const int k = 16 * j + 4 * kg + i;
                ca[k * 16 + tl] = qv; ca[1024 + k * 16 + tl] = rho;
                bwv[i] = bt * wcq; kwv[i] = kt * wcq; wcv[i] = x; }
            const int k0 = 16 * j + 4 * kg;
            *(f32x4*)(cb + 1024 + tl * 64 + k0) = bwv; *(f32x4*)(cb + 2048 + tl * 64 + k0) = kwv;
            if (tl == 15) *(f32x4*)(cb + 3072 + k0) = wcv;
        }
        f32x4 Um, Ubm, Gym, Hym;
#pragma unroll
        for (int e = 0; e < 4; ++e) { const int i = 4 * kg + e; Um[e] = i < tl ? g1[e] : 0.f; Ubm[e] = i < tl ? g2[e] : 0.f; Gym[e] = i <= tl ? g3[e] : 0.f; Hym[e] = i <= tl ? g4[e] : 0.f; }
#define CP_ST(M, X) do { _Pragma("unroll") for (int e = 0; e < 4; ++e) (M)[(4 * kg + e) * 17 + tl] = (X)[e]; } while (0)
#define CP_D(s4) ((tl == 4 * (s4) + kg) ? 1.f : 0.f)
#define CP_MM(OUT, MA, MB, FA, FB) do { float av_[4], bv_[4]; \
            __builtin_amdgcn_sched_barrier(0); \
            _Pragma("unroll") for (int s4 = 0; s4 < 4; ++s4) { av_[s4] = (MA)[tl * 17 + 4 * s4 + kg]; bv_[s4] = (MB)[(4 * s4 + kg) * 17 + tl]; } \
            _Pragma("unroll") for (int s4 = 0; s4 < 4; ++s4) { if (FA) av_[s4] = CP_D(s4) - av_[s4]; if (FB) bv_[s4] = CP_D(s4) + bv_[s4]; } \
            __builtin_amdgcn_sched_barrier(0); \
            OUT = (f32x4){0.f, 0.f, 0.f, 0.f}; \
            _Pragma("unroll") for (int s4 = 0; s4 < 4; ++s4) OUT = mfma4(av_[s4], bv_[s4], OUT); \
            __builtin_amdgcn_sched_barrier(0); } while (0)
        f32x4 Tm;
        {
            CP_ST(M0, Um); WAVE_LDS_SYNC();
            f32x4 x2; CP_MM(x2, M0, M0, false, false);
            CP_ST(M1, x2); WAVE_LDS_SYNC();
            f32x4 x4; CP_MM(x4, M1, M1, false, false);
            CP_ST(M2, x4); WAVE_LDS_SYNC();
            f32x4 x8; CP_MM(x8, M2, M2, false, false);
            CP_ST(M3, x8); WAVE_LDS_SYNC();
            f32x4 p; CP_MM(p, M0, M1, true, true);
            CP_ST(M0, p); WAVE_LDS_SYNC();
            f32x4 p2; CP_MM(p2, M0, M2, false, true);
            CP_ST(M0, p2); WAVE_LDS_SYNC();
            CP_MM(Tm, M0, M3, false, true);
        }
#undef CP_MM
#undef CP_ST
#undef CP_D
#pragma unroll
        for (int e = 0; e < 4; ++e) { const int o = (4 * kg + e) * 16 + tl; cb[o] = Ubm[e]; cb[256 + o] = Tm[e]; cb[512 + o] = Gym[e]; cb[768 + o] = Hym[e]; }
    }
}
constexpr int CS_S = 0, CS_P1QA = 1040, CS_P1QB = CS_P1QA + 272, CS_P1RA = CS_P1QB + 272, CS_P1RB = CS_P1RA + 272, CS_VU = CS_P1RB + 272, CS_VH = CS_VU + 272,
              CS_VK = CS_VH + 272, CS_V = CS_VK + 1040, CS_CH = CS_V + 2 * 272, CS_SAT = CS_CH + 2 * 5184, CS_END = CS_SAT + 8 * 272;
static_assert(CS_END * 4 <= 131072, "chunked scan LDS");
template <int KSTEPS> __device__ __forceinline__ f32x4 cs_mm(const LAS float* A, int lda, const LAS float* B, int ldb, f32x4 acc, int tl, int kg) {
    float av[KSTEPS], bv[KSTEPS];
    __builtin_amdgcn_sched_barrier(0);
#pragma unroll
    for (int s4 = 0; s4 < KSTEPS; ++s4) { av[s4] = A[tl * lda + 4 * s4 + kg]; bv[s4] = B[(4 * s4 + kg) * ldb + tl]; }
    __builtin_amdgcn_sched_barrier(0);
#pragma unroll
    for (int s4 = 0; s4 < KSTEPS; ++s4) acc = mfma4(av[s4], bv[s4], acc);
    __builtin_amdgcn_sched_barrier(0);
    return acc;
}
struct CsPre { f32x4 a, b0, b1, v; };
__device__ __forceinline__ void cs_load(CsPre& p, const float* CHKA, const float* CHKB, const float* RWB, int itc, int row, int h, int vbase, int tid) {
    p.a = *(const f32x4*)(CHKA + (size_t)itc * 2048 + tid * 4);
    p.b0 = *(const f32x4*)(CHKB + (size_t)itc * 3136 + tid * 4);
    if (tid < 272) p.b1 = *(const f32x4*)(CHKB + (size_t)itc * 3136 + 2048 + tid * 4);
    if (tid < 64) p.v = *(const f32x4*)(RWB + (size_t)(row + (tid >> 2)) * 3584 + 1536 + h * 64 + vbase + (tid & 3) * 4);
}
__device__ __forceinline__ void cs_store(LAS float* lds, int buf, const CsPre& p, int tid) {
    LAS float* ch = lds + CS_CH + buf * 5184;
    *(LAS f32x4*)(ch + tid * 4) = p.a;
    *(LAS f32x4*)(ch + 2048 + tid * 4) = p.b0;
    if (tid < 272) *(LAS f32x4*)(ch + 4096 + tid * 4) = p.b1;
    if (tid < 64) { LAS float* vr = lds + CS_V + buf * 272; const int i = tid >> 2, r4 = (tid & 3) * 4;
        vr[(r4 + 0) * 17 + i] = p.v.x; vr[(r4 + 1) * 17 + i] = p.v.y; vr[(r4 + 2) * 17 + i] = p.v.z; vr[(r4 + 3) * 17 + i] = p.v.w; }
}
__device__ __forceinline__ void ph_cscan(const Params& P, int l, int bid, int tid, int wave, int lane, LAS float* lds) {
    const float* RWB = (const float*)(P.ws + WS_RWB);
    const float* CHKA = (const float*)(P.ws + WS_CHKA); const float* CHKB = (const float*)(P.ws + WS_CHKB);
    float* YRAW = (float*)(P.ws + WS_YRAW);
    const int bh = bid >> 2, rgp = bid & 3, s = bh >> 3, h = bh & 7, row0 = s * SEQ, vbase = rgp * 16;
    const int tl = lane & 15, kg = lane >> 4;
    const int it0 = (s * 128) * 8 + h;
    for (int i = tid; i < 1040; i += 512) lds[CS_S + i] = 0.f;
    CsPre pa, pb;
    cs_load(pa, CHKA, CHKB, RWB, it0, row0, h, vbase, tid);
    cs_store(lds, 0, pa, tid);
    cs_load(pa, CHKA, CHKB, RWB, it0 + 8, row0 + 16, h, vbase, tid);
    __syncthreads();
    LAS float* sat = lds + CS_SAT + wave * 272;
    const f32x4 z4 = (f32x4){0.f, 0.f, 0.f, 0.f};
#pragma unroll 1
    for (int c = 0; c < 128; ++c) {
        const LAS float* ch = lds + CS_CH + (c & 1) * 5184;
        const LAS float* vr = lds + CS_V + (c & 1) * 272;
        if (c + 2 < 128) cs_load(pb, CHKA, CHKB, RWB, it0 + 8 * (c + 2), row0 + 16 * (c + 2), h, vbase, tid);
        if (wave < 4) {
            const LAS float* Bm = ch + (wave >> 1) * 1024 + (wave & 1) * 32 * 16;
            f32x4 acc = cs_mm<8>(lds + CS_S + (wave & 1) * 32, 65, Bm, 16, z4, tl, kg);
            LAS float* o = lds + CS_P1QA + wave * 272;
#pragma unroll
            for (int e = 0; e < 4; ++e) o[(4 * kg + e) * 17 + tl] = acc[e];
        } else if (wave == 4) {
            const f32x4 a1 = cs_mm<4>(vr, 17, ch + 2048, 16, z4, tl, kg);
#pragma unroll
            for (int e = 0; e < 4; ++e) lds[CS_VU + (4 * kg + e) * 17 + tl] = a1[e];
            const f32x4 a2 = cs_mm<4>(vr, 17, ch + 2048 + 768, 16, z4, tl, kg);
#pragma unroll
            for (int e = 0; e < 4; ++e) lds[CS_VH + (4 * kg + e) * 17 + tl] = a2[e];
        } else if (wave < 7) {
#pragma unroll
            for (int j2 = 0; j2 < 2; ++j2) { const int j = (wave - 5) * 2 + j2;
                f32x4 a1 = cs_mm<4>(vr, 17, ch + 4096 + 16 * j, 64, z4, tl, kg);
#pragma unroll
                for (int e = 0; e < 4; ++e) lds[CS_VK + (4 * kg + e) * 65 + 16 * j + tl] = a1[e]; }
        }
        __syncthreads();
        f32x4 sa = z4;
        {   float cm[4], tb[4];
            __builtin_amdgcn_sched_barrier(0);
#pragma unroll
            for (int s4 = 0; s4 < 4; ++s4) { const int o = tl * 17 + 4 * s4 + kg;
                cm[s4] = -(lds[CS_P1QA + o] + lds[CS_P1QB + o] + lds[CS_VU + o]); tb[s4] = ch[2048 + 256 + (4 * s4 + kg) * 16 + tl]; }
            __builtin_amdgcn_sched_barrier(0);
#pragma unroll
            for (int s4 = 0; s4 < 4; ++s4) sa = mfma4(cm[s4], tb[s4], sa);
            __builtin_amdgcn_sched_barrier(0);
        }
#pragma unroll
        for (int e = 0; e < 4; ++e) sat[(4 * kg + e) * 17 + tl] = sa[e];
        WAVE_LDS_SYNC();
        if (wave < 4) {
            float sv[4], vk[4]; const float dw = ch[5120 + 16 * wave + tl];
#pragma unroll
            for (int e = 0; e < 4; ++e) { const int o = (4 * kg + e) * 65 + 16 * wave + tl; sv[e] = lds[CS_S + o]; vk[e] = lds[CS_VK + o]; }
            f32x4 acc = cs_mm<4>(sat, 17, ch + 3072 + 16 * wave, 64, z4, tl, kg);
#pragma unroll
            for (int e = 0; e < 4; ++e) { const int o = (4 * kg + e) * 65 + 16 * wave + tl; lds[CS_S + o] = sv[e] * dw + vk[e] + acc[e]; }
        } else if (wave == 4) {
            float ad[4];
#pragma unroll
            for (int e = 0; e < 4; ++e) { const int o = (4 * kg + e) * 17 + tl; ad[e] = lds[CS_P1RA + o] + lds[CS_P1RB + o] + lds[CS_VH + o]; }
            f32x4 acc = cs_mm<4>(sat, 17, ch + 2048 + 512, 16, z4, tl, kg);
            f32x4 yv;
#pragma unroll
            for (int e = 0; e < 4; ++e) yv[e] = acc[e] + ad[e];
            *(f32x4*)(YRAW + (size_t)(row0 + c * 16 + tl) * 512 + h * 64 + vbase + 4 * kg) = yv;
        }
        if (c + 1 < 128) cs_store(lds, (c + 1) & 1, pa, tid);
        pa = pb;
        __syncthreads();
    }
    { float* so = P.out + O_WKV_P + ((((size_t)l * NB + s) * 8 + h) * 64 + vbase) * 64;
      for (int i = tid; i < 1024; i += 512) so[i] = lds[CS_S + (i >> 6) * 65 + (i & 63)]; }
    __syncthreads();
}

constexpr int C2_Q = 0, C2_R = 1280, C2_BW = 2560, C2_T = 3648, C2_GY = 3968, C2_WC = 4288, C2S = 4352;
constexpr int C2_KW = 0, C2_UB = 1088, C2_HY = 1408, C2_V = 1728, C2H = 2304;
constexpr int C2_RING = 0, C2_HIN = 3 * C2S, C2_HP = C2_HIN + 2 * C2H, C2_HPB = 3840, C2_XST = C2_HP + 2 * C2_HPB, C2_XSA = C2_XST + 4096, C2_HPY = C2_XSA + 1024, C2_END = C2_HPY + 3 * 640;
static_assert(C2_END * 4 <= 32768 + 8 * ATT_WLDS, "cscan2 LDS");
struct C2Set { f32x4 st[8]; f32x4 hi[4]; };
__device__ __forceinline__ void c2_load_state(C2Set& r, const float* CHKA, const float* CHKB, int itc, int u) {
    const float* a = CHKA + (size_t)itc * 2048 + 4 * u; const float* b = CHKB + (size_t)itc * 3136 + 4 * u;
    r.st[0] = *(const f32x4*)(a); r.st[1] = *(const f32x4*)(a + 512); r.st[2] = *(const f32x4*)(a + 1024); r.st[3] = *(const f32x4*)(a + 1536);
    r.st[4] = *(const f32x4*)(b + 1024); r.st[5] = *(const f32x4*)(b + 1536); r.st[6] = *(const f32x4*)(b + 256);
    if (u < 16) r.st[7] = *(const f32x4*)(b + 3072);
}
__device__ __forceinline__ void c2_store_state(LAS float* buf, const C2Set& r, int u) {
#pragma unroll
    for (int i2 = 0; i2 < 2; ++i2) { const int i = u + 128 * i2;
        *(LAS f32x4*)(buf + C2_Q + (i >> 2) * 20 + (i & 3) * 4) = r.st[i2]; *(LAS f32x4*)(buf + C2_R + (i >> 2) * 20 + (i & 3) * 4) = r.st[2 + i2];
        *(LAS f32x4*)(buf + C2_BW + (i >> 4) * 68 + (i & 15) * 4) = r.st[4 + i2]; }
    { const int j = u & 63; *(LAS f32x4*)(buf + (u < 64 ? C2_T : C2_GY) + (j >> 2) * 20 + (j & 3) * 4) = r.st[6]; }
    if (u < 16) *(LAS f32x4*)(buf + C2_WC + 4 * u) = r.st[7];
}
__device__ __forceinline__ void c2_load_hin(C2Set& r, const float* CHKB, const float* vsrc, int itc, int u) {
    const float* b = CHKB + (size_t)itc * 3136;
    r.hi[0] = *(const f32x4*)(b + 2048 + 4 * u); r.hi[1] = *(const f32x4*)(b + 2560 + 4 * u);
    r.hi[2] = *(const f32x4*)(b + (u < 64 ? 4 * u : 768 + 4 * (u - 64)));
    r.hi[3] = *(const f32x4*)(vsrc + (size_t)(u >> 3) * 3584 + (u & 7) * 4);
}
__device__ __forceinline__ void c2_store_hin(LAS float* buf, const C2Set& r, int u) {
#pragma unroll
    for (int i2 = 0; i2 < 2; ++i2) { const int i = u + 128 * i2; *(LAS f32x4*)(buf + C2_KW + (i >> 4) * 68 + (i & 15) * 4) = r.hi[i2]; }
    { const int j = u & 63; *(LAS f32x4*)(buf + (u < 64 ? C2_UB : C2_HY) + (j >> 2) * 20 + (j & 3) * 4) = r.hi[2]; }
    *(LAS f32x4*)(buf + C2_V + (u >> 3) * 36 + (u & 7) * 4) = r.hi[3];
}
constexpr int C2_NBAR = 131;
#define c2_meet(fl, wave, seq, lane) do { asm volatile("s_waitcnt lgkmcnt(0)" ::: "memory"); __builtin_amdgcn_s_barrier(); asm volatile("" ::: "memory"); } while (0)
template <bool DOY, bool DOP>
__device__ __forceinline__ void c2_helper_step(LAS float* lds, int cy, int cp, int g, int tl, int kg, int lane, float* yout  ) {
    const LAS float* By = lds + C2_RING + (cy % 3) * C2S;
    const LAS float* Bn = lds + C2_HIN + (cp & 1) * C2H; LAS float* HPn = lds + C2_HP + (cp & 1) * C2_HPB + g * 1920;
    float ar[16], gy[4], yh[4]; f32x4 xs[4], xa;
    float vb[4], ua[4], ha[4], ka[16];
    __builtin_amdgcn_sched_barrier(0);
    if (DOY) {
#pragma unroll
        for (int tile = 0; tile < 4; ++tile) { xs[tile] = *(const LAS f32x4*)(lds + C2_XST + (((cy & 1) * 2 + g) * 4 + tile) * 256 + lane * 4);
#pragma unroll
            for (int reg = 0; reg < 4; ++reg) ar[tile * 4 + reg] = By[C2_R + (16 * tile + 4 * kg + reg) * 20 + tl]; }
        xa = *(const LAS f32x4*)(lds + C2_XSA + ((cy & 1) * 2 + g) * 256 + lane * 4);
#pragma unroll
        for (int e = 0; e < 4; ++e) { gy[e] = By[C2_GY + (4 * kg + e) * 20 + tl]; yh[e] = lds[C2_HPY + (cy % 3) * 640 + g * 320 + (4 * kg + e) * 20 + tl]; }
    }
    if (DOP) {
#pragma unroll
        for (int e = 0; e < 4; ++e) { vb[e] = Bn[C2_V + (4 * kg + e) * 36 + 16 * g + tl]; ua[e] = Bn[C2_UB + (4 * kg + e) * 20 + tl]; ha[e] = Bn[C2_HY + (4 * kg + e) * 20 + tl]; }
#pragma unroll
        for (int tile = 0; tile < 4; ++tile)
#pragma unroll
            for (int e = 0; e < 4; ++e) ka[tile * 4 + e] = Bn[C2_KW + (4 * kg + e) * 68 + 16 * tile + tl];
    }
    __builtin_amdgcn_sched_barrier(0);
    const f32x4 z4 = (f32x4){0.f, 0.f, 0.f, 0.f};
    f32x4 y = z4, du = z4, dh = z4, dk[4] = {z4, z4, z4, z4};
    if (DOY) {
        f32x4 pr = z4;
#pragma unroll
        for (int tile = 0; tile < 4; ++tile)
#pragma unroll
            for (int reg = 0; reg < 4; ++reg) pr = mfma4(ar[tile * 4 + reg], xs[tile][reg], pr);
        y = (f32x4){pr[0] + yh[0], pr[1] + yh[1], pr[2] + yh[2], pr[3] + yh[3]};
#pragma unroll
        for (int e = 0; e < 4; ++e) y = mfma4(gy[e], xa[e], y);
    }
    if (DOP) {
#pragma unroll
        for (int e = 0; e < 4; ++e) { du = mfma4(ua[e], vb[e], du); dh = mfma4(ha[e], vb[e], dh);
#pragma unroll
            for (int tile = 0; tile < 4; ++tile) dk[tile] = mfma4(ka[tile * 4 + e], vb[e], dk[tile]); }
    }
    __builtin_amdgcn_sched_barrier(0);
    if (DOY) {
#pragma unroll
        for (int e = 0; e < 4; ++e) yout[(size_t)e * 512] = y[e];
    }
    if (DOP) {
#pragma unroll
        for (int e = 0; e < 4; ++e) { HPn[(4 * kg + e) * 20 + tl] = du[e]; lds[C2_HPY + (cp % 3) * 640 + g * 320 + (4 * kg + e) * 20 + tl] = dh[e];
#pragma unroll
            for (int tile = 0; tile < 4; ++tile) HPn[640 + (16 * tile + 4 * kg + e) * 20 + tl] = dk[tile][e]; }
    }
    __builtin_amdgcn_sched_barrier(0);
}
__device__ __forceinline__ void ph_cscan2(const Params& P, int l, int bid, int wave, int lane, LAS float* lds, volatile LAS unsigned* fl) {
    const float* RWB = (const float*)(P.ws + WS_RWB);
    const float* CHKA = (const float*)(P.ws + WS_CHKA); const float* CHKB = (const float*)(P.ws + WS_CHKB);
    float* YRAW = (float*)(P.ws + WS_YRAW);
    const int bh = (bid & 7) + 8 * (bid >> 4), half = (bid >> 3) & 1;
    const int s = bh >> 3, h = bh & 7, row0 = s * SEQ;
    const int tl = lane & 15, kg = lane >> 4;
    const int it0 = (s * 128) * 8 + h;
    if (wave >= 6) {
        const int g = wave - 6;
        c2_meet(fl, wave, 0, lane);
        c2_helper_step<false, true>(lds, 0, 0, g, tl, kg, lane, nullptr);
        c2_meet(fl, wave, 0, lane);
#pragma unroll 1
        for (int c = 0; c < 127; ++c) { c2_helper_step<false, true>(lds, 0, c + 1, g, tl, kg, lane, nullptr); c2_meet(fl, wave, 0, lane); }
        c2_meet(fl, wave, 0, lane);
        c2_meet(fl, wave, 0, lane);
    } else if (wave >= 4) {
        const int u = (wave - 4) * 64 + lane;
        const float* vsrc0 = RWB + (size_t)row0 * 3584 + 1536 + h * 64 + 32 * half;
        C2Set ra, rb, rc;
        c2_load_state(ra, CHKA, CHKB, it0, u); c2_load_hin(ra, CHKB, vsrc0, it0, u);
        c2_store_state(lds + C2_RING, ra, u); c2_store_hin(lds + C2_HIN, ra, u);
        c2_load_hin(ra, CHKB, vsrc0 + (size_t)16 * 3584, it0 + 8, u);
        c2_store_hin(lds + C2_HIN + C2H, ra, u);
        c2_load_state(ra, CHKA, CHKB, it0 + 8, u); c2_load_hin(ra, CHKB, vsrc0 + (size_t)32 * 3584, it0 + 16, u);
        c2_load_state(rb, CHKA, CHKB, it0 + 16, u); c2_load_hin(rb, CHKB, vsrc0 + (size_t)48 * 3584, it0 + 24, u);
        c2_load_state(rc, CHKA, CHKB, it0 + 24, u); c2_load_hin(rc, CHKB, vsrc0 + (size_t)64 * 3584, it0 + 32, u);
        c2_meet(fl, wave, seq++, lane);
        c2_meet(fl, wave, seq++, lane);
#define C2_STAGE(C, R) do { const int c_ = (C); \
            if (c_ + 1 < 128) c2_store_state(lds + C2_RING + ((c_ + 1) % 3) * C2S, R, u); \
            if (c_ + 2 < 128) c2_store_hin(lds + C2_HIN + (c_ & 1) * C2H, R, u); \
            WAVE_LDS_SYNC(); \
            { const int c4 = c_ + 4 < 128 ? c_ + 4 : 127, c5 = c_ + 5 < 128 ? c_ + 5 : 127; \
              c2_load_state(R, CHKA, CHKB, it0 + 8 * c4, u); c2_load_hin(R, CHKB, vsrc0 + (size_t)(16 * c5) * 3584, it0 + 8 * c5, u); } \
            c2_meet(fl, wave, seq++, lane); } while (0)
#pragma unroll 1
        for (int c = 0; c < 126; c += 3) { C2_STAGE(c, ra); C2_STAGE(c + 1, rb); C2_STAGE(c + 2, rc); }
        C2_STAGE(126, ra); C2_STAGE(127, rb);
#undef C2_STAGE
        c2_meet(fl, wave, seq++, lane);
    } else if (wave >= 2) {
        const int g = wave - 2;
        float* ycol = YRAW + (size_t)(row0 + 4 * kg) * 512 + h * 64 + 16 * (2 * half + g) + tl;
        c2_meet(fl, wave, seq++, lane);
        c2_meet(fl, wave, seq++, lane);
        c2_meet(fl, wave, seq++, lane);
#pragma unroll 1
        for (int c = 1; c < 128; ++c) {
            c2_helper_step<true, false>(lds, c - 1, 0, g, tl, kg, lane, ycol + (size_t)(c - 1) * 16 * 512);
            c2_meet(fl, wave, seq++, lane);
        }
        c2_helper_step<true, false>(lds, 127, 0, g, tl, kg, lane, ycol + (size_t)127 * 16 * 512);
        c2_meet(fl, wave, seq++, lane);
    } else {
        const int g = wave, rg = 2 * half + g;
        f32x4 ST[4];
#pragma unroll
        for (int tile = 0; tile < 4; ++tile) ST[tile] = (f32x4){0.f, 0.f, 0.f, 0.f};
        c2_meet(fl, wave, seq++, lane);
        c2_meet(fl, wave, seq++, lane);
#pragma unroll 1
        for (int c = 0; c < 128; ++c) {
            const LAS float* B = lds + C2_RING + (c % 3) * C2S; const LAS float* HP = lds + C2_HP + (c & 1) * C2_HPB + g * 1920;
            float aq[16], tm[4], xu[4], bw[16], vk[16]; f32x4 wc[4];
            __builtin_amdgcn_sched_barrier(0);
#pragma unroll
            for (int tile = 0; tile < 4; ++tile) { *(LAS f32x4*)(lds + C2_XST + (((c & 1) * 2 + g) * 4 + tile) * 256 + lane * 4) = ST[tile];
#pragma unroll
                for (int reg = 0; reg < 4; ++reg) aq[tile * 4 + reg] = B[C2_Q + (16 * tile + 4 * kg + reg) * 20 + tl]; }
#pragma unroll
            for (int e = 0; e < 4; ++e) { xu[e] = HP[(4 * kg + e) * 20 + tl]; tm[e] = B[C2_T + (4 * kg + e) * 20 + tl]; }
#pragma unroll
            for (int tile = 0; tile < 4; ++tile) { wc[tile] = *(const LAS f32x4*)(B + C2_WC + 16 * tile + 4 * kg);
#pragma unroll
                for (int e = 0; e < 4; ++e) { bw[tile * 4 + e] = B[C2_BW + (4 * kg + e) * 68 + 16 * tile + tl]; vk[tile * 4 + e] = HP[640 + (16 * tile + 4 * kg + e) * 20 + tl]; } }
            __builtin_amdgcn_sched_barrier(0);
            f32x4 pq = (f32x4){0.f, 0.f, 0.f, 0.f}, pq2 = pq;
#pragma unroll
            for (int tile = 0; tile < 4; tile += 2)
#pragma unroll
                for (int reg = 0; reg < 4; ++reg) { pq = mfma4(aq[tile * 4 + reg], ST[tile][reg], pq); pq2 = mfma4(aq[(tile + 1) * 4 + reg], ST[tile + 1][reg], pq2); }
            f32x4 sa = (f32x4){0.f, 0.f, 0.f, 0.f};
#pragma unroll
            for (int e = 0; e < 4; ++e) sa = mfma4(tm[e], -(pq[e] + pq2[e] + xu[e]), sa);
#pragma unroll
            for (int tile = 0; tile < 4; ++tile) ST[tile] = ST[tile] * wc[tile] + (f32x4){vk[tile * 4 + 0], vk[tile * 4 + 1], vk[tile * 4 + 2], vk[tile * 4 + 3]};
            __builtin_amdgcn_sched_barrier(0);
            *(LAS f32x4*)(lds + C2_XSA + ((c & 1) * 2 + g) * 256 + lane * 4) = sa;
#pragma unroll
            for (int e = 0; e < 4; ++e)
#pragma unroll
                for (int tile = 0; tile < 4; ++tile) ST[tile] = mfma4(bw[tile * 4 + e], sa[e], ST[tile]);
            __builtin_amdgcn_sched_barrier(0);
#pragma unroll
            for (int tile = 0; tile < 4; ++tile) ST[tile][0] += 0.0f;
            __builtin_amdgcn_sched_barrier(0);
            c2_meet(fl, wave, seq++, lane);
        }
        c2_meet(fl, wave, seq++, lane);
        float* so = P.out + O_WKV_P + ((((size_t)l * NB + s) * 8 + h) * 64 + 16 * rg + tl) * 64;
#pragma unroll
        for (int tile = 0; tile < 4; ++tile) *(f32x4*)(so + 16 * tile + 4 * kg) = ST[tile];
    }
}

__device__ __forceinline__ void ph_post(const Params& P, int l, int gw, int ngw, int lane) {
    const float* PROJ = (const float*)(P.ws + WS_PROJ);
    const float* RWB = (const float*)(P.ws + WS_RWB);
    const float* YRAW = (const float*)(P.ws + WS_YRAW);
    bf16* MIX = (bf16*)(P.ws + WS_MIXB);
    float* out = P.out;
    {
        const int h = gw & 7, c = h * 64 + lane;
        const float lg = P.in[24][l * 512 + c], lb = P.in[25][l * 512 + c], rk = P.in[23][(l * 8 + h) * 64 + lane];
#pragma unroll 1
        for (int item0 = gw; item0 < MT * 8; item0 += 8 * ngw) {
            float y[8], rl[8], kl[8], vl[8], gl[8]; int rr[8];
#pragma unroll
            for (int q = 0; q < 8; ++q) { const int item = item0 + q * ngw; rr[q] = (item < MT * 8) ? (item >> 3) : (item0 >> 3);
                y[q] = YRAW[(size_t)rr[q] * 512 + c]; const float* base = RWB + (size_t)rr[q] * 3584 + c;
                rl[q] = base[0]; kl[q] = base[1024]; vl[q] = base[1536]; gl[q] = base[3072]; }
#pragma unroll
            for (int q = 0; q < 8; ++q) {
                const float mean = wave_total(y[q]) * (1.f / 64.f);
                const float d = y[q] - mean;
                const float var = wave_total(d * d) * (1.f / 64.f);
                const float yn = d * rsqrtf(var + GN_EPS) * lg + lb;
                const float bonus = wave_total(rl[q] * kl[q] * rk) * vl[q];
                if (item0 + q * ngw < MT * 8) MIX[(size_t)rr[q] * D + c] = (bf16)f2bf((yn + bonus) * gl[q]);
            }
        }
    }
    {
        const bf16* OPART = (const bf16*)(P.ws + WS_OPART); const float* LSE = (const float*)(P.ws + WS_LSE);
#pragma unroll 8
        for (int item = gw; item < MP * 8; item += ngw) {
            const int r = item >> 3, h = item & 7;
            const float l0 = LSE[((size_t)0 * MP + r) * 8 + h], l1 = LSE[((size_t)1 * MP + r) * 8 + h], l2 = LSE[((size_t)2 * MP + r) * 8 + h];
            const size_t off = (size_t)r * 1024 + h * 128 + 2 * lane;
            const unsigned a0 = *(const unsigned*)(OPART + off), a1 = *(const unsigned*)(OPART + (size_t)MP * 1024 + off), a2 = *(const unsigned*)(OPART + (size_t)2 * MP * 1024 + off);
            const float mx = fmaxf(l0, fmaxf(l1, l2));
            const float w0 = expf(l0 - mx), w1 = expf(l1 - mx), w2 = expf(l2 - mx);
            const float inv = 1.0f / (w0 + w1 + w2);
            const float x = (w0 * __uint_as_float(a0 << 16) + w1 * __uint_as_float(a1 << 16) + w2 * __uint_as_float(a2 << 16)) * inv;
            const float y = (w0 * __uint_as_float(a0 & 0xffff0000u) + w1 * __uint_as_float(a1 & 0xffff0000u) + w2 * __uint_as_float(a2 & 0xffff0000u)) * inv;
            *(unsigned*)(MIX + (size_t)r * D + 1024 + h * 128 + 2 * lane) = pk2(x, y);
        }
    }
    const float* HLOC = (const float*)(P.ws + WS_HLOC); const float* CUMA = (const float*)(P.ws + WS_CUMA); const float* SUMM = (const float*)(P.ws + WS_SUMM);
    for (int item = gw; item < LRU_ITEMS; item += ngw) {
        int s, n, j, r0, nt; lru_item(item, s, n, j, r0, nt);
        const int c = n * 64 + lane;
        float H = (s >= NB) ? P.in[4][((size_t)l * DB + (s - NB)) * 512 + c] : 0.f;
        {
            float sa_[31], se_[31];
#pragma unroll
            for (int jj = 0; jj < 31; ++jj) { const bool in = jj < j; const float* sm = SUMM + (size_t)(item - j + (in ? jj : 0)) * 128; sa_[jj] = in ? sm[lane] : 1.f; se_[jj] = in ? sm[64 + lane] : 0.f; }
#pragma unroll
            for (int jj = 0; jj < 31; ++jj) H = sa_[jj] * H + se_[jj];
        }
        float hlast = 0.f;
#pragma unroll 1
        for (int t0 = 0; t0 < nt; t0 += 8) {
            float hl_[8], ca_[8], gb_[8];
#pragma unroll
            for (int q = 0; q < 8; ++q) { const int r = r0 + ((t0 + q < nt) ? t0 + q : 0);
                hl_[q] = HLOC[(size_t)r * 512 + c]; ca_[q] = CUMA[(size_t)r * 512 + c]; gb_[q] = PROJ[(size_t)r * PW + C_LG + c]; }
#pragma unroll
            for (int q = 0; q < 8; ++q) if (t0 + q < nt) {
                const float hh = hl_[q] + ca_[q] * H;
                MIX[(size_t)(r0 + t0 + q) * D + 512 + c] = (bf16)f2bf(hh * gelu_tanh(gb_[q]));
                hlast = hh;
            }
        }
        if (s < NB) { if (j == 31) out[O_LRUH_P + ((size_t)l * NB + s) * 512 + c] = hlast; }
        else out[O_LRUH_S + ((size_t)l * DB + (s - NB)) * 512 + c] = hlast;
    }
}

__device__ __forceinline__ void ph_norm2(const Params& P, int l, int gw, int ngw, int lane) {
    const float* gp = P.in[10] + (size_t)l * D; const float* gf = P.in[11] + (size_t)l * D;
    const bf16* Y1 = (const bf16*)(P.ws + WS_Y1);
    bf16* H = (bf16*)(P.ws + WS_HB);
    bf16* XH = (bf16*)(P.ws + WS_XH);
    f32x4 g1v[8], g2v[8];
#pragma unroll
    for (int j = 0; j < 8; ++j) { g1v[j] = *(const f32x4*)(gp + lane * 4 + j * 256); g2v[j] = *(const f32x4*)(gf + lane * 4 + j * 256); }
    for (int r0_ = gw; r0_ < MT; r0_ += 2 * ngw) {
#pragma unroll
      for (int q_ = 0; q_ < 2; ++q_) {
        const int r = r0_ + q_ * ngw; if (r >= MT) break;
        const float* xin = r < MP ? P.in[0] + (size_t)r * D : P.in[1] + (size_t)(r - MP) * D;
        f32x4 y[8], x[8]; float ss = 0.f;
#pragma unroll
        for (int j = 0; j < 8; ++j) { { const v2u yb = *(const v2u*)(Y1 + (size_t)r * D + lane * 4 + j * 256); y[j] = (f32x4){__uint_as_float(yb.x << 16), __uint_as_float(yb.x & 0xffff0000u), __uint_as_float(yb.y << 16), __uint_as_float(yb.y & 0xffff0000u)}; } if (l == 0) x[j] = *(const f32x4*)(xin + lane * 4 + j * 256);
            else { const v2u xb = *(const v2u*)(XH + (size_t)r * D + lane * 4 + j * 256); x[j] = (f32x4){__uint_as_float(xb.x << 16), __uint_as_float(xb.x & 0xffff0000u), __uint_as_float(xb.y << 16), __uint_as_float(xb.y & 0xffff0000u)}; }
            ss += y[j].x * y[j].x + y[j].y * y[j].y + y[j].z * y[j].z + y[j].w * y[j].w; }
        ss = wave_sum(ss);
        const float rs = rsqrtf(ss * (1.f / D) + RMS_EPS);
        float s2 = 0.f;
#pragma unroll
        for (int j = 0; j < 8; ++j) { const f32x4 g = g1v[j]; x[j] = x[j] + y[j] * rs * g;
            s2 += x[j].x * x[j].x + x[j].y * x[j].y + x[j].z * x[j].z + x[j].w * x[j].w;
            *(v2u*)(XH + (size_t)r * D + lane * 4 + j * 256) = (v2u){pk2(x[j].x, x[j].y), pk2(x[j].z, x[j].w)}; }
        s2 = wave_sum(s2);
        const float rs2 = rsqrtf(s2 * (1.f / D) + RMS_EPS);
#pragma unroll
        for (int j = 0; j < 8; ++j) { const f32x4 g = g2v[j]; const f32x4 o = x[j] * rs2 * g;
            *(v2u*)(H + (size_t)r * D + lane * 4 + j * 256) = (v2u){pk2(o.x, o.y), pk2(o.z, o.w)}; }
      }
    }
}
__device__ __forceinline__ void ph_norm3(const Params& P, int l, int gw, int ngw, int lane) {
    const float* gp = P.in[12] + (size_t)l * D;
    const bf16* Y1 = (const bf16*)(P.ws + WS_Y1);
    bf16* H = (bf16*)(P.ws + WS_HB);
    float* X = P.out; bf16* XH = (bf16*)(P.ws + WS_XH);
    const float* gn = P.in[9] + (size_t)(l + 1 < DEPTH ? l + 1 : l) * D;
    f32x4 g1v[8], g2v[8];
#pragma unroll
    for (int j = 0; j < 8; ++j) { g1v[j] = *(const f32x4*)(gp + lane * 4 + j * 256); g2v[j] = *(const f32x4*)(gn + lane * 4 + j * 256); }
    for (int r0_ = gw; r0_ < MT; r0_ += 2 * ngw) {
#pragma unroll
      for (int q_ = 0; q_ < 2; ++q_) {
        const int r = r0_ + q_ * ngw; if (r >= MT) break;
        f32x4 y[8], x[8]; float ss = 0.f;
#pragma unroll
        for (int j = 0; j < 8; ++j) { { const v2u yb = *(const v2u*)(Y1 + (size_t)r * D + lane * 4 + j * 256); y[j] = (f32x4){__uint_as_float(yb.x << 16), __uint_as_float(yb.x & 0xffff0000u), __uint_as_float(yb.y << 16), __uint_as_float(yb.y & 0xffff0000u)}; } { const v2u xb = *(const v2u*)(XH + (size_t)r * D + lane * 4 + j * 256); x[j] = (f32x4){__uint_as_float(xb.x << 16), __uint_as_float(xb.x & 0xffff0000u), __uint_as_float(xb.y << 16), __uint_as_float(xb.y & 0xffff0000u)}; }
            ss += y[j].x * y[j].x + y[j].y * y[j].y + y[j].z * y[j].z + y[j].w * y[j].w; }
        ss = wave_sum(ss);
        const float rs = rsqrtf(ss * (1.f / D) + RMS_EPS);
        float s2 = 0.f;
#pragma unroll
        for (int j = 0; j < 8; ++j) { const f32x4 g = g1v[j]; x[j] = x[j] + y[j] * rs * g;
            s2 += x[j].x * x[j].x + x[j].y * x[j].y + x[j].z * x[j].z + x[j].w * x[j].w;
            if (l + 1 < DEPTH) *(v2u*)(XH + (size_t)r * D + lane * 4 + j * 256) = (v2u){pk2(x[j].x, x[j].y), pk2(x[j].z, x[j].w)};
            else *(f32x4*)(X + (size_t)r * D + lane * 4 + j * 256) = x[j]; }
        if (l + 1 < DEPTH) {
            s2 = wave_sum(s2);
            const float rs2 = rsqrtf(s2 * (1.f / D) + RMS_EPS);
#pragma unroll
            for (int j = 0; j < 8; ++j) { const f32x4 g = g2v[j]; const f32x4 o = x[j] * rs2 * g;
                *(v2u*)(H + (size_t)r * D + lane * 4 + j * 256) = (v2u){pk2(o.x, o.y), pk2(o.z, o.w)}; }
        }
      }
    }
}

constexpr int NPHASE = 1 + 10 * DEPTH;
__global__ void __launch_bounds__(NWAVES * 64, 2) mega_fwd(Params P) {
    extern __shared__ __attribute__((aligned(16))) unsigned char lds_raw[];
    LAS unsigned char* lds = (LAS unsigned char*)lds_raw;
    LAS float* ldsf = (LAS float*)lds;
    volatile LAS unsigned* MISC = (volatile LAS unsigned*)(lds + MISC_OFF);
    const int tid = threadIdx.x, lane = tid & 63, wave = __builtin_amdgcn_readfirstlane(tid >> 6);
    const int bid = blockIdx.x, nb = gridDim.x;
    const int gw = bid * NWAVES + wave, ngw = nb * NWAVES;
    for (int u = tid; u < 64; u += NWAVES * 64) ((LAS unsigned*)(lds + MISC_OFF))[u] = 0u;
    __syncthreads();
    XcdBarrier bar; bar.bar = (unsigned*)(P.ws + WS_CTL) + CW_BAR; bar.x = 0; bar.st = nullptr;
    const bool multi = (P.ph_hi - P.ph_lo) > 1;
    if (multi) bar = xcd_barrier_post((unsigned*)(P.ws + WS_CTL) + CW_BAR, MISC + 8);
    bf16* HB = (bf16*)(P.ws + WS_HB); bf16* MIXB = (bf16*)(P.ws + WS_MIXB); bf16* Y1B = (bf16*)(P.ws + WS_Y1);
    float* PROJ = (float*)(P.ws + WS_PROJ); bf16* UB = (bf16*)(P.ws + WS_UB);
    for (int ph = P.ph_lo; ph < P.ph_hi; ++ph) {
        int lane_v = lane, tid_v = tid;
        asm volatile("" : "+v"(lane_v), "+v"(tid_v));
        if (ph == 0) { ph_weights(P, gw, ngw, wave, lane_v, ldsf); ph_norm1(P, gw, ngw, lane_v); }
        else {
            const int l = (ph - 1) / 10, sub = (ph - 1) % 10;
            const int subop = sub < 2 ? sub : (sub == 2 ? 9 : sub - 1);
            switch (subop) {
                case 0: { pg8::Gemm g{HB, (const bf16*)(P.ws + WS_WIN) + (size_t)l * NIN * D, MP, NIN, D}; pg8::StaticOrder S; S.init(MP, NIN, nb, bid);
                          pg8::EpiIn E{PROJ, (bf16*)(P.ws + WS_QKVB), P.out + O_K_P + (size_t)l * MP * 1024, P.out + O_K_S + (size_t)l * MS * 1024, P.out + O_V_P + (size_t)l * MP * 1024, P.out + O_V_S + (size_t)l * MS * 1024, MP, MT};
                          pg8::gemm_phase<pg8::EpiIn, pg8::StaticOrder, true, true>(lds, g, S, E, tid_v);
                          if (bid >= 224) { SEpiIn SE{PROJ, (bf16*)(P.ws + WS_QKVB), P.out + O_K_S + (size_t)l * MS * 1024, P.out + O_V_S + (size_t)l * MS * 1024};
                              gemm_small(HB + (size_t)MP * D, (const bf16*)(P.ws + WS_WIN) + (size_t)l * NIN * D, NIN, D, bid - 224, 32, tid_v, wave, lane_v, ldsf, SE); } } break;
                case 1: ph_post_in(P, l, bid, nb, tid_v, ldsf); break;
                case 9: ph_chunkpre(P, l, gw, ngw, wave, lane_v, ldsf); break;
                case 2: if (bid < 64) { __builtin_amdgcn_s_setprio(3); ph_cscan2(P, l, bid, wave, lane_v, ldsf, MISC + 20); __builtin_amdgcn_s_setprio(0); }
                        else if (bid >= 128 && wave < 2) ph_scan2(P, l, NB * 64 + (bid - 128), 128, tid_v, wave, lane_v, ldsf, MISC + 16);
                        asm volatile("" : "+v"(lane_v));
                        ph_mix(P, l, bid, nb, wave, lane_v, ldsf);
                        break;
                case 3: ph_post(P, l, gw, ngw, lane_v); break;
                case 4: { pg8::Gemm g{MIXB, (const bf16*)(P.ws + WS_WOUT) + (size_t)l * D * D, MP, D, D}; pg8::StaticOrder S; S.init(MP, D, nb, bid);
                          pg8::EpiBf16T<false> E{Y1B, D}; pg8::gemm_phase<pg8::EpiBf16T<false>, pg8::StaticOrder, true, true>(lds, g, S, E, tid_v);
                          SEpiBf16 SE{Y1B, D}; gemm_small(MIXB + (size_t)MP * D, (const bf16*)(P.ws + WS_WOUT) + (size_t)l * D * D, D, D, bid, nb, tid_v, wave, lane_v, ldsf, SE); } break;
                case 5: ph_norm2(P, l, gw, ngw, lane_v); break;
                case 6: { pg8::Gemm g{HB, (const bf16*)(P.ws + WS_W1) + (size_t)l * DFF * D, MP, DFF, D}; pg8::StaticOrder S; S.init(MP, DFF, nb, bid);
                          pg8::EpiBf16T<true> E{UB, DFF}; pg8::gemm_phase<pg8::EpiBf16T<true>, pg8::StaticOrder, true, true>(lds, g, S, E, tid_v);
                          SEpiRelu2 SE{UB, DFF}; gemm_small(HB + (size_t)MP * D, (const bf16*)(P.ws + WS_W1) + (size_t)l * DFF * D, DFF, D, bid, nb, tid_v, wave, lane_v, ldsf, SE); } break;
                case 7: { pg8::Gemm g{UB, (const bf16*)(P.ws + WS_W2) + (size_t)l * D * DFF, MP, D, DFF}; pg8::StaticOrder S; S.init(MP, D, nb, bid);
                          pg8::EpiBf16T<false> E{Y1B, D}; pg8::gemm_phase<pg8::EpiBf16T<false>, pg8::StaticOrder, true, true>(lds, g, S, E, tid_v);
                          SEpiBf16 SE{Y1B, D}; gemm_small(UB + (size_t)MP * DFF, (const bf16*)(P.ws + WS_W2) + (size_t)l * D * DFF, D, DFF, bid, nb, tid_v, wave, lane_v, ldsf, SE); } break;
                case 8: ph_norm3(P, l, gw, ngw, lane_v); break;
            }
        }
        if (ph + 1 < P.ph_hi) xcd_barrier(bar);
    }
}

extern "C" void kernel_launch(void* const* d_in, const int* in_sizes, int n_in, void* d_out, int out_size, void* d_ws, size_t ws_size, hipStream_t stream) {
    static int grid = 0;
    if (grid == 0) {
        if (n_in != 35 || (size_t)out_size != O_END || ws_size < WS_END) {
            fprintf(stderr, "kernel_launch: unexpected shapes: n_in %d out %d ws %zu (need %zu)\n", n_in, out_size, ws_size, (size_t)WS_END); grid = -1; return; }
        int dev = 0, cus = 0, per_cu = 0;
        if (hipGetDevice(&dev) != hipSuccess || hipDeviceGetAttribute(&cus, hipDeviceAttributeMultiprocessorCount, dev) != hipSuccess) { grid = -1; return; }
        if (hipFuncSetAttribute((const void*)mega_fwd, hipFuncAttributeMaxDynamicSharedMemorySize, LDS_BYTES) != hipSuccess) { fprintf(stderr, "kernel_launch: hipFuncSetAttribute failed\n"); grid = -1; return; }
        if (hipOccupancyMaxActiveBlocksPerMultiprocessor(&per_cu, (const void*)mega_fwd, NWAVES * 64, LDS_BYTES) != hipSuccess || per_cu < 1) { fprintf(stderr, "kernel_launch: occupancy query says %d\n", per_cu); per_cu = 1; }
        (void)hipGetLastError();
        grid = cus;
    }
    if (grid < 0) return;
    (void)hipMemsetAsync((char*)d_ws + WS_CTL, 0, CTL_ZERO_BYTES, stream);
    Params p{};
    for (int i = 0; i < 35; ++i) p.in[i] = (const float*)d_in[i];
    p.out = (float*)d_out; p.ws = (unsigned char*)d_ws;
#if MK_MULTI
    for (int ph = 0; ph < NPHASE; ++ph) { p.ph_lo = ph; p.ph_hi = ph + 1; hipLaunchKernelGGL(mega_fwd, dim3(grid), dim3(NWAVES * 64), LDS_BYTES, stream, p); }
#else
    p.ph_lo = 0; p.ph_hi = NPHASE;
    hipLaunchKernelGGL(mega_fwd, dim3(grid), dim3(NWAVES * 64), LDS_BYTES, stream, p);
#endif
}
```

```cpp
#include <hip/hip_runtime.h>
#include <cstdio>
#include <cstdint>

#ifndef MK_MULTI
#define MK_MULTI 0
#endif

constexpr int D = 2048, NB = 4, SEQ = 2048, DEPTH = 2, DB = 8, DS = 4;
constexpr int MP = NB * SEQ, MS = DB * DS, MT = MP + MS, MT_PAD = 8448;
constexpr int RWW = 512, RPROJ = 1792;
constexpr int NIN = 5888, DFF = 8192;
constexpr int C_LX = 1792, C_LG = 2304, C_Q = 2816, C_K = 3840, C_V = 4864;
constexpr int NSEQ = NB + DB;
constexpr int CACHE_W = 2048;
constexpr float RMS_EPS = 1e-6f, GN_EPS = 64e-5f;
constexpr float ATT_SCALE = 0.08838834764831845f;

constexpr size_t O_Y = 0;
constexpr size_t O_WKV_P = (size_t)MT * D;
constexpr size_t O_WKV_S = O_WKV_P + (size_t)DEPTH * NB * 8 * 64 * 64;
constexpr size_t O_SHIFT_P = O_WKV_S + (size_t)DEPTH * DB * 8 * 64 * 64;
constexpr size_t O_SHIFT_S = O_SHIFT_P + (size_t)DEPTH * NB * RPROJ;
constexpr size_t O_LRUH_P = O_SHIFT_S + (size_t)DEPTH * DB * RPROJ;
constexpr size_t O_LRUH_S = O_LRUH_P + (size_t)DEPTH * NB * 512;
constexpr size_t O_CONV_P = O_LRUH_S + (size_t)DEPTH * DB * 512;
constexpr size_t O_CONV_S = O_CONV_P + (size_t)DEPTH * NB * 3 * 512;
constexpr size_t O_K_P = O_CONV_S + (size_t)DEPTH * DB * 3 * 512;
constexpr size_t O_K_S = O_K_P + (size_t)DEPTH * MP * 1024;
constexpr size_t O_V_P = O_K_S + (size_t)DEPTH * MS * 1024;
constexpr size_t O_V_S = O_V_P + (size_t)DEPTH * MP * 1024;
constexpr size_t O_END = O_V_S + (size_t)DEPTH * MS * 1024;
static_assert(O_END == 51406848, "output size");

constexpr size_t MiB = 1u << 20;
constexpr size_t WS_CTL = 0, CTL_ZERO_BYTES = 1 * MiB;
constexpr size_t WS_WIN = 2 * MiB;
constexpr size_t WS_WOUT = 48 * MiB;
constexpr size_t WS_W1 = 64 * MiB;
constexpr size_t WS_W2 = 128 * MiB;
constexpr size_t WS_HB = 192 * MiB;
constexpr size_t WS_MIXB = 225 * MiB;
constexpr size_t WS_Y1 = 258 * MiB;
constexpr int PW = 2816;
constexpr size_t WS_QKVB = WS_Y1;
constexpr size_t WS_LSE = WS_Y1 + 51 * MiB;
constexpr size_t WS_SUMM = WS_Y1 + 53 * MiB;
constexpr size_t WS_PROJ = 324 * MiB;
constexpr size_t WS_OPART = 415 * MiB;
constexpr size_t WS_UB = WS_PROJ;
constexpr size_t WS_RWB = 464 * MiB;
constexpr size_t WS_YRAW = 577 * MiB;
constexpr size_t WS_HLOC = 594 * MiB;
constexpr size_t WS_CUMA = 611 * MiB;
constexpr size_t WS_CHKA = WS_HB;
constexpr size_t WS_CHKB = 628 * MiB;
constexpr size_t WS_XH = 678 * MiB;
constexpr size_t WS_END = 712 * MiB;
static_assert((size_t)NB * 128 * 8 * 2048 * 4 <= (size_t)MP * D * 2 && (size_t)NB * 128 * 8 * 3136 * 4 <= WS_END - WS_CHKB, "chunk matrices");
static_assert((size_t)MT_PAD * DFF * 2 <= WS_RWB - WS_UB, "U overlay");
static_assert((size_t)DEPTH * NIN * D * 2 <= WS_WOUT - WS_WIN && (size_t)MT_PAD * D * 2 <= WS_MIXB - WS_HB && (size_t)MT_PAD * PW * 4 <= WS_OPART - WS_PROJ && (size_t)3 * MP * 1024 * 2 <= WS_RWB - WS_OPART &&
              (size_t)MT * 3584 * 4 <= WS_YRAW - WS_RWB && (size_t)MT * 512 * 4 <= WS_HLOC - WS_YRAW && (size_t)MT_PAD * 3072 * 2 <= 51 * MiB && WS_SUMM + 1088 * 512 <= WS_PROJ, "ws map");

constexpr int CW_BAR = 4096;

constexpr int NWAVES = 8;
constexpr int LDS_BYTES = 147456;
constexpr int MISC_OFF = 147456 - 512;

#define GAS __attribute__((address_space(1)))
#define LAS __attribute__((address_space(3)))
typedef float f32x4 __attribute__((ext_vector_type(4)));
typedef float f32x2 __attribute__((ext_vector_type(2)));
typedef GAS unsigned gu32;

#define XB_TMO      128
#define XB_XCNT(j)  (256  + 64 * (j))
#define XB_XSUB(j)  (1280 + 64 * (j))
#define XB_XGEN(j)  (2304 + 64 * (j))
#define XB_TOP      3328
#define XB_TOPGEN   3392
#define XCD_BAR_WORDS 3456
#define XB_SPIN_CAP (1u << 22)

__device__ __forceinline__ unsigned xb_ld(unsigned* p)              { return __hip_atomic_load(p, __ATOMIC_RELAXED, __HIP_MEMORY_SCOPE_AGENT); }
__device__ __forceinline__ unsigned xb_add(unsigned* p, unsigned v) { return __hip_atomic_fetch_add(p, v, __ATOMIC_RELAXED, __HIP_MEMORY_SCOPE_AGENT); }
__device__ __forceinline__ unsigned xb_xcc_id() { return (unsigned)__builtin_amdgcn_s_getreg((3 << 11) | 20) & 0xFu; }
#define XB_SPIN(cond, bar) do { unsigned _sp = 0; while (cond) { __builtin_amdgcn_s_sleep(1); \
    if ((++_sp & 255u) == 0u) { if (xb_ld(&(bar)[XB_TMO])) break; if (_sp > XB_SPIN_CAP) { atomicAdd(&(bar)[XB_TMO], 1u); break; } } } } while (0)

struct XcdBarrier { unsigned* bar; unsigned x; volatile LAS unsigned* st; };

__device__ __forceinline__ XcdBarrier xcd_barrier_post(unsigned* bar, volatile LAS unsigned* st) {
    XcdBarrier b; b.bar = bar; b.x = xb_xcc_id(); b.st = st;
    if (threadIdx.x == 0) (void)xb_add(&bar[XB_XCNT(b.x)], 1u);
    return b;
}
__device__ __forceinline__ void xcd_barrier_complete(unsigned* bar, unsigned x, unsigned& nloc, unsigned& nx) {
    const unsigned G = gridDim.x * gridDim.y * gridDim.z;
    unsigned sum, cnt, mine, sp = 0u;
    for (;;) {
        sum = 0u; cnt = 0u; mine = 0u;
#pragma unroll
        for (unsigned j = 0; j < 16; ++j) { const unsigned c = xb_ld(&bar[XB_XCNT(j)]); sum += c; cnt += (c > 0u) ? 1u : 0u; mine = (j == x) ? c : mine; }
        if (sum == G) break;
        __builtin_amdgcn_s_sleep(1);
        if ((++sp & 255u) == 0u) { if (xb_ld(&bar[XB_TMO])) break; if (sp > XB_SPIN_CAP) { atomicAdd(&bar[XB_TMO], 1u); break; } }
    }
    nloc = mine > 0u ? mine : 1u; nx = cnt > 0u ? cnt : 1u;
}
__device__ __forceinline__ void xcd_barrier(const XcdBarrier& b) {
    asm volatile("s_waitcnt vmcnt(0)" ::: "memory");
    __syncthreads();
    if (threadIdx.x == 0) {
        unsigned* bar = b.bar;
        __builtin_amdgcn_s_waitcnt(0);
        unsigned nloc = b.st[0], nx = b.st[1];
        if (nloc == 0u) { xcd_barrier_complete(bar, b.x, nloc, nx); b.st[0] = nloc; b.st[1] = nx; }
        const unsigned old = xb_add(&bar[XB_XSUB(b.x)], 1u);
        const unsigned gen = old / nloc;
        if (old + 1u == (gen + 1u) * nloc) {
            __builtin_amdgcn_fence(__ATOMIC_RELEASE, "agent");
            asm volatile("s_waitcnt vmcnt(0)" ::: "memory");
            const unsigned og = xb_add(&bar[XB_TOP], 1u);
            const unsigned tg = og / nx;
            if (og + 1u == (tg + 1u) * nx) xb_add(&bar[XB_TOPGEN], 1u);
            else XB_SPIN(xb_ld(&bar[XB_TOPGEN]) == tg, bar);
            __builtin_amdgcn_fence(__ATOMIC_ACQUIRE, "agent");
            xb_add(&bar[XB_XGEN(b.x)], 1u);
            asm volatile("s_waitcnt vmcnt(0)" ::: "memory");
        } else {
            XB_SPIN(xb_ld(&bar[XB_XGEN(b.x)]) == gen, bar);
            __builtin_amdgcn_fence(__ATOMIC_ACQUIRE, "agent");
            asm volatile("s_waitcnt vmcnt(0)" ::: "memory");
        }
    }
    __syncthreads();
}

struct Params { const float* in[35]; float* out; unsigned char* ws; int ph_lo, ph_hi; };

__device__ __forceinline__ float wave_sum(float v) {
#pragma unroll
    for (int o = 1; o < 64; o <<= 1) v += __shfl_xor(v, o);
    return v;
}
__device__ __forceinline__ float wave_max(float v) {
#pragma unroll
    for (int o = 1; o < 64; o <<= 1) v = fmaxf(v, __shfl_xor(v, o));
    return v;
}
__device__ __forceinline__ float rdl(float x, int k) { return __int_as_float(__builtin_amdgcn_readlane(__float_as_int(x), k)); }
__device__ __forceinline__ float sigmoidf_(float x) { return 1.0f / (1.0f + expf(-x)); }
__device__ __forceinline__ float softplusf_(float x) { return fmaxf(x, 0.f) + log1pf(expf(-fabsf(x))); }
__device__ __forceinline__ float fexp_(float x) { return __builtin_amdgcn_exp2f(x * 1.4426950408889634f); }
__device__ __forceinline__ float fsigmoid_(float x) { return __builtin_amdgcn_rcpf(1.0f + fexp_(-x)); }
__device__ __forceinline__ float ftanh_(float x) { return 1.0f - 2.0f * __builtin_amdgcn_rcpf(1.0f + fexp_(2.0f * x)); }
__device__ __forceinline__ float fsoftplus_(float x) { return fmaxf(x, 0.f) + __builtin_amdgcn_logf(1.0f + fexp_(-fabsf(x))) * 0.6931471805599453f; }
__device__ __forceinline__ float gelu_tanh(float x) { return 0.5f * x * (1.0f + ftanh_(0.7978845608028654f * (x + 0.044715f * x * x * x))); }
#define WAVE_LDS_SYNC() asm volatile("s_waitcnt lgkmcnt(0)" ::: "memory")

__device__ __forceinline__ void seq_of(int s, int& row0, int& T) { if (s < NB) { row0 = s * SEQ; T = SEQ; } else { row0 = MP + (s - NB) * DS; T = DS; } }
__device__ __forceinline__ void row_to_seq(int r, int& s, int& t) { if (r < MP) { s = r >> 11; t = r & (SEQ - 1); } else { s = NB + ((r - MP) >> 2); t = (r - MP) & 3; } }

namespace pg8 {
#define PG8_LAS __attribute__((address_space(3)))
typedef unsigned short bf16_t;
typedef short bf16x8 __attribute__((ext_vector_type(8)));
typedef float f32x4 __attribute__((ext_vector_type(4)));
typedef unsigned u32x4 __attribute__((ext_vector_type(4)));
constexpr int BM = 256, BK = 64, HALF = 128, HTB = HALF * BK * 2  , STAGE_BYTES = 8 * HTB, NXCD = 8, WGM = 8;

__host__ __device__ __forceinline__ int lds_byte(int r, int c) { const int st = (r >> 4) * 2 + (c >> 5), rr = r & 15, cc = c & 31, ob = rr * 64 + cc * 2; return st * 1024 + (ob ^ (((ob >> 9) & 1) << 5)); }
__host__ __device__ __forceinline__ void stage_rc(int b, int& R, int& C) { const int st = b / 1024, sb = b % 1024, swz = sb ^ (((sb >> 9) & 1) << 5); R = (st >> 1) * 16 + swz / 64; C = (st & 1) * 32 + (swz % 64) / 2; }
__host__ __device__ __forceinline__ int perm32(int rho) { const int n = rho >> 4, i = rho & 15; return 8 * (i >> 2) + 4 * n + (i & 3); }

struct Unit { int pm, pn; };
struct Gemm { const bf16_t* A; const bf16_t* Bt; int M, N, K; };

struct StaticOrder {
    int nM, nN, nwg, G, c;
    __host__ __device__ void init(int M, int N, int G_, int c_) { nM = M / BM; nN = N / BM; nwg = nM * nN; G = G_; c = c_; }
    __host__ __device__ bool next(int i, Unit& u) const {
        const long L = (long)i * G + c; if (L >= nwg) return false;
        int wgid = (int)L; { const int q = nwg / NXCD, r = nwg % NXCD, xcd = wgid % NXCD, off = wgid / NXCD; wgid = (xcd < r ? xcd * (q + 1) : r * (q + 1) + (xcd - r) * q) + off; }
        const int nig = WGM * nN, gid = wgid / nig, fm = gid * WGM, gsz = (nM - fm) < WGM ? (nM - fm) : WGM;
        u.pm = fm + ((wgid % nig) % gsz); u.pn = (wgid % nig) / gsz; return true;
    }
    __device__ __forceinline__ void a_ready(const Unit&) const {}
    __device__ __forceinline__ void done(const Unit&) const {}
};
__device__ __forceinline__ unsigned cvt_pk_bf16(float lo, float hi) { unsigned r; asm volatile("v_cvt_pk_bf16_f32 %0, %1, %2" : "=v"(r) : "v"(lo), "v"(hi)); return r; }
typedef float f32x2 __attribute__((ext_vector_type(2)));

struct EpiF32 {
    static constexpr bool PERM = false, AFTER_DRAIN = false;
    float* C; int ldc;
    __device__ __forceinline__ void operator()(const f32x4 (&acc)[2][2][4][2], const Unit& u, int wr, int wc, int fr, int fq) const {
        const int row0 = u.pm * BM + wr * 64 + fr, col0 = u.pn * BM + wc * 32 + 4 * fq;
#pragma unroll
        for (int ai = 0; ai < 2; ++ai)
#pragma unroll
            for (int m = 0; m < 4; ++m) { float* rowp = C + (size_t)(row0 + ai * HALF + m * 16) * ldc + col0;
#pragma unroll
                for (int bj = 0; bj < 2; ++bj)
#pragma unroll
                    for (int n = 0; n < 2; ++n) *(f32x4*)(rowp + bj * HALF + n * 16) = acc[ai][bj][m][n]; }
    }
};
struct EpiF32P {
    static constexpr bool PERM = true, AFTER_DRAIN = false;
    float* C; int ldc;
    __device__ __forceinline__ void operator()(const f32x4 (&acc)[2][2][4][2], const Unit& u, int wr, int wc, int fr, int fq) const {
        const int row0 = u.pm * BM + wr * 64 + fr, col0 = u.pn * BM + wc * 32 + 8 * fq;
#pragma unroll
        for (int ai = 0; ai < 2; ++ai)
#pragma unroll
            for (int m = 0; m < 4; ++m) { float* rowp = C + (size_t)(row0 + ai * HALF + m * 16) * ldc + col0;
#pragma unroll
                for (int bj = 0; bj < 2; ++bj)
#pragma unroll
                    for (int n = 0; n < 2; ++n) *(f32x4*)(rowp + bj * HALF + n * 4) = acc[ai][bj][m][n]; }
    }
};
struct EpiIn {
    static constexpr bool PERM = true, AFTER_DRAIN = false;
    float* C; bf16_t* QKV; float* kp; float* ks; float* vp; float* vs; int mp, mt;
    __device__ __forceinline__ void operator()(const f32x4 (&acc)[2][2][4][2], const Unit& u, int wr, int wc, int fr, int fq) const {
        const int row0 = u.pm * BM + wr * 64 + fr;
        if (u.pn < 11) {
            const int col0 = u.pn * BM + wc * 32 + 8 * fq;
#pragma unroll
            for (int ai = 0; ai < 2; ++ai)
#pragma unroll
                for (int m = 0; m < 4; ++m) { float* rowp = C + (size_t)(row0 + ai * HALF + m * 16) * 2816 + col0;
#pragma unroll
                    for (int bj = 0; bj < 2; ++bj)
#pragma unroll
                        for (int n = 0; n < 2; ++n) *(f32x4*)(rowp + bj * HALF + n * 4) = acc[ai][bj][m][n]; }
        } else {
            const int colq = (u.pn - 11) * BM + wc * 32 + 8 * fq;
            const int sect = colq >> 10, cc = colq & 1023;
#pragma unroll
            for (int ai = 0; ai < 2; ++ai)
#pragma unroll
                for (int m = 0; m < 4; ++m) { const int row = row0 + ai * HALF + m * 16; bf16_t* rowp = QKV + (size_t)row * 3072 + colq;
                    float* fo = nullptr;
                    if (sect == 1) fo = row < mp ? kp + (size_t)row * 1024 + cc : (row < mt ? ks + (size_t)(row - mp) * 1024 + cc : nullptr);
                    if (sect == 2) fo = row < mp ? vp + (size_t)row * 1024 + cc : (row < mt ? vs + (size_t)(row - mp) * 1024 + cc : nullptr);
#pragma unroll
                    for (int bj = 0; bj < 2; ++bj) { const f32x4 v0 = acc[ai][bj][m][0], v1 = acc[ai][bj][m][1];
                        u32x4 w; w.x = cvt_pk_bf16(v0[0], v0[1]); w.y = cvt_pk_bf16(v0[2], v0[3]); w.z = cvt_pk_bf16(v1[0], v1[1]); w.w = cvt_pk_bf16(v1[2], v1[3]);
                        *(u32x4*)(rowp + bj * HALF) = w;
                        if (fo) { *(f32x4*)(fo + bj * HALF) = v0; *(f32x4*)(fo + bj * HALF + 4) = v1; } } }
        }
    }
};
template <bool RELU2> struct EpiBf16T {
    static constexpr bool PERM = true, AFTER_DRAIN = false;
    bf16_t* O; int ldc;
    __device__ __forceinline__ void operator()(const f32x4 (&acc)[2][2][4][2], const Unit& u, int wr, int wc, int fr, int fq) const {
        const int row0 = u.pm * BM + wr * 64 + fr, col0 = u.pn * BM + wc * 32 + 8 * fq;
#pragma unroll
        for (int ai = 0; ai < 2; ++ai)
#pragma unroll
            for (int m = 0; m < 4; ++m) { bf16_t* rowp = O + (size_t)(row0 + ai * HALF + m * 16) * ldc + col0;
#pragma unroll
                for (int bj = 0; bj < 2; ++bj) { f32x4 v0 = acc[ai][bj][m][0], v1 = acc[ai][bj][m][1];
                    if (RELU2) { v0 = __builtin_elementwise_max(v0, (f32x4){0.f, 0.f, 0.f, 0.f}); v1 = __builtin_elementwise_max(v1, (f32x4){0.f, 0.f, 0.f, 0.f}); v0 = v0 * v0; v1 = v1 * v1; }
                    u32x4 w; w.x = cvt_pk_bf16(v0[0], v0[1]); w.y = cvt_pk_bf16(v0[2], v0[3]); w.z = cvt_pk_bf16(v1[0], v1[1]); w.w = cvt_pk_bf16(v1[2], v1[3]);
                    *(u32x4*)(rowp + bj * HALF) = w; } }
    }
};

template <class Epi, class Sched, bool ALIGN_EPI = false, bool SP2 = false>
__device__ __forceinline__ void gemm_phase(PG8_LAS unsigned char* lds, const Gemm g, const Sched& S, const Epi& E, const int tid) {
    const int wid = __builtin_amdgcn_readfirstlane(tid >> 6), lane = tid & 63, wr = wid >> 2, wc = wid & 3, fr = lane & 15, fq = lane >> 4;
    const int K = g.K, nt = K / BK;
    unsigned voffA[2], voffB[2];
#pragma unroll
    for (int i = 0; i < 2; ++i) { int R, C; stage_rc(tid * 16 + i * 8192, R, C); const int Rb = Epi::PERM ? ((R & ~31) + perm32(R & 31)) : R;
        voffA[i] = (unsigned)(R * K + C) * 2u; voffB[i] = (unsigned)(Rb * K + C) * 2u; }
    const size_t kstep = (size_t)(BK * 2);
    const size_t hstep = (size_t)HALF * K * 2;
    const size_t tstep = 2 * hstep;
    const unsigned ldsw = (unsigned)wid * 1024u;
    const int aoff = lds_byte(wr * 64 + fr, fq * 8), boff = lds_byte(wc * 32 + fr, fq * 8);
#define PG8_SA(b, h) (((b) * 2 + (h)) * HTB)
#define PG8_SB(b, h) ((4 + (b) * 2 + (h)) * HTB)
#define PG8_STAGE(bufoff, gbase, voff) do { _Pragma("unroll") for (int _i = 0; _i < 2; ++_i) \
        __builtin_amdgcn_global_load_lds((const unsigned*)((const char*)(gbase) + (voff)[_i]), (PG8_LAS unsigned*)(lds + (bufoff) + ldsw + _i * 8192), 16, 0, 0); } while (0)
#define PG8_LDA(dst, b, h) do { _Pragma("unroll") for (int m = 0; m < 4; ++m) _Pragma("unroll") for (int k = 0; k < 2; ++k) dst[m][k] = *(const PG8_LAS bf16x8*)(lds + PG8_SA(b, h) + aoff + m * 2048 + k * 1024); } while (0)
#define PG8_LDB(dst, b, h) do { _Pragma("unroll") for (int n = 0; n < 2; ++n) _Pragma("unroll") for (int k = 0; k < 2; ++k) dst[n][k] = *(const PG8_LAS bf16x8*)(lds + PG8_SB(b, h) + boff + n * 2048 + k * 1024); } while (0)
#define PG8_MMA(ai, bj, At, Bt) do { __builtin_amdgcn_s_setprio(1); _Pragma("unroll") for (int m = 0; m < 4; ++m) _Pragma("unroll") for (int n = 0; n < 2; ++n) _Pragma("unroll") for (int k = 0; k < 2; ++k) \
        acc[ai][bj][m][n] = __builtin_amdgcn_mfma_f32_16x16x32_bf16(Bt[n][k], At[m][k], acc[ai][bj][m][n], 0, 0, 0); __builtin_amdgcn_s_setprio(0); } while (0)
#define PG8_WAIT_V(n) asm volatile("s_waitcnt vmcnt(" #n ")" ::: "memory")
#define PG8_WAIT_L(n) asm volatile("s_waitcnt lgkmcnt(" #n ")" ::: "memory")
#define PG8_BAR __builtin_amdgcn_s_barrier()
#define PG8_SCHED __builtin_amdgcn_sched_barrier(0)
    Unit cur, nxt; int ui = 0;
    if (!S.next(0, cur)) return;
    f32x4 acc[2][2][4][2];
#pragma unroll
    for (int a = 0; a < 2; ++a)
#pragma unroll
        for (int b = 0; b < 2; ++b)
#pragma unroll
            for (int m = 0; m < 4; ++m)
#pragma unroll
                for (int n = 0; n < 2; ++n) acc[a][b][m][n] = (f32x4){0.f, 0.f, 0.f, 0.f};
    bf16x8 At[4][2], B0[2][2], B1[2][2];
    const char* cA = (const char*)g.A + (size_t)cur.pm * tstep; const char* cB = (const char*)g.Bt + (size_t)cur.pn * tstep;
    S.a_ready(cur);
    if constexpr (SP2) {
        PG8_STAGE(PG8_SB(0, 0), cB, voffB); PG8_STAGE(PG8_SB(0, 1), cB + hstep, voffB); PG8_STAGE(PG8_SA(0, 0), cA, voffA); PG8_STAGE(PG8_SA(0, 1), cA + hstep, voffA);
        if (wr == 1) PG8_BAR;
        PG8_WAIT_V(2); PG8_BAR;
        PG8_STAGE(PG8_SB(1, 0), cB + kstep, voffB); PG8_STAGE(PG8_SA(1, 0), cA + kstep, voffA); PG8_STAGE(PG8_SB(1, 1), cB + hstep + kstep, voffB);
        PG8_WAIT_V(6); PG8_BAR;
    } else {
        PG8_STAGE(PG8_SB(0, 0), cB, voffB); PG8_STAGE(PG8_SA(0, 0), cA, voffA); PG8_STAGE(PG8_SB(0, 1), cB + hstep, voffB); PG8_STAGE(PG8_SA(0, 1), cA + hstep, voffA);
        if (wr == 1) PG8_BAR;
        PG8_WAIT_V(4); PG8_BAR;
        PG8_STAGE(PG8_SB(1, 0), cB + kstep, voffB); PG8_STAGE(PG8_SA(1, 0), cA + kstep, voffA); PG8_STAGE(PG8_SB(1, 1), cB + hstep + kstep, voffB);
        PG8_WAIT_V(6); PG8_BAR;
    }
    for (;;) {
        const bool has_next = S.next(ui + 1, nxt);
        const char* nA = has_next ? (const char*)g.A + (size_t)nxt.pm * tstep : cA; const char* nB = has_next ? (const char*)g.Bt + (size_t)nxt.pn * tstep : cB;
        for (int t = 0; t < nt; t += 2) {
            const bool last = (t == nt - 2);
            const char* a1 = cA + (size_t)(t + 1) * kstep;
            const char* a2 = last ? nA : cA + (size_t)(t + 2) * kstep; const char* b2 = last ? nB : cB + (size_t)(t + 2) * kstep;
            const char* a3 = a2 + kstep; const char* b3 = b2 + kstep;
            if (last && has_next) S.a_ready(nxt);
            if constexpr (SP2) {
            PG8_LDB(B0, 0, 0); PG8_LDB(B1, 0, 1); PG8_SCHED; PG8_LDA(At, 0, 0); PG8_STAGE(PG8_SA(1, 1), a1 + hstep, voffA);
            PG8_WAIT_V(8); PG8_WAIT_L(0); PG8_BAR; PG8_MMA(0, 0, At, B0); PG8_MMA(0, 1, At, B1); PG8_BAR; PG8_SCHED;
            PG8_LDA(At, 0, 1); PG8_STAGE(PG8_SB(0, 0), b2, voffB); PG8_STAGE(PG8_SB(0, 1), b2 + hstep, voffB); PG8_STAGE(PG8_SA(0, 0), a2, voffA);
            PG8_WAIT_V(8); PG8_WAIT_L(0); PG8_BAR; PG8_MMA(1, 0, At, B0); PG8_MMA(1, 1, At, B1); PG8_BAR; PG8_SCHED;
            PG8_LDB(B0, 1, 0); PG8_LDB(B1, 1, 1); PG8_SCHED; PG8_LDA(At, 1, 0); PG8_STAGE(PG8_SA(0, 1), a2 + hstep, voffA);
            PG8_WAIT_V(8); PG8_WAIT_L(0); PG8_BAR; PG8_MMA(0, 0, At, B0); PG8_MMA(0, 1, At, B1); PG8_BAR; PG8_SCHED;
            PG8_LDA(At, 1, 1); PG8_STAGE(PG8_SB(1, 0), b3, voffB); PG8_STAGE(PG8_SB(1, 1), b3 + hstep, voffB); PG8_STAGE(PG8_SA(1, 0), a3, voffA);
            PG8_WAIT_V(8); PG8_WAIT_L(0); PG8_BAR; PG8_MMA(1, 0, At, B0); PG8_MMA(1, 1, At, B1); PG8_BAR; PG8_SCHED;
            } else {
            PG8_LDB(B0, 0, 0); PG8_SCHED; PG8_LDA(At, 0, 0); PG8_STAGE(PG8_SA(1, 1), a1 + hstep, voffA);
            PG8_WAIT_L(8); PG8_BAR; PG8_WAIT_L(0); PG8_MMA(0, 0, At, B0); PG8_BAR; PG8_SCHED;
            PG8_LDB(B1, 0, 1); PG8_STAGE(PG8_SB(0, 0), b2, voffB);
            PG8_BAR; PG8_WAIT_L(0); PG8_MMA(0, 1, At, B1); PG8_BAR;
            PG8_LDA(At, 0, 1); PG8_STAGE(PG8_SA(0, 0), a2, voffA);
            PG8_BAR; PG8_WAIT_L(0); PG8_MMA(1, 0, At, B0); PG8_BAR; PG8_SCHED;
            PG8_STAGE(PG8_SB(0, 1), b2 + hstep, voffB);
            PG8_WAIT_V(6); PG8_BAR; PG8_MMA(1, 1, At, B1); PG8_BAR;
            PG8_LDB(B0, 1, 0); PG8_SCHED; PG8_LDA(At, 1, 0); PG8_STAGE(PG8_SA(0, 1), a2 + hstep, voffA);
            PG8_WAIT_L(8); PG8_BAR; PG8_WAIT_L(0); PG8_MMA(0, 0, At, B0); PG8_BAR; PG8_SCHED;
            PG8_LDB(B1, 1, 1); PG8_STAGE(PG8_SB(1, 0), b3, voffB);
            PG8_BAR; PG8_WAIT_L(0); PG8_MMA(0, 1, At, B1); PG8_BAR;
            PG8_LDA(At, 1, 1); PG8_STAGE(PG8_SA(1, 0), a3, voffA);
            PG8_BAR; PG8_WAIT_L(0); PG8_MMA(1, 0, At, B0); PG8_BAR; PG8_SCHED;
            PG8_STAGE(PG8_SB(1, 1), b3 + hstep, voffB);
            PG8_WAIT_V(6); PG8_BAR; PG8_MMA(1, 1, At, B1); PG8_BAR;
            }
        }
        if constexpr (ALIGN_EPI) { if (wr == 0) PG8_BAR; }
        if constexpr (!Epi::AFTER_DRAIN) { E(acc, cur, wr, wc, fr, fq); S.done(cur); }
        if (!has_next) break;
#pragma unroll
        for (int a = 0; a < 2; ++a)
#pragma unroll
            for (int b = 0; b < 2; ++b)
#pragma unroll
                for (int m = 0; m < 4; ++m)
#pragma unroll
                    for (int n = 0; n < 2; ++n) acc[a][b][m][n] = (f32x4){0.f, 0.f, 0.f, 0.f};
        cur = nxt; cA = nA; cB = nB; ++ui;
        if constexpr (ALIGN_EPI) { if (wr == 1) PG8_BAR; }
    }
    PG8_WAIT_V(0);
    if constexpr (!ALIGN_EPI) { if (wr == 0) PG8_BAR; }
    PG8_BAR;
    if constexpr (Epi::AFTER_DRAIN) { E.fused(acc, cur, wr, wc, fr, fq, lds, wid, lane); S.done(cur); }
#undef PG8_SA
#undef PG8_SB
#undef PG8_STAGE
#undef PG8_LDA
#undef PG8_LDB
#undef PG8_MMA
#undef PG8_WAIT_V
#undef PG8_WAIT_L
#undef PG8_BAR
#undef PG8_SCHED
}
}


typedef unsigned short bf16;
typedef short bf16x8 __attribute__((ext_vector_type(8)));
typedef short s16x4 __attribute__((ext_vector_type(4)));
typedef float f32x16 __attribute__((ext_vector_type(16)));
constexpr int ATT_WLDS = 12800;
typedef unsigned v4u __attribute__((ext_vector_type(4)));
typedef unsigned v2u __attribute__((ext_vector_type(2)));
typedef float f32x2c_ __attribute__((ext_vector_type(2)));
typedef __bf16 bf16x2c_ __attribute__((ext_vector_type(2)));
__device__ __forceinline__ unsigned pk2(float lo, float hi) { const f32x2c_ v = {lo, hi}; return __builtin_bit_cast(unsigned, __builtin_convertvector(v, bf16x2c_)); }
__device__ __forceinline__ unsigned f2bf(float f) { return pk2(f, f) & 0xffffu; }
#define LDS_WAIT() asm volatile("s_waitcnt lgkmcnt(0)" ::: "memory")

__device__ __forceinline__ void p0_transpose_item(const float* W, int K, int N, bf16* WT, LAS float* scr, int item, int lane) {
    const int nblk = N / 32, kb = item / nblk, nb = item % nblk, k0 = 64 * kb, n0 = 32 * nb;
    float wv[32];
#pragma unroll
    for (int i = 0; i < 32; ++i) wv[i] = W[(size_t)(k0 + 2 * i + (lane >> 5)) * N + n0 + (lane & 31)];
#pragma unroll
    for (int i = 0; i < 32; ++i) scr[(2 * i + (lane >> 5)) * 33 + (lane & 31)] = wv[i];
    LDS_WAIT(); asm volatile("" ::: "memory");
    const int c = lane & 7;
#pragma unroll
    for (int j = 0; j < 4; ++j) { const int n = (lane >> 3) + 8 * j; const LAS float* s = scr + (8 * c) * 33 + n;
        v4u o; o.x = pk2(s[0 * 33], s[1 * 33]); o.y = pk2(s[2 * 33], s[3 * 33]); o.z = pk2(s[4 * 33], s[5 * 33]); o.w = pk2(s[6 * 33], s[7 * 33]);
        *(GAS v4u*)(WT + (size_t)(n0 + n) * K + k0 + 8 * c) = o; }
    LDS_WAIT(); asm volatile("" ::: "memory");
}
__device__ __forceinline__ void ph_weights(const Params& P, int gw, int ngw, int wave, int lane, LAS float* lds) {
    LAS float* scr = lds + wave * 4096;
    constexpr int I_IN = (D / 64) * (NIN / 32), I_OUT = (D / 64) * (D / 32), I_1 = (D / 64) * (DFF / 32), I_2 = (DFF / 64) * (D / 32);
    constexpr int PER_L = I_IN + I_OUT + I_1 + I_2;
    for (int it = gw; it < DEPTH * PER_L; it += ngw) {
        const int l = it / PER_L; int r = it % PER_L;
        if (r < I_IN) { p0_transpose_item(P.in[13] + (size_t)l * D * NIN, D, NIN, (bf16*)(P.ws + WS_WIN) + (size_t)l * NIN * D, scr, r, lane); continue; } r -= I_IN;
        if (r < I_OUT) { p0_transpose_item(P.in[14] + (size_t)l * D * D, D, D, (bf16*)(P.ws + WS_WOUT) + (size_t)l * D * D, scr, r, lane); continue; } r -= I_OUT;
        if (r < I_1) { p0_transpose_item(P.in[33] + (size_t)l * D * DFF, D, DFF, (bf16*)(P.ws + WS_W1) + (size_t)l * DFF * D, scr, r, lane); continue; } r -= I_1;
        p0_transpose_item(P.in[34] + (size_t)l * DFF * D, DFF, D, (bf16*)(P.ws + WS_W2) + (size_t)l * D * DFF, scr, r, lane);
    }
}

struct SEpiIn { float* C; bf16* QKV; float* ks; float* vs;
    __device__ __forceinline__ void operator()(int row, int col, float s) const {
        if (col < PW) C[(size_t)(MP + row) * PW + col] = s;
        else { const int cq = col - PW; QKV[(size_t)(MP + row) * 3072 + cq] = (bf16)f2bf(s);
            if (cq >= 2048) vs[(size_t)row * 1024 + (cq - 2048)] = s; else if (cq >= 1024) ks[(size_t)row * 1024 + (cq - 1024)] = s; } } };
struct SEpiF32 { float* C; int ldc;
    __device__ __forceinline__ void operator()(int row, int col, float s) const { C[(size_t)(MP + row) * ldc + col] = s; } };
struct SEpiBf16 { bf16* O; int ldc;
    __device__ __forceinline__ void operator()(int row, int col, float s) const { O[(size_t)(MP + row) * ldc + col] = (bf16)f2bf(s); } };
struct SEpiRelu2 { bf16* O; int ldc;
    __device__ __forceinline__ void operator()(int row, int col, float s) const { const float t = fmaxf(s, 0.f); O[(size_t)(MP + row) * ldc + col] = (bf16)f2bf(t * t); } };
template <class E>
__device__ __forceinline__ void gemm_small(const bf16* A, const bf16* Bt, int N, int K, int u0, int ustride, int tid, int wave, int lane, LAS float* lds, const E& epi) {
    const int kw = K >> 3, i32 = lane & 31, hi = lane >> 5;
    for (int u = u0; u < (N >> 5); u += ustride) {
        const int n0 = u * 32;
        f32x16 acc;
#pragma unroll
        for (int r = 0; r < 16; ++r) acc[r] = 0.f;
        const bf16* ap = A + (size_t)i32 * K + wave * kw + hi * 8;
        const bf16* bp = Bt + (size_t)(n0 + i32) * K + wave * kw + hi * 8;
#pragma unroll 8
        for (int k = 0; k < kw; k += 16) { const bf16x8 a = *(const bf16x8*)(ap + k); const bf16x8 b = *(const bf16x8*)(bp + k); acc = __builtin_amdgcn_mfma_f32_32x32x16_bf16(a, b, acc, 0, 0, 0); }
#pragma unroll
        for (int r = 0; r < 16; ++r) lds[wave * 1024 + r * 64 + lane] = acc[r];
        __syncthreads();
#pragma unroll
        for (int q = 0; q < 2; ++q) { const int idx = tid + 512 * q; float s = 0.f;
#pragma unroll
            for (int w = 0; w < 8; ++w) s += lds[w * 1024 + idx];
            const int ri = idx >> 6, ln = idx & 63;
            epi((ri & 3) + 8 * (ri >> 2) + 4 * (ln >> 5), n0 + (ln & 31), s); }
        __syncthreads();
    }
}

__device__ __forceinline__ void ph_norm1(const Params& P, int gw, int ngw, int lane) {
    const float* g = P.in[9];
    bf16* H = (bf16*)(P.ws + WS_HB);
    f32x4 g1v[8];
#pragma unroll
    for (int j = 0; j < 8; ++j) g1v[j] = *(const f32x4*)(g + lane * 4 + j * 256);
    for (int r = gw; r < MT; r += ngw) {
        const float* x = r < MP ? P.in[0] + (size_t)r * D : P.in[1] + (size_t)(r - MP) * D;
        f32x4 v[8]; float ss = 0.f;
#pragma unroll
        for (int j = 0; j < 8; ++j) { v[j] = *(const f32x4*)(x + lane * 4 + j * 256); ss += v[j].x * v[j].x + v[j].y * v[j].y + v[j].z * v[j].z + v[j].w * v[j].w; }
        ss = wave_sum(ss);
        const float rs = rsqrtf(ss * (1.f / D) + RMS_EPS);
#pragma unroll
        for (int j = 0; j < 8; ++j) { const f32x4 gv = g1v[j]; const f32x4 o = v[j] * rs * gv;
            *(v2u*)(H + (size_t)r * D + lane * 4 + j * 256) = (v2u){pk2(o.x, o.y), pk2(o.z, o.w)}; }
    }
}

template <int EPI>
__device__ __forceinline__ void ph_gemm_naive(const float* A, int lda, const float* W, float* C, int ldc, int M, int N, int K, int bid, int nb, int tid, LAS float* lds) {
    LAS float* As = lds;
    LAS float* Bs = lds + 16 * 132;
    const int ty = tid >> 4, tx = tid & 15;
    const int ntm = (M + 127) / 128, ntn = N / 64;
    for (int tile = bid; tile < ntm * ntn; tile += nb) {
        const int tm = tile / ntn, tn = tile % ntn, m0 = tm * 128, n0 = tn * 64;
        float acc[4][4];
#pragma unroll
        for (int i = 0; i < 4; ++i)
#pragma unroll
            for (int j = 0; j < 4; ++j) acc[i][j] = 0.f;
        const int ar = m0 + (tid >> 2), ak = (tid & 3) * 4, bk = tid >> 5, bc = (tid & 31) * 2;
        for (int k0 = 0; k0 < K; k0 += 16) {
            f32x4 av = (f32x4){0.f, 0.f, 0.f, 0.f};
            if (ar < M) av = *(const f32x4*)(A + (size_t)ar * lda + k0 + ak);
            const f32x2 bv = *(const f32x2*)(W + (size_t)(k0 + bk) * N + n0 + bc);
            __syncthreads();
            As[(ak + 0) * 132 + (tid >> 2)] = av.x; As[(ak + 1) * 132 + (tid >> 2)] = av.y; As[(ak + 2) * 132 + (tid >> 2)] = av.z; As[(ak + 3) * 132 + (tid >> 2)] = av.w;
            Bs[bk * 64 + bc] = bv.x; Bs[bk * 64 + bc + 1] = bv.y;
            __syncthreads();
#pragma unroll
            for (int k = 0; k < 16; ++k) {
                const f32x4 a = *(const LAS f32x4*)(As + k * 132 + ty * 4);
                const f32x4 b = *(const LAS f32x4*)(Bs + k * 64 + tx * 4);
#pragma unroll
                for (int i = 0; i < 4; ++i)
#pragma unroll
                    for (int j = 0; j < 4; ++j) acc[i][j] += a[i] * b[j];
            }
        }
#pragma unroll
        for (int i = 0; i < 4; ++i) {
            const int row = m0 + ty * 4 + i;
            if (row < M) {
                f32x4 o = (f32x4){acc[i][0], acc[i][1], acc[i][2], acc[i][3]};
                if (EPI == 1) { o.x = fmaxf(o.x, 0.f); o.y = fmaxf(o.y, 0.f); o.z = fmaxf(o.z, 0.f); o.w = fmaxf(o.w, 0.f); o = o * o; }
                *(f32x4*)(C + (size_t)row * ldc + n0 + tx * 4) = o;
            }
        }
    }
}

template <int NJ> __device__ __forceinline__ void lora_pass(f32x2 (&acc)[18], const LAS float* act, const float* wcol) {
#pragma unroll 1
    for (int j0 = 0; j0 < NJ; j0 += 8) {
        float wv[8];
#pragma unroll
        for (int q = 0; q < 8; ++q) wv[q] = wcol[(size_t)(j0 + q) * 512];
        f32x4 xa[9], xb[9];
#pragma unroll
        for (int t4 = 0; t4 < 9; ++t4) xa[t4] = *(const LAS f32x4*)(act + j0 * 36 + 4 * t4);
        __builtin_amdgcn_sched_barrier(0);
#pragma unroll
        for (int q = 0; q < 8; q += 2) {
#pragma unroll
            for (int t4 = 0; t4 < 9; ++t4) xb[t4] = *(const LAS f32x4*)(act + (j0 + q + 1) * 36 + 4 * t4);
            { const f32x2 w2 = (f32x2){wv[q], wv[q]};
#pragma unroll
              for (int t4 = 0; t4 < 9; ++t4) { acc[2 * t4] += xa[t4].xy * w2; acc[2 * t4 + 1] += xa[t4].zw * w2; } }
            __builtin_amdgcn_sched_barrier(0);
            if (q + 2 < 8) {
#pragma unroll
                for (int t4 = 0; t4 < 9; ++t4) xa[t4] = *(const LAS f32x4*)(act + (j0 + q + 2) * 36 + 4 * t4);
            }
            { const f32x2 w2 = (f32x2){wv[q + 1], wv[q + 1]};
#pragma unroll
              for (int t4 = 0; t4 < 9; ++t4) { acc[2 * t4] += xb[t4].xy * w2; acc[2 * t4 + 1] += xb[t4].zw * w2; } }
            __builtin_amdgcn_sched_barrier(0);
        }
    }
}
constexpr int LA_P = 264;
__device__ __forceinline__ void lora_mfma64(f32x4 (&acc)[3][2], const LAS unsigned short* AH, const LAS unsigned short* AL, int kofs, const float* wsl_, int half, int lane) {
    const float* wsl = wsl_ + 32 * half;
    const int n = lane & 15, kq = lane >> 4;
    unsigned wlo = (unsigned)(kq * 8 * 512 + n);
    asm volatile("" : "+s"(wsl), "+v"(wlo));
    float wf[2][2][8];
#pragma unroll
    for (int nt = 0; nt < 2; ++nt)
#pragma unroll
        for (int ks = 0; ks < 2; ++ks)
#pragma unroll
            for (int i = 0; i < 8; ++i) wf[nt][ks][i] = (wsl + (32 * ks + i) * 512 + 16 * nt)[wlo];
    bf16x8 ah[2][3], al[2][3];
    __builtin_amdgcn_sched_barrier(0);
#pragma unroll
    for (int ks = 0; ks < 2; ++ks)
#pragma unroll
        for (int mt = 0; mt < 3; ++mt) { ah[ks][mt] = *(const LAS bf16x8*)(AH + (16 * mt + n) * LA_P + kofs + 32 * ks + 8 * kq); al[ks][mt] = *(const LAS bf16x8*)(AL + (16 * mt + n) * LA_P + kofs + 32 * ks + 8 * kq); }
    WAVE_LDS_SYNC();
    __builtin_amdgcn_sched_barrier(0);
#pragma unroll
    for (int ks = 0; ks < 2; ++ks) {
#pragma unroll
        for (int nt = 0; nt < 2; ++nt) {
            bf16x8 bh, bl;
#pragma unroll
            for (int i = 0; i < 8; ++i) { const float wv_ = wf[nt][ks][i]; const unsigned h_ = f2bf(wv_); bh[i] = (short)h_; bl[i] = (short)f2bf(wv_ - __uint_as_float(h_ << 16)); }
#pragma unroll
            for (int mt = 0; mt < 3; ++mt) {
                acc[mt][nt] = __builtin_amdgcn_mfma_f32_16x16x32_bf16(ah[ks][mt], bh, acc[mt][nt], 0, 0, 0);
                acc[mt][nt] = __builtin_amdgcn_mfma_f32_16x16x32_bf16(al[ks][mt], bh, acc[mt][nt], 0, 0, 0);
                acc[mt][nt] = __builtin_amdgcn_mfma_f32_16x16x32_bf16(ah[ks][mt], bl, acc[mt][nt], 0, 0, 0);
            }
        }
    }
    __builtin_amdgcn_sched_barrier(0);
#pragma unroll
    for (int mt = 0; mt < 3; ++mt)
#pragma unroll
        for (int nt = 0; nt < 2; ++nt) acc[mt][nt][0] += 0.0f;
    __builtin_amdgcn_sched_barrier(0);
}
__device__ __forceinline__ void lora_store(const f32x4 (&acc)[3][2], LAS float* RES, int wave, int half, int lane) {
    const int n = lane & 15, kq = lane >> 4;
#pragma unroll
    for (int mt = 0; mt < 3; ++mt)
#pragma unroll
        for (int r = 0; r < 4; ++r) { const int row = 16 * mt + 4 * kq + r;
            if (row < 33) {
#pragma unroll
                for (int nt = 0; nt < 2; ++nt) RES[row * 512 + 64 * wave + 32 * half + 16 * nt + n] = acc[mt][nt][r]; } }
}
__device__ __forceinline__ void ph_post_in(const Params& P, int l, int bid, int nb, int tid, LAS float* lds) {
    const float* PROJ = (const float*)(P.ws + WS_PROJ);
    float* RWB = (float*)(P.ws + WS_RWB);
    float* out = P.out;
    const size_t gtid = (size_t)bid * 512 + tid, nthr = (size_t)nb * 512;
#pragma unroll 1
    for (size_t i = gtid; i < (size_t)NSEQ * RPROJ; i += nthr) {
        const int s = (int)(i / RPROJ), c = (int)(i % RPROJ); int row0, T; seq_of(s, row0, T);
        const float v = PROJ[(size_t)(row0 + T - 1) * PW + c];
        if (s < NB) out[O_SHIFT_P + ((size_t)l * NB + s) * RPROJ + c] = v; else out[O_SHIFT_S + ((size_t)l * DB + (s - NB)) * RPROJ + c] = v;
    }
#pragma unroll 1
    for (size_t i = gtid; i < (size_t)NSEQ * 3 * 512; i += nthr) {
        const int s = (int)(i / 1536), j = (int)((i % 1536) / 512), c = (int)(i % 512); int row0, T; seq_of(s, row0, T);
        const float v = PROJ[(size_t)(row0 + T - 3 + j) * PW + C_LX + c];
        if (s < NB) out[O_CONV_P + (((size_t)l * NB + s) * 3 + j) * 512 + c] = v; else out[O_CONV_S + (((size_t)l * DB + (s - NB)) * 3 + j) * 512 + c] = v;
    }
    constexpr int TT = 33, NTILE = (MT + TT - 1) / TT;
    LAS unsigned short* AH = (LAS unsigned short*)lds;
    LAS unsigned short* AL = AH + 48 * LA_P;
    LAS float* RES = (LAS float*)(AL + 48 * LA_P);
    static_assert(2 * 48 * LA_P * 2 + 33 * 512 * 4 <= 131072, "prep LDS");
    const float* mu = P.in[15] + (size_t)l * RPROJ;
    const float* w_up = P.in[17] + (size_t)l * 64 * 512; const float* a_up = P.in[19] + (size_t)l * 64 * 512; const float* g_up = P.in[20] + (size_t)l * 128 * 512;
    const int wave = __builtin_amdgcn_readfirstlane(tid >> 6), lane = tid & 63;
    for (int tile = bid; tile < NTILE; tile += nb) {
        int c = tid; asm volatile("" : "+v"(c));
        const int r0 = tile * TT;
        {
            const int j = tid & 255, th = tid >> 8;
            const float muj = mu[1536 + j];
            float pprev = 0.f;
            { const int r = r0 + th * 18; if (r > 0 && r < MT) pprev = PROJ[(size_t)(r - 1) * PW + 1536 + j]; }
#pragma unroll 9
            for (int i = 0; i < 18; ++i) {
                const int t = th * 18 + i, r = r0 + t;
                float av = 0.f;
                if (t < TT && r < MT) {
                    int s, ts; row_to_seq(r, s, ts);
                    const float p = PROJ[(size_t)r * PW + 1536 + j];
                    float pv = pprev;
                    if (ts == 0) pv = (s >= NB) ? P.in[3][((size_t)l * DB + (s - NB)) * RPROJ + 1536 + j] : 0.f;
                    const float m = p + (pv - p) * muj;
                    av = j < 64 ? ftanh_(m) : (j < 128 ? m : fsigmoid_(m));
                    pprev = p;
                }
                const unsigned hb = f2bf(av);
                AH[t * LA_P + j] = (unsigned short)hb; AL[t * LA_P + j] = (unsigned short)f2bf(av - __uint_as_float(hb << 16));
            }
            for (int i = tid; i < 12 * 256; i += 512) { AH[(36 + (i >> 8)) * LA_P + (i & 255)] = 0; AL[(36 + (i >> 8)) * LA_P + (i & 255)] = 0; }
        }
        __syncthreads();
        f32x4 acc[3][2];
#define LORA_ZERO() do { _Pragma("unroll") for (int mt = 0; mt < 3; ++mt) _Pragma("unroll") for (int nt = 0; nt < 2; ++nt) acc[mt][nt] = (f32x4){0.f, 0.f, 0.f, 0.f}; } while (0)
#pragma unroll 1
        for (int half = 0; half < 2; ++half) { LORA_ZERO(); lora_mfma64(acc, AH, AL, 0, w_up + 64 * wave, half, lane); lora_store(acc, RES, wave, half, lane); }
        __syncthreads();
        {
            const float w0c = P.in[16][l * 512 + c];
#pragma unroll
            for (int t = 0; t < TT; ++t) {
                if ((t & 7) == 0) __builtin_amdgcn_sched_barrier(0);
                const float z = w0c + RES[t * 512 + c];
                const float w_log = -fsoftplus_(-z) - 0.5f;
                if (r0 + t < MT) RWB[(size_t)(r0 + t) * 3584 + 512 + c] = fexp_(-fexp_(w_log));
            }
        }
        __syncthreads();
        asm volatile("" : "+v"(c));
#pragma unroll 1
        for (int half = 0; half < 2; ++half) { LORA_ZERO(); lora_mfma64(acc, AH, AL, 64, a_up + 64 * wave, half, lane); lora_store(acc, RES, wave, half, lane); }
        __syncthreads();
        float acc1[TT];
        {
            const float a0c = P.in[18][l * 512 + c];
#pragma unroll
            for (int t = 0; t < TT; ++t) acc1[t] = fsigmoid_(a0c + RES[t * 512 + c]);
        }
        __syncthreads();
        asm volatile("" : "+v"(c));
#pragma unroll 1
        for (int half = 0; half < 2; ++half) { LORA_ZERO(); lora_mfma64(acc, AH, AL, 128, g_up + 64 * wave, half, lane); lora_mfma64(acc, AH, AL, 192, g_up + (size_t)64 * 512 + 64 * wave, half, lane); lora_store(acc, RES, wave, half, lane); }
#undef LORA_ZERO
        __syncthreads();
        asm volatile("" : "+v"(c));
        {
            const float mur = mu[c], muk = mu[512 + c], muv = mu[1024 + c];
            const float kkc = P.in[21][l * 512 + c], kac = P.in[22][l * 512 + c];
            float pv0 = 0.f, pv1 = 0.f, pv2 = 0.f;
            if (r0 > 0) { const float* pp = PROJ + (size_t)(r0 - 1) * PW; pv0 = pp[c]; pv1 = pp[512 + c]; pv2 = pp[1024 + c]; }
#pragma unroll
            for (int t = 0; t < TT; ++t) {
                if (t % 11 == 0) __builtin_amdgcn_sched_barrier(0);
                const int r = (r0 + t < MT) ? r0 + t : MT - 1; int s, ts; row_to_seq(r, s, ts);
                const float* pr = PROJ + (size_t)r * PW;
                const float p0 = pr[c], p1 = pr[512 + c], p2 = pr[1024 + c];
                float q0 = pv0, q1 = pv1, q2 = pv2;
                if (ts == 0) { q0 = 0.f; q1 = 0.f; q2 = 0.f;
                    if (s >= NB) { const float* st = P.in[3] + ((size_t)l * DB + (s - NB)) * RPROJ; q0 = st[c]; q1 = st[512 + c]; q2 = st[1024 + c]; } }
                pv0 = p0; pv1 = p1; pv2 = p2;
                const float rr = p0 + (q0 - p0) * mur, k = p1 + (q1 - p1) * muk, vv = p2 + (q2 - p2) * muv;
                const float a = acc1[t];
                const float kkv = k * kkc;
                const float ss = wave_sum(kkv * kkv);
                const float kkn = kkv * __builtin_amdgcn_rsqf(fmaxf(ss, 1e-24f));
                if (r0 + t < MT) { float* o = RWB + (size_t)r * 3584 + c;
                    o[0] = rr; o[1024] = k * (1.0f + (a - 1.0f) * kac); o[1536] = vv; o[2048] = kkn; o[2560] = kkn * a; o[3072] = RES[t * 512 + c]; }
            }
        }
        __syncthreads();
    }
}

__device__ __forceinline__ float att_bias(const float* rel_bias, int dist, int h) {
    int b;
    if (dist < 16) b = dist;
    else { b = 16 + (int)(logf((float)dist / 16.0f) / 4.852030263919617f * 16.0f); b = b > 31 ? 31 : b; }
    return rel_bias[b * 8 + h];
}

__device__ __forceinline__ int qpop(unsigned* ctr, int lane) { unsigned v = 0u; if (lane == 0) v = atomicAdd(ctr, 1u); return (int)__builtin_amdgcn_readfirstlane(v); }
constexpr int CW_QUEUE = 1024;
constexpr int LRU_ITEMS = NB * 8 * 32 + DB * 8;
__device__ __forceinline__ void lru_item(int item, int& s, int& n, int& j, int& r0, int& nt) {
    if (item < NB * 8 * 32) { s = item >> 8; n = (item >> 5) & 7; j = item & 31; r0 = s * SEQ + j * 64; nt = 64; }
    else { const int q = item - NB * 8 * 32; s = NB + (q >> 3); n = q & 7; j = 0; r0 = MP + (q >> 3) * DS; nt = DS; }
}
__device__ __forceinline__ void ph_mix(const Params& P, int l, int bid, int nb, int wave, int lane, LAS float* lds) {
    const float* PROJ = (const float*)(P.ws + WS_PROJ);
    bf16* MIX = (bf16*)(P.ws + WS_MIXB);
    const int gw = bid * NWAVES + wave, ngw = nb * NWAVES;
    {
        float* HLOC = (float*)(P.ws + WS_HLOC); float* CUMA = (float*)(P.ws + WS_CUMA); float* SUMM = (float*)(P.ws + WS_SUMM);
        unsigned* qc = (unsigned*)(P.ws + WS_CTL) + CW_QUEUE + (l * 3 + 0) * 64;
        LAS float* XC = (LAS float*)((LAS unsigned char*)lds + 32768 + wave * ATT_WLDS);
        LAS float* GR = XC + 1040; LAS float* GI = GR + 1024;
        const int tl = lane & 15, kg = lane >> 4;
        for (int item = qpop(qc, lane); item < LRU_ITEMS; item = qpop(qc, lane)) {
            int s, n, j, r0, nt; lru_item(item, s, n, j, r0, nt);
            const int c = n * 64 + lane;
            const float* wab = P.in[28] + ((size_t)l * 8 + n) * 4096; const float* wxb = P.in[30] + ((size_t)l * 8 + n) * 4096;
            const unsigned wlo = (unsigned)(kg * 64 + 4 * tl);
            float x1 = 0.f, x2 = 0.f, x3 = 0.f;
            if (j > 0) { x1 = PROJ[(size_t)(r0 - 3) * PW + C_LX + c]; x2 = PROJ[(size_t)(r0 - 2) * PW + C_LX + c]; x3 = PROJ[(size_t)(r0 - 1) * PW + C_LX + c]; }
            else if (s >= NB) { const float* cs = P.in[5] + (((size_t)l * DB + (s - NB)) * 3) * 512 + c; x1 = cs[0]; x2 = cs[512]; x3 = cs[1024]; }
            const float cw0 = P.in[26][(l * 4 + 0) * 512 + c], cw1 = P.in[26][(l * 4 + 1) * 512 + c], cw2 = P.in[26][(l * 4 + 2) * 512 + c], cw3 = P.in[26][(l * 4 + 3) * 512 + c];
            const float cb = P.in[27][l * 512 + c], ba = P.in[29][l * 512 + c], bx = P.in[31][l * 512 + c];
            const float sp = softplusf_(-P.in[32][l * 512 + c]);
            float hl = 0.f, ca = 1.f;
            float xn[16];
#pragma unroll
            for (int q = 0; q < 16; ++q) xn[q] = (q < nt) ? PROJ[(size_t)(r0 + q) * PW + C_LX + c] : 0.f;
#pragma unroll 1
            for (int t0 = 0; t0 < nt; t0 += 16) {
                f32x4 wva[8], wvx[8];
#define LRU_LDW(S0) do { _Pragma("unroll") for (int s4 = 0; s4 < 8; ++s4) { wva[s4] = *(const f32x4*)(wab + ((S0) + s4) * 256 + wlo); wvx[s4] = *(const f32x4*)(wxb + ((S0) + s4) * 256 + wlo); } } while (0)
                LRU_LDW(0);
#pragma unroll
                for (int q = 0; q < 16; ++q) { const float xb = xn[q]; XC[q * 65 + lane] = cb + cw0 * x1 + cw1 * x2 + cw2 * x3 + cw3 * xb; x1 = x2; x2 = x3; x3 = xb; }
                WAVE_LDS_SYNC();
                float av[16];
#pragma unroll
                for (int s4 = 0; s4 < 16; ++s4) av[s4] = XC[tl * 65 + 4 * s4 + kg];
                WAVE_LDS_SYNC();
                __builtin_amdgcn_sched_barrier(0);
                f32x4 ar[4], ai[4];
#pragma unroll
                for (int ct = 0; ct < 4; ++ct) { ar[ct] = (f32x4){0.f, 0.f, 0.f, 0.f}; ai[ct] = ar[ct]; }
#pragma unroll
                for (int s4 = 0; s4 < 8; ++s4)
#pragma unroll
                    for (int ct = 0; ct < 4; ++ct) { ar[ct] = __builtin_amdgcn_mfma_f32_16x16x4f32(av[s4], wva[s4][ct], ar[ct], 0, 0, 0); ai[ct] = __builtin_amdgcn_mfma_f32_16x16x4f32(av[s4], wvx[s4][ct], ai[ct], 0, 0, 0); }
                __builtin_amdgcn_sched_barrier(0);
                LRU_LDW(8);
                __builtin_amdgcn_sched_barrier(0);
#pragma unroll
                for (int s4 = 0; s4 < 8; ++s4)
#pragma unroll
                    for (int ct = 0; ct < 4; ++ct) { ar[ct] = __builtin_amdgcn_mfma_f32_16x16x4f32(av[8 + s4], wva[s4][ct], ar[ct], 0, 0, 0); ai[ct] = __builtin_amdgcn_mfma_f32_16x16x4f32(av[8 + s4], wvx[s4][ct], ai[ct], 0, 0, 0); }
                __builtin_amdgcn_sched_barrier(0);
#undef LRU_LDW
#pragma unroll
                for (int ct = 0; ct < 4; ++ct)
#pragma unroll
                    for (int e = 0; e < 4; ++e) { GR[(4 * kg + e) * 64 + 4 * tl + ct] = ar[ct][e]; GI[(4 * kg + e) * 64 + 4 * tl + ct] = ai[ct][e]; }
                WAVE_LDS_SYNC();
                __builtin_amdgcn_sched_barrier(0);
#pragma unroll
                for (int q = 0; q < 16; ++q) xn[q] = (t0 + 16 + q < nt) ? PROJ[(size_t)(r0 + t0 + 16 + q) * PW + C_LX + c] : 0.f;
#pragma unroll
                for (int q = 0; q < 16; ++q) {
                    if (t0 + q < nt) {
                        const float xcv = XC[q * 65 + lane];
                        const float gr = sigmoidf_(GR[q * 64 + lane] + ba), gi = sigmoidf_(GI[q * 64 + lane] + bx);
                        const float log_a = -8.0f * gr * sp;
                        const float a = expf(log_a);
                        const float u = sqrtf(-expm1f(2.0f * log_a)) * (gi * xcv);
                        hl = a * hl + u; ca = ca * a;
                        HLOC[(size_t)(r0 + t0 + q) * 512 + c] = hl; CUMA[(size_t)(r0 + t0 + q) * 512 + c] = ca;
                    }
                }
                WAVE_LDS_SYNC();
            }
            SUMM[(size_t)item * 128 + lane] = ca; SUMM[(size_t)item * 128 + 64 + lane] = hl;
        }
    }
    LAS float* qs = (LAS float*)((LAS unsigned char*)lds + 32768 + wave * ATT_WLDS);
    LAS float* ps = qs + 128;
    const float* rel_bias = P.in[8];
    const bf16* QKVB = (const bf16*)(P.ws + WS_QKVB);
    unsigned* qc1 = (unsigned*)(P.ws + WS_CTL) + CW_QUEUE + (l * 3 + 1) * 64;
    for (int item = qpop(qc1, lane); item < MS * 8; item = qpop(qc1, lane)) {
        const int r = MP + (item >> 3), h = item & 7; int s, t; row_to_seq(r, s, t);
        const int b = s - NB;
        const float* knew = P.out + O_K_S + ((size_t)l * MS + b * DS) * 1024 + h * 128;
        const float* vnew = P.out + O_V_S + ((size_t)l * MS + b * DS) * 1024 + h * 128;
        const bf16* qrow = QKVB + (size_t)r * 3072 + h * 128;
        qs[lane] = __uint_as_float((unsigned)qrow[lane] << 16); qs[64 + lane] = __uint_as_float((unsigned)qrow[64 + lane] << 16);
        WAVE_LDS_SYNC();
        float sc[9]; float mx = -INFINITY;
#pragma unroll
        for (int g = 0; g < 3; ++g) {
            const int dil = g == 0 ? 1 : (g == 1 ? 4 : 16);
#pragma unroll
            for (int jj = 0; jj < 3; ++jj) {
                const int j = jj * 64 + lane;
                const float* krow = nullptr;
                if (j <= 128) { const int idx = CACHE_W + t - dil * j;
                    if (idx < CACHE_W) krow = P.in[6] + ((((size_t)l * DB + b) * CACHE_W + idx) * 8 + h) * 128;
                    else krow = knew + (size_t)(idx - CACHE_W) * 1024; }
                float sv = -INFINITY;
                if (krow) {
                    float acc = 0.f;
#pragma unroll 4
                    for (int i = 0; i < 32; ++i) { const f32x4 kq = *(const f32x4*)(krow + 4 * i); const f32x4 qq = *(const LAS f32x4*)(qs + 4 * i);
                        acc += kq.x * qq.x + kq.y * qq.y + kq.z * qq.z + kq.w * qq.w; }
                    sv = acc * ATT_SCALE + att_bias(rel_bias, j * dil, h);
                }
                sc[g * 3 + jj] = sv; mx = fmaxf(mx, sv);
            }
        }
        mx = wave_max(mx);
        float sum = 0.f;
#pragma unroll
        for (int g = 0; g < 3; ++g)
#pragma unroll
            for (int jj = 0; jj < 3; ++jj) {
                const int j = jj * 64 + lane; const float sv = sc[g * 3 + jj];
                const float p = (sv == -INFINITY) ? 0.f : expf(sv - mx);
                sum += p;
                if (j <= 128) ps[g * 129 + j] = p;
            }
        sum = wave_sum(sum);
        const float inv = 1.0f / sum;
        WAVE_LDS_SYNC();
        float o0 = 0.f, o1 = 0.f;
        for (int g = 0; g < 3; ++g) {
            const int dil = g == 0 ? 1 : (g == 1 ? 4 : 16);
#pragma unroll 1
            for (int j0 = 0; j0 < 136; j0 += 8) {
                float pq[8]; f32x2 vq[8];
#pragma unroll
                for (int q = 0; q < 8; ++q) {
                    const int j = j0 + q; const bool in = j <= 128;
                    pq[q] = in ? ps[g * 129 + j] : 0.f;
                    const int idx = CACHE_W + t - dil * (in ? j : 0);
                    const float* vrow = (idx < CACHE_W) ? P.in[7] + ((((size_t)l * DB + b) * CACHE_W + idx) * 8 + h) * 128 : vnew + (size_t)(idx - CACHE_W) * 1024;
                    vq[q] = *(const f32x2*)(vrow + 2 * lane);
                }
#pragma unroll
                for (int q = 0; q < 8; ++q) { o0 += pq[q] * vq[q].x; o1 += pq[q] * vq[q].y; }
            }
        }
        *(unsigned*)(MIX + (size_t)r * D + 1024 + h * 128 + 2 * lane) = pk2(o0 * inv, o1 * inv);
        WAVE_LDS_SYNC();
    }
    {
        bf16* OPART = (bf16*)(P.ws + WS_OPART); float* LSE = (float*)(P.ws + WS_LSE);
        LAS unsigned char* wl = (LAS unsigned char*)lds + 32768 + wave * ATT_WLDS;
        LAS float* btab = (LAS float*)wl;
        LAS float* fl = (LAS float*)(wl + 528);
        LAS unsigned char* vt = wl + 1024;
        const int i32 = lane & 31, hi = lane >> 5, i16 = lane & 15, q4 = i16 >> 2, p4 = i16 & 3, blk = (lane >> 4) & 1;
        const int xq = bid & 7;
        unsigned* qc2 = (unsigned*)(P.ws + WS_CTL) + CW_QUEUE + 512 + (l * 8 + xq) * 64;
        for (int item = qpop(qc2, lane); item < NB * 192; item = qpop(qc2, lane)) {
            const int bh = xq + 8 * (item / 192), rem = item % 192, g = rem >> 6, e = rem & 63;
            const int b = bh >> 3, h = bh & 7;
            const int dil = g == 0 ? 1 : (g == 1 ? 4 : 16), lgn = g == 0 ? 6 : (g == 1 ? 4 : 2);
            const int c = e >> lgn, l0 = (e & ((1 << lgn) - 1)) * 32;
            const bf16* base = QKVB + ((size_t)b * SEQ + c) * 3072 + h * 128;
            const size_t rstride = (size_t)dil * 3072;
            for (int d = lane; d < 129; d += 64) btab[d] = att_bias(rel_bias, d * dil, h) * 1.4426950408889634f;
            bf16x8 qf[8];
            { const bf16* qp = base + (size_t)(l0 + i32) * rstride + hi * 8;
#pragma unroll
              for (int ks = 0; ks < 8; ++ks) qf[ks] = *(const bf16x8*)(qp + ks * 16); }
            WAVE_LDS_SYNC();
            const int jmin = l0 >= 128 ? 0 : (128 - l0) >> 5;
            f32x16 sc[5];
            float mloc = -INFINITY;
            bf16x8 kf[1][8];
#define ATT_LDK(SET, J) do { const bf16* kp_ = base + (size_t)(l0 - 128 + 32 * (J) + i32) * rstride + 1024 + hi * 8; \
                _Pragma("unroll") for (int ks = 0; ks < 8; ++ks) kf[SET][ks] = *(const bf16x8*)(kp_ + ks * 16); } while (0)
#pragma unroll
            for (int j = 0; j < 5; ++j) {
                if (j >= jmin) {
                    ATT_LDK(0, j);
                    f32x16 acc;
#pragma unroll
                    for (int r = 0; r < 16; ++r) acc[r] = 0.f;
#pragma unroll
                    for (int ks = 0; ks < 8; ++ks) acc = __builtin_amdgcn_mfma_f32_32x32x16_bf16(kf[0][ks], qf[ks], acc, 0, 0, 0);
#pragma unroll
                    for (int r = 0; r < 16; ++r) {
                        const int kk = (r & 3) + 8 * (r >> 2) + 4 * hi;
                        const int delta = i32 + 128 - 32 * j - kk;
                        bool ok = true;
                        if (j == 0) ok = kk >= i32;
                        if (j == 4) ok = kk <= i32;
                        const float sv = ok ? acc[r] * (ATT_SCALE * 1.4426950408889634f) + btab[ok ? delta : 0] : -INFINITY;
                        acc[r] = sv; mloc = fmaxf(mloc, sv);
                    }
                    sc[j] = acc;
                } else {
#pragma unroll
                    for (int r = 0; r < 16; ++r) sc[j][r] = -INFINITY;
                }
            }
#undef ATT_LDK
            v4u vr[1][8];
#define ATT_LDV(SET, J) do { _Pragma("unroll") for (int i = 0; i < 8; ++i) vr[0][i] = *(const v4u*)(base + (size_t)(l0 - 128 + 32 * (J) + 4 * i + (lane >> 4)) * rstride + 2048 + i16 * 8); } while (0)
            if (jmin == 0) ATT_LDV(0, 0);
            const float m = fmaxf(mloc, __shfl_xor(mloc, 32));
            float lsum = 0.f;
            bf16x8 pf[5][2];
#pragma unroll
            for (int j = 0; j < 5; ++j) {
#pragma unroll
                for (int r = 0; r < 16; ++r) { const float p = __builtin_amdgcn_exp2f(sc[j][r] - m); sc[j][r] = p; lsum += p; }
#pragma unroll
                for (int s2 = 0; s2 < 2; ++s2) {
                    v4u w; w.x = pk2(sc[j][8 * s2 + 0], sc[j][8 * s2 + 1]); w.y = pk2(sc[j][8 * s2 + 2], sc[j][8 * s2 + 3]);
                    w.z = pk2(sc[j][8 * s2 + 4], sc[j][8 * s2 + 5]); w.w = pk2(sc[j][8 * s2 + 6], sc[j][8 * s2 + 7]);
                    pf[j][s2] = __builtin_bit_cast(bf16x8, w);
                }
            }
            const float lt = lsum + __shfl_xor(lsum, 32);
            if (hi == 0) fl[i32] = 1.0f / lt;
            f32x16 o[4];
#pragma unroll
            for (int db = 0; db < 4; ++db)
#pragma unroll
                for (int r = 0; r < 16; ++r) o[db][r] = 0.f;
#pragma unroll
            for (int j = 0; j < 5; ++j) {
                if (j >= jmin) {
                    WAVE_LDS_SYNC();
#pragma unroll
                    for (int i = 0; i < 8; ++i) *(LAS v4u*)(vt + (4 * i + (lane >> 4)) * 320 + i16 * 16) = vr[0][i];
                }
                if (j + 1 < 5 && j + 1 >= jmin) ATT_LDV((j + 1) & 1, j + 1);
                if (j >= jmin) {
                    WAVE_LDS_SYNC();
                    s16x4 vlo[8], vhv[8];
#pragma unroll
                    for (int db = 0; db < 4; ++db)
#pragma unroll
                        for (int s2 = 0; s2 < 2; ++s2) {
                            const LAS unsigned char* a0 = vt + (16 * s2 + 4 * hi + q4) * 320 + (32 * db + 16 * blk + 4 * p4) * 2;
                            vlo[db * 2 + s2] = __builtin_bit_cast(s16x4, __builtin_amdgcn_ds_read_tr16_b64_v4i16((LAS s16x4*)a0));
                            vhv[db * 2 + s2] = __builtin_bit_cast(s16x4, __builtin_amdgcn_ds_read_tr16_b64_v4i16((LAS s16x4*)(a0 + 8 * 320)));
                        }
                    WAVE_LDS_SYNC();
                    __builtin_amdgcn_sched_barrier(0);
#pragma unroll
                    for (int db = 0; db < 4; ++db)
#pragma unroll
                        for (int s2 = 0; s2 < 2; ++s2) {
                            const s16x4 lo = vlo[db * 2 + s2], hv = vhv[db * 2 + s2];
                            const bf16x8 vf = (bf16x8){lo[0], lo[1], lo[2], lo[3], hv[0], hv[1], hv[2], hv[3]};
                            o[db] = __builtin_amdgcn_mfma_f32_32x32x16_bf16(pf[j][s2], vf, o[db], 0, 0, 0);
                        }
                    __builtin_amdgcn_sched_barrier(0);
                }
            }
#undef ATT_LDV
            WAVE_LDS_SYNC();
            float li[16];
#pragma unroll
            for (int r = 0; r < 16; ++r) li[r] = fl[(r & 3) + 8 * (r >> 2) + 4 * hi];
#pragma unroll
            for (int db = 0; db < 4; ++db)
#pragma unroll
                for (int r = 0; r < 16; ++r) *(LAS unsigned short*)(vt + ((r & 3) + 8 * (r >> 2) + 4 * hi) * 272 + (32 * db + i32) * 2) = (unsigned short)f2bf(o[db][r] * li[r]);
            WAVE_LDS_SYNC();
            bf16* og = OPART + (size_t)g * MP * 1024;
#pragma unroll
            for (int i = 0; i < 8; ++i) { const int row = 4 * i + (lane >> 4);
                const v4u v = *(const LAS v4u*)(vt + row * 272 + i16 * 16);
                *(v4u*)(og + ((size_t)b * SEQ + (size_t)(l0 + row) * dil + c) * 1024 + h * 128 + i16 * 8) = v; }
            if (hi == 0) LSE[((size_t)g * MP + (size_t)b * SEQ + (size_t)(l0 + i32) * dil + c) * 8 + h] = (m + __builtin_amdgcn_logf(lt)) * 0.6931471805599453f;
            WAVE_LDS_SYNC();
        }
    }
}

template <int CTRL, int RM> __device__ __forceinline__ float dpp0(float x) { return __int_as_float(__builtin_amdgcn_update_dpp(0, __float_as_int(x), CTRL, RM, 0xF, false)); }
__device__ __forceinline__ float wave_total(float x) {
    x += dpp0<0xB1, 0xF>(x); x += dpp0<0x4E, 0xF>(x); x += dpp0<0x141, 0xF>(x); x += dpp0<0x140, 0xF>(x);
    x += dpp0<0x142, 0xA>(x); x += dpp0<0x143, 0xC>(x);
    return rdl(x, 63);
}
constexpr int SCAN_ITEMS = NSEQ * 8 * 8;
constexpr int SCAN_Q = 5 * 2048 + 256;
constexpr int SCAN_AB = SCAN_Q + 1024;
constexpr int SCAN_BUF = SCAN_AB + 32;
__device__ __forceinline__ void scan_stage_store(LAS float* buf, const f32x4 (&st)[6], int tid, int stt, int sk4) {
    LAS float* d = buf + stt * 64 + sk4;
#pragma unroll
    for (int a = 0; a < 5; ++a) *(LAS f32x4*)(d + a * 2048) = st[a];
    if (tid < 64) *(LAS f32x4*)(buf + 10240 + (tid >> 1) * 8 + (tid & 1) * 4) = st[5];
    f32x4 kn;
    kn.x = __shfl_down(st[0].x, 16); kn.y = __shfl_down(st[0].y, 16); kn.z = __shfl_down(st[0].z, 16); kn.w = __shfl_down(st[0].w, 16);
    float pa = st[2].x * kn.x + st[2].y * kn.y + st[2].z * kn.z + st[2].w * kn.w;
    float pb = st[3].x * kn.x + st[3].y * kn.y + st[3].z * kn.z + st[3].w * kn.w;
    pa += dpp0<0xB1, 0xF>(pa); pa += dpp0<0x4E, 0xF>(pa); pa += dpp0<0x141, 0xF>(pa); pa += dpp0<0x140, 0xF>(pa);
    pb += dpp0<0xB1, 0xF>(pb); pb += dpp0<0x4E, 0xF>(pb); pb += dpp0<0x141, 0xF>(pb); pb += dpp0<0x140, 0xF>(pb);
    if ((stt & 1) == 0) {
        *(LAS f32x4*)(buf + SCAN_Q + (stt >> 1) * 64 + sk4) = st[1] * kn;
        if (sk4 == 0) { buf[SCAN_AB + stt] = pa; buf[SCAN_AB + stt + 1] = pb; }
    }
}
template <int CTRL> __device__ __forceinline__ float dppa(float x) { return x + __int_as_float(__builtin_amdgcn_update_dpp(0, __float_as_int(x), CTRL, 0xF, 0xF, true)); }
__device__ __forceinline__ float row16_sum(float x) { x = dppa<0xB1>(x); x = dppa<0x4E>(x); x = dppa<0x141>(x); x = dppa<0x140>(x); return x; }
__device__ __forceinline__ void ph_scan(const Params& P, int l, int bid, int nb, int tid, int wave, int lane, LAS float* lds) {
    const float* RWB = (const float*)(P.ws + WS_RWB);
    float* YRAW = (float*)(P.ws + WS_YRAW);
    float* out = P.out;
    LAS float* Pw = lds + 2 * SCAN_BUF + wave * (16 * 68);
    const int stt = tid >> 4, sk4 = (tid & 15) * 4;
    const int rw = lane >> 4, kq4 = (lane & 15) * 4;
    for (int item = bid; item < SCAN_ITEMS; item += nb) {
        int s, h, rg;
        if (item < NB * 64) { s = item >> 6; h = (item >> 3) & 7; rg = item & 7; }
        else { const int q = item - NB * 64; s = NB + (q >> 6); h = (q >> 3) & 7; rg = q & 7; }
        int row0, T; seq_of(s, row0, T);
        const int v = rg * 8 + (wave & 1) * 4 + rw;
        f32x4 S = (f32x4){0.f, 0.f, 0.f, 0.f};
        if (s >= NB && wave < 2) S = *(const f32x4*)(P.in[2] + ((((size_t)l * DB + (s - NB)) * 8 + h) * 64 + v) * 64 + kq4);
        const int nchunk = (T + 31) >> 5;
        f32x4 st[6];
        {
            const bool ok = stt < T;
            const float* src = RWB + (size_t)(row0 + (ok ? stt : 0)) * 3584 + h * 64 + sk4;
            st[0] = *(const f32x4*)(src + 2048); st[1] = *(const f32x4*)(src + 512); st[2] = *(const f32x4*)(src + 2560); st[3] = *(const f32x4*)(src + 1024); st[4] = *(const f32x4*)(src);
            if (tid < 64) { const int vt = tid >> 1; st[5] = *(const f32x4*)(RWB + (size_t)(row0 + (vt < T ? vt : 0)) * 3584 + 1536 + h * 64 + rg * 8 + (tid & 1) * 4); }
            scan_stage_store(lds, st, tid, stt, sk4);
        }
        __syncthreads();
        for (int ch = 0; ch < nchunk; ++ch) {
            const LAS float* cur = lds + (ch & 1) * SCAN_BUF;
            const bool more = ch + 1 < nchunk;
            if (more) {
                const int t1 = (ch + 1) * 32;
                const bool ok = t1 + stt < T;
                const float* src = RWB + (size_t)(row0 + (ok ? t1 + stt : 0)) * 3584 + h * 64 + sk4;
                st[0] = *(const f32x4*)(src + 2048); st[1] = *(const f32x4*)(src + 512); st[2] = *(const f32x4*)(src + 2560); st[3] = *(const f32x4*)(src + 1024); st[4] = *(const f32x4*)(src);
                if (tid < 64) { const int vt = t1 + (tid >> 1); st[5] = *(const f32x4*)(RWB + (size_t)(row0 + (vt < T ? vt : 0)) * 3584 + 1536 + h * 64 + rg * 8 + (tid & 1) * 4); }
            }
            const int nsteps = (T - ch * 32) < 32 ? (T - ch * 32) : 32;
            if (wave < 2) {
                const LAS float* cl = cur + kq4;
                const LAS float* cvp = cur + 10240 + (wave & 1) * 4 + rw;
#define SCAN_DECL(X) f32x4 kk##X, qv##X, w0##X, b0##X, p0##X, r0##X, w1##X, b1##X, p1##X, r1##X; float v0##X, v1##X, al##X, be##X
#define SCAN_LD(T2, X) do { const int t_ = (T2); \
                    kk##X = *(const LAS f32x4*)(cl + t_ * 64); qv##X = *(const LAS f32x4*)(cur + SCAN_Q + (t_ >> 1) * 64 + kq4); \
                    w0##X = *(const LAS f32x4*)(cl + 2048 + t_ * 64); b0##X = *(const LAS f32x4*)(cl + 4096 + t_ * 64); p0##X = *(const LAS f32x4*)(cl + 6144 + t_ * 64); r0##X = *(const LAS f32x4*)(cl + 8192 + t_ * 64); \
                    w1##X = *(const LAS f32x4*)(cl + 2048 + t_ * 64 + 64); b1##X = *(const LAS f32x4*)(cl + 4096 + t_ * 64 + 64); p1##X = *(const LAS f32x4*)(cl + 6144 + t_ * 64 + 64); r1##X = *(const LAS f32x4*)(cl + 8192 + t_ * 64 + 64); \
                    v0##X = cvp[t_ * 8]; v1##X = cvp[t_ * 8 + 8]; al##X = cur[SCAN_AB + t_]; be##X = cur[SCAN_AB + t_ + 1]; } while (0)
#define LO(v) (v).xy
#define HI(v) (v).zw
#define SCAN_PAIR(T2, X) do { \
                    f32x2 e1 = Sa * LO(kk##X); e1 = Sb * HI(kk##X) + e1; f32x2 e2 = Sa * LO(qv##X); e2 = Sb * HI(qv##X) + e2; \
                    const float d1 = row16_sum(e1.x + e1.y), d2 = row16_sum(e2.x + e2.y); \
                    const float sa0 = -d1; const float sa1 = -d2 - v0##X * be##X - sa0 * al##X; \
                    const f32x2 vv0 = (f32x2){v0##X, v0##X}, vv1 = (f32x2){v1##X, v1##X}, ss0 = (f32x2){sa0, sa0}, ss1 = (f32x2){sa1, sa1}; \
                    Sa = Sa * LO(w0##X) + (LO(b0##X) * ss0 + LO(p0##X) * vv0); Sb = Sb * HI(w0##X) + (HI(b0##X) * ss0 + HI(p0##X) * vv0); \
                    f32x2 y0 = Sa * LO(r0##X); y0 = Sb * HI(r0##X) + y0; \
                    Sa = Sa * LO(w1##X) + (LO(b1##X) * ss1 + LO(p1##X) * vv1); Sb = Sb * HI(w1##X) + (HI(b1##X) * ss1 + HI(p1##X) * vv1); \
                    f32x2 y1 = Sa * LO(r1##X); y1 = Sb * HI(r1##X) + y1; \
                    Pw[((T2) & 15) * 68 + lane] = y0.x + y0.y; Pw[(((T2) & 15) + 1) * 68 + lane] = y1.x + y1.y; \
                    if ((((T2) + 2) & 15) == 0 || (T2) + 2 >= nsteps) { \
                        const int hb = (T2) & ~15, ns = (T2) + 2 - hb; \
                        WAVE_LDS_SYNC(); \
                        { const int t = lane >> 2, rr = lane & 3; \
                          const LAS f32x4* pp = (const LAS f32x4*)(Pw + t * 68 + rr * 16); \
                          const f32x4 a0 = pp[0], a1 = pp[1], a2 = pp[2], a3 = pp[3]; \
                          const float y = ((a0.x + a0.y) + (a0.z + a0.w)) + ((a1.x + a1.y) + (a1.z + a1.w)) + ((a2.x + a2.y) + (a2.z + a2.w)) + ((a3.x + a3.y) + (a3.z + a3.w)); \
                          if (t < ns) YRAW[(size_t)(row0 + ch * 32 + hb + t) * 512 + h * 64 + rg * 8 + (wave & 1) * 4 + rr] = y; } \
                        WAVE_LDS_SYNC(); } } while (0)
                f32x2 Sa = S.xy, Sb = S.zw;
                SCAN_DECL(A); SCAN_DECL(B);
                SCAN_LD(0, A);
#pragma unroll 1
                for (int t2 = 0; t2 < nsteps; t2 += 4) {
                    SCAN_LD(t2 + 2, B);
                    SCAN_PAIR(t2, A);
                    SCAN_LD((t2 + 4 < 32) ? t2 + 4 : t2, A);
                    SCAN_PAIR(t2 + 2, B);
                }
                S.xy = Sa; S.zw = Sb;
#undef SCAN_PAIR
#undef LO
#undef HI
#undef SCAN_DECL
            }
#undef SCAN_LD
            if (more) scan_stage_store(lds + ((ch + 1) & 1) * SCAN_BUF, st, tid, stt, sk4);
            __syncthreads();
        }
        if (wave < 2) {
            float* so = (s < NB) ? out + O_WKV_P + ((((size_t)l * NB + s) * 8 + h) * 64 + v) * 64
                                 : out + O_WKV_S + ((((size_t)l * DB + (s - NB)) * 8 + h) * 64 + v) * 64;
            *(f32x4*)(so + kq4) = S;
        }
    }
}
constexpr int S2_ARR = 16 * 64, S2_V = 5 * S2_ARR, S2_Q = S2_V + 128, S2_AB = S2_Q + 512, S2_BUF = S2_AB + 32;
struct Scan2St { f32x4 a[2][5]; f32x4 v; };
__device__ __forceinline__ void scan2_load(Scan2St& st, const float* RWB, int row0, int t0, int T, int h, int rg, int tid) {
    const int sk4 = (tid & 15) * 4;
#pragma unroll
    for (int i = 0; i < 2; ++i) { const int t = t0 + (tid >> 4) + 8 * i;
        const float* src = RWB + (size_t)(row0 + (t < T ? t : 0)) * 3584 + h * 64 + sk4;
        st.a[i][0] = *(const f32x4*)(src + 2048); st.a[i][1] = *(const f32x4*)(src + 512); st.a[i][2] = *(const f32x4*)(src + 2560); st.a[i][3] = *(const f32x4*)(src + 1024); st.a[i][4] = *(const f32x4*)(src); }
    if (tid < 32) { const int vt = t0 + (tid >> 1); st.v = *(const f32x4*)(RWB + (size_t)(row0 + (vt < T ? vt : 0)) * 3584 + 1536 + h * 64 + rg * 8 + (tid & 1) * 4); }
}
__device__ __forceinline__ void scan2_store(LAS float* buf, const Scan2St& st, int tid) {
    const int sk4 = (tid & 15) * 4;
#pragma unroll
    for (int i = 0; i < 2; ++i) { const int stt = (tid >> 4) + 8 * i;
        LAS float* d = buf + stt * 64 + sk4;
#pragma unroll
        for (int a = 0; a < 5; ++a) *(LAS f32x4*)(d + a * S2_ARR) = st.a[i][a];
        f32x4 kn;
        kn.x = __shfl_down(st.a[i][0].x, 16); kn.y = __shfl_down(st.a[i][0].y, 16); kn.z = __shfl_down(st.a[i][0].z, 16); kn.w = __shfl_down(st.a[i][0].w, 16);
        float pa = st.a[i][2].x * kn.x + st.a[i][2].y * kn.y + st.a[i][2].z * kn.z + st.a[i][2].w * kn.w;
        float pb = st.a[i][3].x * kn.x + st.a[i][3].y * kn.y + st.a[i][3].z * kn.z + st.a[i][3].w * kn.w;
        pa = row16_sum(pa); pb = row16_sum(pb);
        if ((stt & 1) == 0) {
            *(LAS f32x4*)(buf + S2_Q + (stt >> 1) * 64 + sk4) = st.a[i][1] * kn;
            if (sk4 == 0) { buf[S2_AB + stt] = pa; buf[S2_AB + stt + 1] = pb; }
        } }
    if (tid < 32) *(LAS f32x4*)(buf + S2_V + (tid >> 1) * 8 + (tid & 1) * 4) = st.v;
}
__device__ __forceinline__ void scan2_meet(volatile LAS unsigned* fl, int wave, unsigned seq, int lane) {
    WAVE_LDS_SYNC();
    if (lane == 0) fl[wave] = seq;
    while (fl[wave ^ 1] < seq) { }
    asm volatile("" ::: "memory");
}
__device__ __forceinline__ void ph_scan2(const Params& P, int l, int item0, int istride, int tid, int wave, int lane, LAS float* lds, volatile LAS unsigned* fl) {
    const float* RWB = (const float*)(P.ws + WS_RWB);
    float* YRAW = (float*)(P.ws + WS_YRAW);
    float* out = P.out;
    LAS float* Pw = lds + 2 * S2_BUF + wave * (16 * 68);
    const int rw = lane >> 4, kq4 = (lane & 15) * 4;
    unsigned seq = (unsigned)l * 1000000u + 1u;
    for (int item = item0; item < SCAN_ITEMS; item += istride) {
        int s, h, rg;
        if (item < NB * 64) { s = item >> 6; h = (item >> 3) & 7; rg = item & 7; }
        else { const int q = item - NB * 64; s = NB + (q >> 6); h = (q >> 3) & 7; rg = q & 7; }
        int row0, T; seq_of(s, row0, T);
        const int v = rg * 8 + wave * 4 + rw;
        f32x4 S = (f32x4){0.f, 0.f, 0.f, 0.f};
        if (s >= NB) S = *(const f32x4*)(P.in[2] + ((((size_t)l * DB + (s - NB)) * 8 + h) * 64 + v) * 64 + kq4);
        const int nchunk = (T + 15) >> 4;
        Scan2St st;
        scan2_load(st, RWB, row0, 0, T, h, rg, tid);
        scan2_store(lds, st, tid);
        scan2_meet(fl, wave, seq++, lane);
        for (int ch = 0; ch < nchunk; ++ch) {
            const LAS float* cur = lds + (ch & 1) * S2_BUF;
            const bool more = ch + 1 < nchunk;
            if (more) scan2_load(st, RWB, row0, (ch + 1) * 16, T, h, rg, tid);
            const int nsteps = (T - ch * 16) < 16 ? (T - ch * 16) : 16;
            const LAS float* cl = cur + kq4;
            const LAS float* cvp = cur + S2_V + wave * 4 + rw;
#define SCAN_DECL(X) f32x4 kk##X, qv##X, w0##X, b0##X, p0##X, r0##X, w1##X, b1##X, p1##X, r1##X; float v0##X, v1##X, al##X, be##X
#define SCAN_LD(T2, X) do { const int t_ = (T2); \
                kk##X = *(const LAS f32x4*)(cl + t_ * 64); qv##X = *(const LAS f32x4*)(cur + S2_Q + (t_ >> 1) * 64 + kq4); \
                w0##X = *(const LAS f32x4*)(cl + S2_ARR + t_ * 64); b0##X = *(const LAS f32x4*)(cl + 2 * S2_ARR + t_ * 64); p0##X = *(const LAS f32x4*)(cl + 3 * S2_ARR + t_ * 64); r0##X = *(const LAS f32x4*)(cl + 4 * S2_ARR + t_ * 64); \
                w1##X = *(const LAS f32x4*)(cl + S2_ARR + t_ * 64 + 64); b1##X = *(const LAS f32x4*)(cl + 2 * S2_ARR + t_ * 64 + 64); p1##X = *(const LAS f32x4*)(cl + 3 * S2_ARR + t_ * 64 + 64); r1##X = *(const LAS f32x4*)(cl + 4 * S2_ARR + t_ * 64 + 64); \
                v0##X = cvp[t_ * 8]; v1##X = cvp[t_ * 8 + 8]; al##X = cur[S2_AB + t_]; be##X = cur[S2_AB + t_ + 1]; } while (0)
#define LO(v) (v).xy
#define HI(v) (v).zw
#define SCAN_PAIR(T2, X) do { \
                f32x2 e1 = Sa * LO(kk##X); e1 = Sb * HI(kk##X) + e1; f32x2 e2 = Sa * LO(qv##X); e2 = Sb * HI(qv##X) + e2; \
                const float d1 = row16_sum(e1.x + e1.y), d2 = row16_sum(e2.x + e2.y); \
                const float sa0 = -d1; const float sa1 = -d2 - v0##X * be##X - sa0 * al##X; \
                const f32x2 vv0 = (f32x2){v0##X, v0##X}, vv1 = (f32x2){v1##X, v1##X}, ss0 = (f32x2){sa0, sa0}, ss1 = (f32x2){sa1, sa1}; \
                Sa = Sa * LO(w0##X) + (LO(b0##X) * ss0 + LO(p0##X) * vv0); Sb = Sb * HI(w0##X) + (HI(b0##X) * ss0 + HI(p0##X) * vv0); \
                f32x2 y0 = Sa * LO(r0##X); y0 = Sb * HI(r0##X) + y0; \
                Sa = Sa * LO(w1##X) + (LO(b1##X) * ss1 + LO(p1##X) * vv1); Sb = Sb * HI(w1##X) + (HI(b1##X) * ss1 + HI(p1##X) * vv1); \
                f32x2 y1 = Sa * LO(r1##X); y1 = Sb * HI(r1##X) + y1; \
                Pw[(T2) * 68 + lane] = y0.x + y0.y; Pw[((T2) + 1) * 68 + lane] = y1.x + y1.y; } while (0)
            f32x2 Sa = S.xy, Sb = S.zw;
            SCAN_DECL(A); SCAN_DECL(B);
            SCAN_LD(0, A);
#pragma unroll 1
            for (int t2 = 0; t2 < nsteps; t2 += 4) {
                SCAN_LD(t2 + 2, B);
                SCAN_PAIR(t2, A);
                SCAN_LD((t2 + 4 < 16) ? t2 + 4 : t2, A);
                SCAN_PAIR(t2 + 2, B);
            }
            S.xy = Sa; S.zw = Sb;
#undef SCAN_PAIR
#undef LO
#undef HI
#undef SCAN_LD
#undef SCAN_DECL
            WAVE_LDS_SYNC();
            {
                const int t = lane >> 2, rr = lane & 3;
                const LAS f32x4* pp = (const LAS f32x4*)(Pw + t * 68 + rr * 16);
                const f32x4 a0 = pp[0], a1 = pp[1], a2 = pp[2], a3 = pp[3];
                const float y = ((a0.x + a0.y) + (a0.z + a0.w)) + ((a1.x + a1.y) + (a1.z + a1.w)) + ((a2.x + a2.y) + (a2.z + a2.w)) + ((a3.x + a3.y) + (a3.z + a3.w));
                if (t < nsteps) YRAW[(size_t)(row0 + ch * 16 + t) * 512 + h * 64 + rg * 8 + wave * 4 + rr] = y;
            }
            if (more) scan2_store(lds + ((ch + 1) & 1) * S2_BUF, st, tid);
            scan2_meet(fl, wave, seq++, lane);
        }
        float* so = (s < NB) ? out + O_WKV_P + ((((size_t)l * NB + s) * 8 + h) * 64 + v) * 64
                             : out + O_WKV_S + ((((size_t)l * DB + (s - NB)) * 8 + h) * 64 + v) * 64;
        *(f32x4*)(so + kq4) = S;
    }
}
__device__ __forceinline__ f32x4 mfma4(float a, float b, f32x4 c) { return __builtin_amdgcn_mfma_f32_16x16x4f32(a, b, c, 0, 0, 0); }
template <int N> __device__ __forceinline__ float dpp_shr1(float x) {
    return __int_as_float(__builtin_amdgcn_update_dpp(0x3f800000, __float_as_int(x), 0x110 + N, 0xF, 0xF, false)); }
constexpr int CPRE_ITEMS = NB * 128 * 8;
__device__ __forceinline__ void ph_chunkpre(const Params& P, int l, int gw, int ngw, int wave, int lane, LAS float* lds) {
    const float* RWB = (const float*)(P.ws + WS_RWB);
    float* CHKA = (float*)(P.ws + WS_CHKA); float* CHKB = (float*)(P.ws + WS_CHKB);
    LAS float* M0 = lds + wave * 1152; LAS float* M1 = M0 + 272; LAS float* M2 = M1 + 272; LAS float* M3 = M2 + 272;
    const int tl = lane & 15, kg = lane >> 4;
    for (int it = gw; it < CPRE_ITEMS; it += ngw) {
        const int h = it & 7, ci = (it >> 3) & 127, s = it >> 10;
        const float* base = RWB + (size_t)(s * SEQ + ci * 16 + tl) * 3584 + h * 64 + 4 * kg;
        float w[16], kk[16], b[16], kp[16], r[16];
#pragma unroll
        for (int j = 0; j < 4; ++j) { const f32x4 v0 = *(const f32x4*)(base + 512 + 16 * j), v1 = *(const f32x4*)(base + 2048 + 16 * j), v2 = *(const f32x4*)(base + 2560 + 16 * j),
                                                  v3 = *(const f32x4*)(base + 1024 + 16 * j), v4 = *(const f32x4*)(base + 16 * j);
#pragma unroll
            for (int i = 0; i < 4; ++i) { w[4 * j + i] = v0[i]; kk[4 * j + i] = v1[i]; b[4 * j + i] = v2[i]; kp[4 * j + i] = v3[i]; r[4 * j + i] = v4[i]; } }
        f32x4 g1 = (f32x4){0.f, 0.f, 0.f, 0.f}, g2 = g1, g3 = g1, g4 = g1;
        float* ca = CHKA + (size_t)it * 2048; float* cb = CHKB + (size_t)it * 3136;
#pragma unroll
        for (int j = 0; j < 4; ++j) {
            f32x4 bwv, kwv, wcv;
#pragma unroll
            for (int i = 0; i < 4; ++i) { const int q = 4 * j + i;
                float x = w[q];
                x *= dpp_shr1<1>(x); x *= dpp_shr1<2>(x); x *= dpp_shr1<4>(x); x *= dpp_shr1<8>(x);
                const float wex = dpp_shr1<1>(x);
                const float wcq = __shfl(x, (lane & 48) | 15);
                const float inv = __builtin_amdgcn_rcpf(x);
                const float bt = b[q] * inv, kt = kp[q] * inv, qv = wex * kk[q], rho = x * r[q];
                g1 = mfma4(bt, qv, g1); g2 = mfma4(kt, qv, g2); g3 = mfma4(bt, rho, g3); g4 = mfma4(kt, rho, g4);
                const int k = 16 * j + 4 * kg + i;
                ca[k * 16 + tl] = qv; ca[1024 + k * 16 + tl] = rho;
                bwv[i] = bt * wcq; kwv[i] = kt * wcq; wcv[i] = x; }
            const int k0 = 16 * j + 4 * kg;
            *(f32x4*)(cb + 1024 + tl * 64 + k0) = bwv; *(f32x4*)(cb + 2048 + tl * 64 + k0) = kwv;
            if (tl == 15) *(f32x4*)(cb + 3072 + k0) = wcv;
        }
        f32x4 Um, Ubm, Gym, Hym;
#pragma unroll
        for (int e = 0; e < 4; ++e) { const int i = 4 * kg + e; Um[e] = i < tl ? g1[e] : 0.f; Ubm[e] = i < tl ? g2[e] : 0.f; Gym[e] = i <= tl ? g3[e] : 0.f; Hym[e] = i <= tl ? g4[e] : 0.f; }
#define CP_ST(M, X) do { _Pragma("unroll") for (int e = 0; e < 4; ++e) (M)[(4 * kg + e) * 17 + tl] = (X)[e]; } while (0)
#define CP_D(s4) ((tl == 4 * (s4) + kg) ? 1.f : 0.f)
#define CP_MM(OUT, MA, MB, FA, FB) do { float av_[4], bv_[4]; \
            __builtin_amdgcn_sched_barrier(0); \
            _Pragma("unroll") for (int s4 = 0; s4 < 4; ++s4) { av_[s4] = (MA)[tl * 17 + 4 * s4 + kg]; bv_[s4] = (MB)[(4 * s4 + kg) * 17 + tl]; } \
            _Pragma("unroll") for (int s4 = 0; s4 < 4; ++s4) { if (FA) av_[s4] = CP_D(s4) - av_[s4]; if (FB) bv_[s4] = CP_D(s4) + bv_[s4]; } \
            __builtin_amdgcn_sched_barrier(0); \
            OUT = (f32x4){0.f, 0.f, 0.f, 0.f}; \
            _Pragma("unroll") for (int s4 = 0; s4 < 4; ++s4) OUT = mfma4(av_[s4], bv_[s4], OUT); \
            __builtin_amdgcn_sched_barrier(0); } while (0)
        f32x4 Tm;
        {
            CP_ST(M0, Um); WAVE_LDS_SYNC();
            f32x4 x2; CP_MM(x2, M0, M0, false, false);
            CP_ST(M1, x2); WAVE_LDS_SYNC();
            f32x4 x4; CP_MM(x4, M1, M1, false, false);
            CP_ST(M2, x4); WAVE_LDS_SYNC();
            f32x4 x8; CP_MM(x8, M2, M2, false, false);
            CP_ST(M3, x8); WAVE_LDS_SYNC();
            f32x4 p; CP_MM(p, M0, M1, true, true);
            CP_ST(M0, p); WAVE_LDS_SYNC();
            f32x4 p2; CP_MM(p2, M0, M2, false, true);
            CP_ST(M0, p2); WAVE_LDS_SYNC();
            CP_MM(Tm, M0, M3, false, true);
        }
#undef CP_MM
#undef CP_ST
#undef CP_D
#pragma unroll
        for (int e = 0; e < 4; ++e) { const int o = (4 * kg + e) * 16 + tl; cb[o] = Ubm[e]; cb[256 + o] = Tm[e]; cb[512 + o] = Gym[e]; cb[768 + o] = Hym[e]; }
    }
}
constexpr int CS_S = 0, CS_P1QA = 1040, CS_P1QB = CS_P1QA + 272, CS_P1RA = CS_P1QB + 272, CS_P1RB = CS_P1RA + 272, CS_VU = CS_P1RB + 272, CS_VH = CS_VU + 272,
              CS_VK = CS_VH + 272, CS_V = CS_VK + 1040, CS_CH = CS_V + 2 * 272, CS_SAT = CS_CH + 2 * 5184, CS_END = CS_SAT + 8 * 272;
static_assert(CS_END * 4 <= 131072, "chunked scan LDS");
template <int KSTEPS> __device__ __forceinline__ f32x4 cs_mm(const LAS float* A, int lda, const LAS float* B, int ldb, f32x4 acc, int tl, int kg) {
    float av[KSTEPS], bv[KSTEPS];
    __builtin_amdgcn_sched_barrier(0);
#pragma unroll
    for (int s4 = 0; s4 < KSTEPS; ++s4) { av[s4] = A[tl * lda + 4 * s4 + kg]; bv[s4] = B[(4 * s4 + kg) * ldb + tl]; }
    __builtin_amdgcn_sched_barrier(0);
#pragma unroll
    for (int s4 = 0; s4 < KSTEPS; ++s4) acc = mfma4(av[s4], bv[s4], acc);
    __builtin_amdgcn_sched_barrier(0);
    return acc;
}
struct CsPre { f32x4 a, b0, b1, v; };
__device__ __forceinline__ void cs_load(CsPre& p, const float* CHKA, const float* CHKB, const float* RWB, int itc, int row, int h, int vbase, int tid) {
    p.a = *(const f32x4*)(CHKA + (size_t)itc * 2048 + tid * 4);
    p.b0 = *(const f32x4*)(CHKB + (size_t)itc * 3136 + tid * 4);
    if (tid < 272) p.b1 = *(const f32x4*)(CHKB + (size_t)itc * 3136 + 2048 + tid * 4);
    if (tid < 64) p.v = *(const f32x4*)(RWB + (size_t)(row + (tid >> 2)) * 3584 + 1536 + h * 64 + vbase + (tid & 3) * 4);
}
__device__ __forceinline__ void cs_store(LAS float* lds, int buf, const CsPre& p, int tid) {
    LAS float* ch = lds + CS_CH + buf * 5184;
    *(LAS f32x4*)(ch + tid * 4) = p.a;
    *(LAS f32x4*)(ch + 2048 + tid * 4) = p.b0;
    if (tid < 272) *(LAS f32x4*)(ch + 4096 + tid * 4) = p.b1;
    if (tid < 64) { LAS float* vr = lds + CS_V + buf * 272; const int i = tid >> 2, r4 = (tid & 3) * 4;
        vr[(r4 + 0) * 17 + i] = p.v.x; vr[(r4 + 1) * 17 + i] = p.v.y; vr[(r4 + 2) * 17 + i] = p.v.z; vr[(r4 + 3) * 17 + i] = p.v.w; }
}
__device__ __forceinline__ void ph_cscan(const Params& P, int l, int bid, int tid, int wave, int lane, LAS float* lds) {
    const float* RWB = (const float*)(P.ws + WS_RWB);
    const float* CHKA = (const float*)(P.ws + WS_CHKA); const float* CHKB = (const float*)(P.ws + WS_CHKB);
    float* YRAW = (float*)(P.ws + WS_YRAW);
    const int bh = bid >> 2, rgp = bid & 3, s = bh >> 3, h = bh & 7, row0 = s * SEQ, vbase = rgp * 16;
    const int tl = lane & 15, kg = lane >> 4;
    const int it0 = (s * 128) * 8 + h;
    for (int i = tid; i < 1040; i += 512) lds[CS_S + i] = 0.f;
    CsPre pa, pb;
    cs_load(pa, CHKA, CHKB, RWB, it0, row0, h, vbase, tid);
    cs_store(lds, 0, pa, tid);
    cs_load(pa, CHKA, CHKB, RWB, it0 + 8, row0 + 16, h, vbase, tid);
    __syncthreads();
    LAS float* sat = lds + CS_SAT + wave * 272;
    const f32x4 z4 = (f32x4){0.f, 0.f, 0.f, 0.f};
#pragma unroll 1
    for (int c = 0; c < 128; ++c) {
        const LAS float* ch = lds + CS_CH + (c & 1) * 5184;
        const LAS float* vr = lds + CS_V + (c & 1) * 272;
        if (c + 2 < 128) cs_load(pb, CHKA, CHKB, RWB, it0 + 8 * (c + 2), row0 + 16 * (c + 2), h, vbase, tid);
        if (wave < 4) {
            const LAS float* Bm = ch + (wave >> 1) * 1024 + (wave & 1) * 32 * 16;
            f32x4 acc = cs_mm<8>(lds + CS_S + (wave & 1) * 32, 65, Bm, 16, z4, tl, kg);
            LAS float* o = lds + CS_P1QA + wave * 272;
#pragma unroll
            for (int e = 0; e < 4; ++e) o[(4 * kg + e) * 17 + tl] = acc[e];
        } else if (wave == 4) {
            const f32x4 a1 = cs_mm<4>(vr, 17, ch + 2048, 16, z4, tl, kg);
#pragma unroll
            for (int e = 0; e < 4; ++e) lds[CS_VU + (4 * kg + e) * 17 + tl] = a1[e];
            const f32x4 a2 = cs_mm<4>(vr, 17, ch + 2048 + 768, 16, z4, tl, kg);
#pragma unroll
            for (int e = 0; e < 4; ++e) lds[CS_VH + (4 * kg + e) * 17 + tl] = a2[e];
        } else if (wave < 7) {
#pragma unroll
            for (int j2 = 0; j2 < 2; ++j2) { const int j = (wave - 5) * 2 + j2;
                f32x4 a1 = cs_mm<4>(vr, 17, ch + 4096 + 16 * j, 64, z4, tl, kg);
#pragma unroll
                for (int e = 0; e < 4; ++e) lds[CS_VK + (4 * kg + e) * 65 + 16 * j + tl] = a1[e]; }
        }
        __syncthreads();
        f32x4 sa = z4;
        {   float cm[4], tb[4];
            __builtin_amdgcn_sched_barrier(0);
#pragma unroll
            for (int s4 = 0; s4 < 4; ++s4) { const int o = tl * 17 + 4 * s4 + kg;
                cm[s4] = -(lds[CS_P1QA + o] + lds[CS_P1QB + o] + lds[CS_VU + o]); tb[s4] = ch[2048 + 256 + (4 * s4 + kg) * 16 + tl]; }
            __builtin_amdgcn_sched_barrier(0);
#pragma unroll
            for (int s4 = 0; s4 < 4; ++s4) sa = mfma4(cm[s4], tb[s4], sa);
            __builtin_amdgcn_sched_barrier(0);
        }
#pragma unroll
        for (int e = 0; e < 4; ++e) sat[(4 * kg + e) * 17 + tl] = sa[e];
        WAVE_LDS_SYNC();
        if (wave < 4) {
            float sv[4], vk[4]; const float dw = ch[5120 + 16 * wave + tl];
#pragma unroll
            for (int e = 0; e < 4; ++e) { const int o = (4 * kg + e) * 65 + 16 * wave + tl; sv[e] = lds[CS_S + o]; vk[e] = lds[CS_VK + o]; }
            f32x4 acc = cs_mm<4>(sat, 17, ch + 3072 + 16 * wave, 64, z4, tl, kg);
#pragma unroll
            for (int e = 0; e < 4; ++e) { const int o = (4 * kg + e) * 65 + 16 * wave + tl; lds[CS_S + o] = sv[e] * dw + vk[e] + acc[e]; }
        } else if (wave == 4) {
            float ad[4];
#pragma unroll
            for (int e = 0; e < 4; ++e) { const int o = (4 * kg + e) * 17 + tl; ad[e] = lds[CS_P1RA + o] + lds[CS_P1RB + o] + lds[CS_VH + o]; }
            f32x4 acc = cs_mm<4>(sat, 17, ch + 2048 + 512, 16, z4, tl, kg);
            f32x4 yv;
#pragma unroll
            for (int e = 0; e < 4; ++e) yv[e] = acc[e] + ad[e];
            *(f32x4*)(YRAW + (size_t)(row0 + c * 16 + tl) * 512 + h * 64 + vbase + 4 * kg) = yv;
        }
        if (c + 1 < 128) cs_store(lds, (c + 1) & 1, pa, tid);
        pa = pb;
        __syncthreads();
    }
    { float* so = P.out + O_WKV_P + ((((size_t)l * NB + s) * 8 + h) * 64 + vbase) * 64;
      for (int i = tid; i < 1024; i += 512) so[i] = lds[CS_S + (i >> 6) * 65 + (i & 63)]; }
    __syncthreads();
}

constexpr int C2_Q = 0, C2_R = 1280, C2_BW = 2560, C2_T = 3648, C2_GY = 3968, C2_WC = 4288, C2S = 4352;
constexpr int C2_KW = 0, C2_UB = 1088, C2_HY = 1408, C2_V = 1728, C2H = 2304;
constexpr int C2_RING = 0, C2_HIN = 3 * C2S, C2_HP = C2_HIN + 2 * C2H, C2_HPB = 3840, C2_XST = C2_HP + 2 * C2_HPB, C2_XSA = C2_XST + 4096, C2_HPY = C2_XSA + 1024, C2_END = C2_HPY + 3 * 640;
static_assert(C2_END * 4 <= 32768 + 8 * ATT_WLDS, "cscan2 LDS");
struct C2Set { f32x4 st[8]; f32x4 hi[4]; };
__device__ __forceinline__ void c2_load_state(C2Set& r, const float* CHKA, const float* CHKB, int itc, int u) {
    const float* a = CHKA + (size_t)itc * 2048 + 4 * u; const float* b = CHKB + (size_t)itc * 3136 + 4 * u;
    r.st[0] = *(const f32x4*)(a); r.st[1] = *(const f32x4*)(a + 512); r.st[2] = *(const f32x4*)(a + 1024); r.st[3] = *(const f32x4*)(a + 1536);
    r.st[4] = *(const f32x4*)(b + 1024); r.st[5] = *(const f32x4*)(b + 1536); r.st[6] = *(const f32x4*)(b + 256);
    if (u < 16) r.st[7] = *(const f32x4*)(b + 3072);
}
__device__ __forceinline__ void c2_store_state(LAS float* buf, const C2Set& r, int u) {
#pragma unroll
    for (int i2 = 0; i2 < 2; ++i2) { const int i = u + 128 * i2;
        *(LAS f32x4*)(buf + C2_Q + (i >> 2) * 20 + (i & 3) * 4) = r.st[i2]; *(LAS f32x4*)(buf + C2_R + (i >> 2) * 20 + (i & 3) * 4) = r.st[2 + i2];
        *(LAS f32x4*)(buf + C2_BW + (i >> 4) * 68 + (i & 15) * 4) = r.st[4 + i2]; }
    { const int j = u & 63; *(LAS f32x4*)(buf + (u < 64 ? C2_T : C2_GY) + (j >> 2) * 20 + (j & 3) * 4) = r.st[6]; }
    if (u < 16) *(LAS f32x4*)(buf + C2_WC + 4 * u) = r.st[7];
}
__device__ __forceinline__ void c2_load_hin(C2Set& r, const float* CHKB, const float* vsrc, int itc, int u) {
    const float* b = CHKB + (size_t)itc * 3136;
    r.hi[0] = *(const f32x4*)(b + 2048 + 4 * u); r.hi[1] = *(const f32x4*)(b + 2560 + 4 * u);
    r.hi[2] = *(const f32x4*)(b + (u < 64 ? 4 * u : 768 + 4 * (u - 64)));
    r.hi[3] = *(const f32x4*)(vsrc + (size_t)(u >> 3) * 3584 + (u & 7) * 4);
}
__device__ __forceinline__ void c2_store_hin(LAS float* buf, const C2Set& r, int u) {
#pragma unroll
    for (int i2 = 0; i2 < 2; ++i2) { const int i = u + 128 * i2; *(LAS f32x4*)(buf + C2_KW + (i >> 4) * 68 + (i & 15) * 4) = r.hi[i2]; }
    { const int j = u & 63; *(LAS f32x4*)(buf + (u < 64 ? C2_UB : C2_HY) + (j >> 2) * 20 + (j & 3) * 4) = r.hi[2]; }
    *(LAS f32x4*)(buf + C2_V + (u >> 3) * 36 + (u & 7) * 4) = r.hi[3];
}
constexpr int C2_NBAR = 131;
#define c2_meet(fl, wave, seq, lane) do { asm volatile("s_waitcnt lgkmcnt(0)" ::: "memory"); __builtin_amdgcn_s_barrier(); asm volatile("" ::: "memory"); } while (0)
template <bool DOY, bool DOP>
__device__ __forceinline__ void c2_helper_step(LAS float* lds, int cy, int cp, int g, int tl, int kg, int lane, float* yout  ) {
    const LAS float* By = lds + C2_RING + (cy % 3) * C2S;
    const LAS float* Bn = lds + C2_HIN + (cp & 1) * C2H; LAS float* HPn = lds + C2_HP + (cp & 1) * C2_HPB + g * 1920;
    float ar[16], gy[4], yh[4]; f32x4 xs[4], xa;
    float vb[4], ua[4], ha[4], ka[16];
    __builtin_amdgcn_sched_barrier(0);
    if (DOY) {
#pragma unroll
        for (int tile = 0; tile < 4; ++tile) { xs[tile] = *(const LAS f32x4*)(lds + C2_XST + (((cy & 1) * 2 + g) * 4 + tile) * 256 + lane * 4);
#pragma unroll
            for (int reg = 0; reg < 4; ++reg) ar[tile * 4 + reg] = By[C2_R + (16 * tile + 4 * kg + reg) * 20 + tl]; }
        xa = *(const LAS f32x4*)(lds + C2_XSA + ((cy & 1) * 2 + g) * 256 + lane * 4);
#pragma unroll
        for (int e = 0; e < 4; ++e) { gy[e] = By[C2_GY + (4 * kg + e) * 20 + tl]; yh[e] = lds[C2_HPY + (cy % 3) * 640 + g * 320 + (4 * kg + e) * 20 + tl]; }
    }
    if (DOP) {
#pragma unroll
        for (int e = 0; e < 4; ++e) { vb[e] = Bn[C2_V + (4 * kg + e) * 36 + 16 * g + tl]; ua[e] = Bn[C2_UB + (4 * kg + e) * 20 + tl]; ha[e] = Bn[C2_HY + (4 * kg + e) * 20 + tl]; }
#pragma unroll
        for (int tile = 0; tile < 4; ++tile)
#pragma unroll
            for (int e = 0; e < 4; ++e) ka[tile * 4 + e] = Bn[C2_KW + (4 * kg + e) * 68 + 16 * tile + tl];
    }
    __builtin_amdgcn_sched_barrier(0);
    const f32x4 z4 = (f32x4){0.f, 0.f, 0.f, 0.f};
    f32x4 y = z4, du = z4, dh = z4, dk[4] = {z4, z4, z4, z4};
    if (DOY) {
        f32x4 pr = z4;
#pragma unroll
        for (int tile = 0; tile < 4; ++tile)
#pragma unroll
            for (int reg = 0; reg < 4; ++reg) pr = mfma4(ar[tile * 4 + reg], xs[tile][reg], pr);
        y = (f32x4){pr[0] + yh[0], pr[1] + yh[1], pr[2] + yh[2], pr[3] + yh[3]};
#pragma unroll
        for (int e = 0; e < 4; ++e) y = mfma4(gy[e], xa[e], y);
    }
    if (DOP) {
#pragma unroll
        for (int e = 0; e < 4; ++e) { du = mfma4(ua[e], vb[e], du); dh = mfma4(ha[e], vb[e], dh);
#pragma unroll
            for (int tile = 0; tile < 4; ++tile) dk[tile] = mfma4(ka[tile * 4 + e], vb[e], dk[tile]); }
    }
    __builtin_amdgcn_sched_barrier(0);
    if (DOY) {
#pragma unroll
        for (int e = 0; e < 4; ++e) yout[(size_t)e * 512] = y[e];
    }
    if (DOP) {
#pragma unroll
        for (int e = 0; e < 4; ++e) { HPn[(4 * kg + e) * 20 + tl] = du[e]; lds[C2_HPY + (cp % 3) * 640 + g * 320 + (4 * kg + e) * 20 + tl] = dh[e];
#pragma unroll
            for (int tile = 0; tile < 4; ++tile) HPn[640 + (16 * tile + 4 * kg + e) * 20 + tl] = dk[tile][e]; }
    }
    __builtin_amdgcn_sched_barrier(0);
}
__device__ __forceinline__ void ph_cscan2(const Params& P, int l, int bid, int wave, int lane, LAS float* lds, volatile LAS unsigned* fl) {
    const float* RWB = (const float*)(P.ws + WS_RWB);
    const float* CHKA = (const float*)(P.ws + WS_CHKA); const float* CHKB = (const float*)(P.ws + WS_CHKB);
    float* YRAW = (float*)(P.ws + WS_YRAW);
    const int bh = (bid & 7) + 8 * (bid >> 4), half = (bid >> 3) & 1;
    const int s = bh >> 3, h = bh & 7, row0 = s * SEQ;
    const int tl = lane & 15, kg = lane >> 4;
    const int it0 = (s * 128) * 8 + h;
    if (wave >= 6) {
        const int g = wave - 6;
        c2_meet(fl, wave, 0, lane);
        c2_helper_step<false, true>(lds, 0, 0, g, tl, kg, lane, nullptr);
        c2_meet(fl, wave, 0, lane);
#pragma unroll 1
        for (int c = 0; c < 127; ++c) { c2_helper_step<false, true>(lds, 0, c + 1, g, tl, kg, lane, nullptr); c2_meet(fl, wave, 0, lane); }
        c2_meet(fl, wave, 0, lane);
        c2_meet(fl, wave, 0, lane);
    } else if (wave >= 4) {
        const int u = (wave - 4) * 64 + lane;
        const float* vsrc0 = RWB + (size_t)row0 * 3584 + 1536 + h * 64 + 32 * half;
        C2Set ra, rb, rc;
        c2_load_state(ra, CHKA, CHKB, it0, u); c2_load_hin(ra, CHKB, vsrc0, it0, u);
        c2_store_state(lds + C2_RING, ra, u); c2_store_hin(lds + C2_HIN, ra, u);
        c2_load_hin(ra, CHKB, vsrc0 + (size_t)16 * 3584, it0 + 8, u);
        c2_store_hin(lds + C2_HIN + C2H, ra, u);
        c2_load_state(ra, CHKA, CHKB, it0 + 8, u); c2_load_hin(ra, CHKB, vsrc0 + (size_t)32 * 3584, it0 + 16, u);
        c2_load_state(rb, CHKA, CHKB, it0 + 16, u); c2_load_hin(rb, CHKB, vsrc0 + (size_t)48 * 3584, it0 + 24, u);
        c2_load_state(rc, CHKA, CHKB, it0 + 24, u); c2_load_hin(rc, CHKB, vsrc0 + (size_t)64 * 3584, it0 + 32, u);
        c2_meet(fl, wave, seq++, lane);
        c2_meet(fl, wave, seq++, lane);
#define C2_STAGE(C, R) do { const int c_ = (C); \
            if (c_ + 1 < 128) c2_store_state(lds + C2_RING + ((c_ + 1) % 3) * C2S, R, u); \
            if (c_ + 2 < 128) c2_store_hin(lds + C2_HIN + (c_ & 1) * C2H, R, u); \
            WAVE_LDS_SYNC(); \
            { const int c4 = c_ + 4 < 128 ? c_ + 4 : 127, c5 = c_ + 5 < 128 ? c_ + 5 : 127; \
              c2_load_state(R, CHKA, CHKB, it0 + 8 * c4, u); c2_load_hin(R, CHKB, vsrc0 + (size_t)(16 * c5) * 3584, it0 + 8 * c5, u); } \
            c2_meet(fl, wave, seq++, lane); } while (0)
#pragma unroll 1
        for (int c = 0; c < 126; c += 3) { C2_STAGE(c, ra); C2_STAGE(c + 1, rb); C2_STAGE(c + 2, rc); }
        C2_STAGE(126, ra); C2_STAGE(127, rb);
#undef C2_STAGE
        c2_meet(fl, wave, seq++, lane);
    } else if (wave >= 2) {
        const int g = wave - 2;
        float* ycol = YRAW + (size_t)(row0 + 4 * kg) * 512 + h * 64 + 16 * (2 * half + g) + tl;
        c2_meet(fl, wave, seq++, lane);
        c2_meet(fl, wave, seq++, lane);
        c2_meet(fl, wave, seq++, lane);
#pragma unroll 1
        for (int c = 1; c < 128; ++c) {
            c2_helper_step<true, false>(lds, c - 1, 0, g, tl, kg, lane, ycol + (size_t)(c - 1) * 16 * 512);
            c2_meet(fl, wave, seq++, lane);
        }
        c2_helper_step<true, false>(lds, 127, 0, g, tl, kg, lane, ycol + (size_t)127 * 16 * 512);
        c2_meet(fl, wave, seq++, lane);
    } else {
        const int g = wave, rg = 2 * half + g;
        f32x4 ST[4];
#pragma unroll
        for (int tile = 0; tile < 4; ++tile) ST[tile] = (f32x4){0.f, 0.f, 0.f, 0.f};
        c2_meet(fl, wave, seq++, lane);
        c2_meet(fl, wave, seq++, lane);
#pragma unroll 1
        for (int c = 0; c < 128; ++c) {
            const LAS float* B = lds + C2_RING + (c % 3) * C2S; const LAS float* HP = lds + C2_HP + (c & 1) * C2_HPB + g * 1920;
            float aq[16], tm[4], xu[4], bw[16], vk[16]; f32x4 wc[4];
            __builtin_amdgcn_sched_barrier(0);
#pragma unroll
            for (int tile = 0; tile < 4; ++tile) { *(LAS f32x4*)(lds + C2_XST + (((c & 1) * 2 + g) * 4 + tile) * 256 + lane * 4) = ST[tile];
#pragma unroll
                for (int reg = 0; reg < 4; ++reg) aq[tile * 4 + reg] = B[C2_Q + (16 * tile + 4 * kg + reg) * 20 + tl]; }
#pragma unroll
            for (int e = 0; e < 4; ++e) { xu[e] = HP[(4 * kg + e) * 20 + tl]; tm[e] = B[C2_T + (4 * kg + e) * 20 + tl]; }
#pragma unroll
            for (int tile = 0; tile < 4; ++tile) { wc[tile] = *(const LAS f32x4*)(B + C2_WC + 16 * tile + 4 * kg);
#pragma unroll
                for (int e = 0; e < 4; ++e) { bw[tile * 4 + e] = B[C2_BW + (4 * kg + e) * 68 + 16 * tile + tl]; vk[tile * 4 + e] = HP[640 + (16 * tile + 4 * kg + e) * 20 + tl]; } }
            __builtin_amdgcn_sched_barrier(0);
            f32x4 pq = (f32x4){0.f, 0.f, 0.f, 0.f}, pq2 = pq;
#pragma unroll
            for (int tile = 0; tile < 4; tile += 2)
#pragma unroll
                for (int reg = 0; reg < 4; ++reg) { pq = mfma4(aq[tile * 4 + reg], ST[tile][reg], pq); pq2 = mfma4(aq[(tile + 1) * 4 + reg], ST[tile + 1][reg], pq2); }
            f32x4 sa = (f32x4){0.f, 0.f, 0.f, 0.f};
#pragma unroll
            for (int e = 0; e < 4; ++e) sa = mfma4(tm[e], -(pq[e] + pq2[e] + xu[e]), sa);
#pragma unroll
            for (int tile = 0; tile < 4; ++tile) ST[tile] = ST[tile] * wc[tile] + (f32x4){vk[tile * 4 + 0], vk[tile * 4 + 1], vk[tile * 4 + 2], vk[tile * 4 + 3]};
            __builtin_amdgcn_sched_barrier(0);
            *(LAS f32x4*)(lds + C2_XSA + ((c & 1) * 2 + g) * 256 + lane * 4) = sa;
#pragma unroll
            for (int e = 0; e < 4; ++e)
#pragma unroll
                for (int tile = 0; tile < 4; ++tile) ST[tile] = mfma4(bw[tile * 4 + e], sa[e], ST[tile]);
            __builtin_amdgcn_sched_barrier(0);
#pragma unroll
            for (int tile = 0; tile < 4; ++tile) ST[tile][0] += 0.0f;
            __builtin_amdgcn_sched_barrier(0);
            c2_meet(fl, wave, seq++, lane);
        }
        c2_meet(fl, wave, seq++, lane);
        float* so = P.out + O_WKV_P + ((((size_t)l * NB + s) * 8 + h) * 64 + 16 * rg + tl) * 64;
#pragma unroll
        for (int tile = 0; tile < 4; ++tile) *(f32x4*)(so + 16 * tile + 4 * kg) = ST[tile];
    }
}

__device__ __forceinline__ void ph_post(const Params& P, int l, int gw, int ngw, int lane) {
    const float* PROJ = (const float*)(P.ws + WS_PROJ);
    const float* RWB = (const float*)(P.ws + WS_RWB);
    const float* YRAW = (const float*)(P.ws + WS_YRAW);
    bf16* MIX = (bf16*)(P.ws + WS_MIXB);
    float* out = P.out;
    {
        const int h = gw & 7, c = h * 64 + lane;
        const float lg = P.in[24][l * 512 + c], lb = P.in[25][l * 512 + c], rk = P.in[23][(l * 8 + h) * 64 + lane];
#pragma unroll 1
        for (int item0 = gw; item0 < MT * 8; item0 += 8 * ngw) {
            float y[8], rl[8], kl[8], vl[8], gl[8]; int rr[8];
#pragma unroll
            for (int q = 0; q < 8; ++q) { const int item = item0 + q * ngw; rr[q] = (item < MT * 8) ? (item >> 3) : (item0 >> 3);
                y[q] = YRAW[(size_t)rr[q] * 512 + c]; const float* base = RWB + (size_t)rr[q] * 3584 + c;
                rl[q] = base[0]; kl[q] = base[1024]; vl[q] = base[1536]; gl[q] = base[3072]; }
#pragma unroll
            for (int q = 0; q < 8; ++q) {
                const float mean = wave_total(y[q]) * (1.f / 64.f);
                const float d = y[q] - mean;
                const float var = wave_total(d * d) * (1.f / 64.f);
                const float yn = d * rsqrtf(var + GN_EPS) * lg + lb;
                const float bonus = wave_total(rl[q] * kl[q] * rk) * vl[q];
                if (item0 + q * ngw < MT * 8) MIX[(size_t)rr[q] * D + c] = (bf16)f2bf((yn + bonus) * gl[q]);
            }
        }
    }
    {
        const bf16* OPART = (const bf16*)(P.ws + WS_OPART); const float* LSE = (const float*)(P.ws + WS_LSE);
#pragma unroll 8
        for (int item = gw; item < MP * 8; item += ngw) {
            const int r = item >> 3, h = item & 7;
            const float l0 = LSE[((size_t)0 * MP + r) * 8 + h], l1 = LSE[((size_t)1 * MP + r) * 8 + h], l2 = LSE[((size_t)2 * MP + r) * 8 + h];
            const size_t off = (size_t)r * 1024 + h * 128 + 2 * lane;
            const unsigned a0 = *(const unsigned*)(OPART + off), a1 = *(const unsigned*)(OPART + (size_t)MP * 1024 + off), a2 = *(const unsigned*)(OPART + (size_t)2 * MP * 1024 + off);
            const float mx = fmaxf(l0, fmaxf(l1, l2));
            const float w0 = fexp_(l0 - mx), w1 = fexp_(l1 - mx), w2 = fexp_(l2 - mx);
            const float inv = __builtin_amdgcn_rcpf(w0 + w1 + w2);
            const float x = (w0 * __uint_as_float(a0 << 16) + w1 * __uint_as_float(a1 << 16) + w2 * __uint_as_float(a2 << 16)) * inv;
            const float y = (w0 * __uint_as_float(a0 & 0xffff0000u) + w1 * __uint_as_float(a1 & 0xffff0000u) + w2 * __uint_as_float(a2 & 0xffff0000u)) * inv;
            *(unsigned*)(MIX + (size_t)r * D + 1024 + h * 128 + 2 * lane) = pk2(x, y);
        }
    }
    const float* HLOC = (const float*)(P.ws + WS_HLOC); const float* CUMA = (const float*)(P.ws + WS_CUMA); const float* SUMM = (const float*)(P.ws + WS_SUMM);
    for (int item = gw; item < LRU_ITEMS; item += ngw) {
        int s, n, j, r0, nt; lru_item(item, s, n, j, r0, nt);
        const int c = n * 64 + lane;
        float H = (s >= NB) ? P.in[4][((size_t)l * DB + (s - NB)) * 512 + c] : 0.f;
        {
            float sa_[31], se_[31];
#pragma unroll
            for (int jj = 0; jj < 31; ++jj) { const bool in = jj < j; const float* sm = SUMM + (size_t)(item - j + (in ? jj : 0)) * 128; sa_[jj] = in ? sm[lane] : 1.f; se_[jj] = in ? sm[64 + lane] : 0.f; }
#pragma unroll
            for (int jj = 0; jj < 31; ++jj) H = sa_[jj] * H + se_[jj];
        }
        float hlast = 0.f;
#pragma unroll 1
        for (int t0 = 0; t0 < nt; t0 += 16) {
            float hl_[16], ca_[16], gb_[16];
#pragma unroll
            for (int q = 0; q < 16; ++q) { const int r = r0 + ((t0 + q < nt) ? t0 + q : 0);
                hl_[q] = HLOC[(size_t)r * 512 + c]; ca_[q] = CUMA[(size_t)r * 512 + c]; gb_[q] = PROJ[(size_t)r * PW + C_LG + c]; }
#pragma unroll
            for (int q = 0; q < 16; ++q) if (t0 + q < nt) {
                const float hh = hl_[q] + ca_[q] * H;
                MIX[(size_t)(r0 + t0 + q) * D + 512 + c] = (bf16)f2bf(hh * gelu_tanh(gb_[q]));
                hlast = hh;
            }
        }
        if (s < NB) { if (j == 31) out[O_LRUH_P + ((size_t)l * NB + s) * 512 + c] = hlast; }
        else out[O_LRUH_S + ((size_t)l * DB + (s - NB)) * 512 + c] = hlast;
    }
}

__device__ __forceinline__ void ph_norm2(const Params& P, int l, int gw, int ngw, int lane) {
    const float* gp = P.in[10] + (size_t)l * D; const float* gf = P.in[11] + (size_t)l * D;
    const bf16* Y1 = (const bf16*)(P.ws + WS_Y1);
    bf16* H = (bf16*)(P.ws + WS_HB);
    bf16* XH = (bf16*)(P.ws + WS_XH);
    f32x4 g1v[8], g2v[8];
#pragma unroll
    for (int j = 0; j < 8; ++j) { g1v[j] = *(const f32x4*)(gp + lane * 4 + j * 256); g2v[j] = *(const f32x4*)(gf + lane * 4 + j * 256); }
    for (int r0_ = gw; r0_ < MT; r0_ += 2 * ngw) {
#pragma unroll
      for (int q_ = 0; q_ < 2; ++q_) {
        const int r = r0_ + q_ * ngw; if (r >= MT) break;
        const float* xin = r < MP ? P.in[0] + (size_t)r * D : P.in[1] + (size_t)(r - MP) * D;
        f32x4 y[8], x[8]; float ss = 0.f;
#pragma unroll
        for (int j = 0; j < 8; ++j) { { const v2u yb = *(const v2u*)(Y1 + (size_t)r * D + lane * 4 + j * 256); y[j] = (f32x4){__uint_as_float(yb.x << 16), __uint_as_float(yb.x & 0xffff0000u), __uint_as_float(yb.y << 16), __uint_as_float(yb.y & 0xffff0000u)}; } if (l == 0) x[j] = *(const f32x4*)(xin + lane * 4 + j * 256);
            else { const v2u xb = *(const v2u*)(XH + (size_t)r * D + lane * 4 + j * 256); x[j] = (f32x4){__uint_as_float(xb.x << 16), __uint_as_float(xb.x & 0xffff0000u), __uint_as_float(xb.y << 16), __uint_as_float(xb.y & 0xffff0000u)}; }
            ss += y[j].x * y[j].x + y[j].y * y[j].y + y[j].z * y[j].z + y[j].w * y[j].w; }
        ss = wave_sum(ss);
        const float rs = rsqrtf(ss * (1.f / D) + RMS_EPS);
        float s2 = 0.f;
#pragma unroll
        for (int j = 0; j < 8; ++j) { const f32x4 g = g1v[j]; x[j] = x[j] + y[j] * rs * g;
            s2 += x[j].x * x[j].x + x[j].y * x[j].y + x[j].z * x[j].z + x[j].w * x[j].w;
            *(v2u*)(XH + (size_t)r * D + lane * 4 + j * 256) = (v2u){pk2(x[j].x, x[j].y), pk2(x[j].z, x[j].w)}; }
        s2 = wave_sum(s2);
        const float rs2 = rsqrtf(s2 * (1.f / D) + RMS_EPS);
#pragma unroll
        for (int j = 0; j < 8; ++j) { const f32x4 g = g2v[j]; const f32x4 o = x[j] * rs2 * g;
            *(v2u*)(H + (size_t)r * D + lane * 4 + j * 256) = (v2u){pk2(o.x, o.y), pk2(o.z, o.w)}; }
      }
    }
}
__device__ __forceinline__ void ph_norm3(const Params& P, int l, int gw, int ngw, int lane) {
    const float* gp = P.in[12] + (size_t)l * D;
    const bf16* Y1 = (const bf16*)(P.ws + WS_Y1);
    bf16* H = (bf16*)(P.ws + WS_HB);
    float* X = P.out; bf16* XH = (bf16*)(P.ws + WS_XH);
    const float* gn = P.in[9] + (size_t)(l + 1 < DEPTH ? l + 1 : l) * D;
    f32x4 g1v[8], g2v[8];
#pragma unroll
    for (int j = 0; j < 8; ++j) { g1v[j] = *(const f32x4*)(gp + lane * 4 + j * 256); g2v[j] = *(const f32x4*)(gn + lane * 4 + j * 256); }
    for (int r0_ = gw; r0_ < MT; r0_ += 2 * ngw) {
#pragma unroll
      for (int q_ = 0; q_ < 2; ++q_) {
        const int r = r0_ + q_ * ngw; if (r >= MT) break;
        f32x4 y[8], x[8]; float ss = 0.f;
#pragma unroll
        for (int j = 0; j < 8; ++j) { { const v2u yb = *(const v2u*)(Y1 + (size_t)r * D + lane * 4 + j * 256); y[j] = (f32x4){__uint_as_float(yb.x << 16), __uint_as_float(yb.x & 0xffff0000u), __uint_as_float(yb.y << 16), __uint_as_float(yb.y & 0xffff0000u)}; } { const v2u xb = *(const v2u*)(XH + (size_t)r * D + lane * 4 + j * 256); x[j] = (f32x4){__uint_as_float(xb.x << 16), __uint_as_float(xb.x & 0xffff0000u), __uint_as_float(xb.y << 16), __uint_as_float(xb.y & 0xffff0000u)}; }
            ss += y[j].x * y[j].x + y[j].y * y[j].y + y[j].z * y[j].z + y[j].w * y[j].w; }
        ss = wave_sum(ss);
        const float rs = rsqrtf(ss * (1.f / D) + RMS_EPS);
        float s2 = 0.f;
#pragma unroll
        for (int j = 0; j < 8; ++j) { const f32x4 g = g1v[j]; x[j] = x[j] + y[j] * rs * g;
            s2 += x[j].x * x[j].x + x[j].y * x[j].y + x[j].z * x[j].z + x[j].w * x[j].w;
            if (l + 1 < DEPTH) *(v2u*)(XH + (size_t)r * D + lane * 4 + j * 256) = (v2u){pk2(x[j].x, x[j].y), pk2(x[j].z, x[j].w)};
            else *(f32x4*)(X + (size_t)r * D + lane * 4 + j * 256) = x[j]; }
        if (l + 1 < DEPTH) {
            s2 = wave_sum(s2);
            const float rs2 = rsqrtf(s2 * (1.f / D) + RMS_EPS);
#pragma unroll
            for (int j = 0; j < 8; ++j) { const f32x4 g = g2v[j]; const f32x4 o = x[j] * rs2 * g;
                *(v2u*)(H + (size_t)r * D + lane * 4 + j * 256) = (v2u){pk2(o.x, o.y), pk2(o.z, o.w)}; }
        }
      }
    }
}

constexpr int NPHASE = 1 + 10 * DEPTH;
__global__ void __launch_bounds__(NWAVES * 64, 2) mega_fwd(Params P) {
    extern __shared__ __attribute__((aligned(16))) unsigned char lds_raw[];
    LAS unsigned char* lds = (LAS unsigned char*)lds_raw;
    LAS float* ldsf = (LAS float*)lds;
    volatile LAS unsigned* MISC = (volatile LAS unsigned*)(lds + MISC_OFF);
    const int tid = threadIdx.x, lane = tid & 63, wave = __builtin_amdgcn_readfirstlane(tid >> 6);
    const int bid = blockIdx.x, nb = gridDim.x;
    const int gw = bid * NWAVES + wave, ngw = nb * NWAVES;
    for (int u = tid; u < 64; u += NWAVES * 64) ((LAS unsigned*)(lds + MISC_OFF))[u] = 0u;
    __syncthreads();
    XcdBarrier bar; bar.bar = (unsigned*)(P.ws + WS_CTL) + CW_BAR; bar.x = 0; bar.st = nullptr;
    const bool multi = (P.ph_hi - P.ph_lo) > 1;
    if (multi) bar = xcd_barrier_post((unsigned*)(P.ws + WS_CTL) + CW_BAR, MISC + 8);
    bf16* HB = (bf16*)(P.ws + WS_HB); bf16* MIXB = (bf16*)(P.ws + WS_MIXB); bf16* Y1B = (bf16*)(P.ws + WS_Y1);
    float* PROJ = (float*)(P.ws + WS_PROJ); bf16* UB = (bf16*)(P.ws + WS_UB);
    for (int ph = P.ph_lo; ph < P.ph_hi; ++ph) {
        int lane_v = lane, tid_v = tid;
        asm volatile("" : "+v"(lane_v), "+v"(tid_v));
        if (ph == 0) { ph_weights(P, gw, ngw, wave, lane_v, ldsf); ph_norm1(P, gw, ngw, lane_v); }
        else {
            const int l = (ph - 1) / 10, sub = (ph - 1) % 10;
            const int subop = sub < 2 ? sub : (sub == 2 ? 9 : sub - 1);
            switch (subop) {
                case 0: { pg8::Gemm g{HB, (const bf16*)(P.ws + WS_WIN) + (size_t)l * NIN * D, MP, NIN, D}; pg8::StaticOrder S; S.init(MP, NIN, nb, bid);
                          pg8::EpiIn E{PROJ, (bf16*)(P.ws + WS_QKVB), P.out + O_K_P + (size_t)l * MP * 1024, P.out + O_K_S + (size_t)l * MS * 1024, P.out + O_V_P + (size_t)l * MP * 1024, P.out + O_V_S + (size_t)l * MS * 1024, MP, MT};
                          pg8::gemm_phase<pg8::EpiIn, pg8::StaticOrder, true, true>(lds, g, S, E, tid_v);
                          if (bid >= 224) { SEpiIn SE{PROJ, (bf16*)(P.ws + WS_QKVB), P.out + O_K_S + (size_t)l * MS * 1024, P.out + O_V_S + (size_t)l * MS * 1024};
                              gemm_small(HB + (size_t)MP * D, (const bf16*)(P.ws + WS_WIN) + (size_t)l * NIN * D, NIN, D, bid - 224, 32, tid_v, wave, lane_v, ldsf, SE); } } break;
                case 1: ph_post_in(P, l, bid, nb, tid_v, ldsf); break;
                case 9: ph_chunkpre(P, l, gw, ngw, wave, lane_v, ldsf); break;
                case 2: if (bid < 64) { __builtin_amdgcn_s_setprio(3); ph_cscan2(P, l, bid, wave, lane_v, ldsf, MISC + 20); __builtin_amdgcn_s_setprio(0); }
                        else if (bid >= 128 && wave < 2) ph_scan2(P, l, NB * 64 + (bid - 128), 128, tid_v, wave, lane_v, ldsf, MISC + 16);
                        asm volatile("" : "+v"(lane_v));
                        ph_mix(P, l, bid, nb, wave, lane_v, ldsf);
                        break;
                case 3: ph_post(P, l, gw, ngw, lane_v); break;
                case 4: { pg8::Gemm g{MIXB, (const bf16*)(P.ws + WS_WOUT) + (size_t)l * D * D, MP, D, D}; pg8::StaticOrder S; S.init(MP, D, nb, bid);
                          pg8::EpiBf16T<false> E{Y1B, D}; pg8::gemm_phase<pg8::EpiBf16T<false>, pg8::StaticOrder, true, true>(lds, g, S, E, tid_v);
                          SEpiBf16 SE{Y1B, D}; gemm_small(MIXB + (size_t)MP * D, (const bf16*)(P.ws + WS_WOUT) + (size_t)l * D * D, D, D, bid, nb, tid_v, wave, lane_v, ldsf, SE); } break;
                case 5: ph_norm2(P, l, gw, ngw, lane_v); break;
                case 6: { pg8::Gemm g{HB, (const bf16*)(P.ws + WS_W1) + (size_t)l * DFF * D, MP, DFF, D}; pg8::StaticOrder S; S.init(MP, DFF, nb, bid);
                          pg8::EpiBf16T<true> E{UB, DFF}; pg8::gemm_phase<pg8::EpiBf16T<true>, pg8::StaticOrder, true, true>(lds, g, S, E, tid_v);
                          SEpiRelu2 SE{UB, DFF}; gemm_small(HB + (size_t)MP * D, (const bf16*)(P.ws + WS_W1) + (size_t)l * DFF * D, DFF, D, bid, nb, tid_v, wave, lane_v, ldsf, SE); } break;
                case 7: { pg8::Gemm g{UB, (const bf16*)(P.ws + WS_W2) + (size_t)l * D * DFF, MP, D, DFF}; pg8::StaticOrder S; S.init(MP, D, nb, bid);
                          pg8::EpiBf16T<false> E{Y1B, D}; pg8::gemm_phase<pg8::EpiBf16T<false>, pg8::StaticOrder, true, true>(lds, g, S, E, tid_v);
                          SEpiBf16 SE{Y1B, D}; gemm_small(UB + (size_t)MP * DFF, (const bf16*)(P.ws + WS_W2) + (size_t)l * D * DFF, D, DFF, bid, nb, tid_v, wave, lane_v, ldsf, SE); } break;
                case 8: ph_norm3(P, l, gw, ngw, lane_v); break;
            }
        }
        if (ph + 1 < P.ph_hi) xcd_barrier(bar);
    }
}

extern "C" void kernel_launch(void* const* d_in, const int* in_sizes, int n_in, void* d_out, int out_size, void* d_ws, size_t ws_size, hipStream_t stream) {
    static int grid = 0;
    if (grid == 0) {
        if (n_in != 35 || (size_t)out_size != O_END || ws_size < WS_END) {
            fprintf(stderr, "kernel_launch: unexpected shapes: n_in %d out %d ws %zu (need %zu)\n", n_in, out_size, ws_size, (size_t)WS_END); grid = -1; return; }
        int dev = 0, cus = 0, per_cu = 0;
        if (hipGetDevice(&dev) != hipSuccess || hipDeviceGetAttribute(&cus, hipDeviceAttributeMultiprocessorCount, dev) != hipSuccess) { grid = -1; return; }
        if (hipFuncSetAttribute((const void*)mega_fwd, hipFuncAttributeMaxDynamicSharedMemorySize, LDS_BYTES) != hipSuccess) { fprintf(stderr, "kernel_launch: hipFuncSetAttribute failed\n"); grid = -1; return; }
        if (hipOccupancyMaxActiveBlocksPerMultiprocessor(&per_cu, (const void*)mega_fwd, NWAVES * 64, LDS_BYTES) != hipSuccess || per_cu < 1) { fprintf(stderr, "kernel_launch: occupancy query says %d\n", per_cu); per_cu = 1; }
        (void)hipGetLastError();
        grid = cus;
    }
    if (grid < 0) return;
    (void)hipMemsetAsync((char*)d_ws + WS_CTL, 0, CTL_ZERO_BYTES, stream);
    Params p{};
    for (int i = 0; i < 35; ++i) p.in[i] = (const float*)d_in[i];
    p.out = (float*)d_out; p.ws = (unsigned char*)d_ws;
#if MK_MULTI
    for (int ph = 0; ph < NPHASE; ++ph) { p.ph_lo = ph; p.ph_hi = ph + 1; hipLaunchKernelGGL(mega_fwd, dim3(grid), dim3(NWAVES * 64), LDS_BYTES, stream, p); }
#else
    p.ph_lo = 0; p.ph_hi = NPHASE;
    hipLaunchKernelGGL(mega_fwd, dim3(grid), dim3(NWAVES * 64), LDS_BYTES, stream, p);
#endif
}
```

```cpp
#include <hip/hip_runtime.h>
#include <cstdio>
#include <cstdint>

#ifndef MK_MULTI
#define MK_MULTI 0
#endif

constexpr int D = 2048, NB = 4, SEQ = 2048, DEPTH = 2, DB = 8, DS = 4;
constexpr int MP = NB * SEQ, MS = DB * DS, MT = MP + MS, MT_PAD = 8448;
constexpr int RWW = 512, RPROJ = 1792;
constexpr int NIN = 5888, DFF = 8192;
constexpr int C_LX = 1792, C_LG = 2304, C_Q = 2816, C_K = 3840, C_V = 4864;
constexpr int NSEQ = NB + DB;
constexpr int CACHE_W = 2048;
constexpr float RMS_EPS = 1e-6f, GN_EPS = 64e-5f;
constexpr float ATT_SCALE = 0.08838834764831845f;

constexpr size_t O_Y = 0;
constexpr size_t O_WKV_P = (size_t)MT * D;
constexpr size_t O_WKV_S = O_WKV_P + (size_t)DEPTH * NB * 8 * 64 * 64;
constexpr size_t O_SHIFT_P = O_WKV_S + (size_t)DEPTH * DB * 8 * 64 * 64;
constexpr size_t O_SHIFT_S = O_SHIFT_P + (size_t)DEPTH * NB * RPROJ;
constexpr size_t O_LRUH_P = O_SHIFT_S + (size_t)DEPTH * DB * RPROJ;
constexpr size_t O_LRUH_S = O_LRUH_P + (size_t)DEPTH * NB * 512;
constexpr size_t O_CONV_P = O_LRUH_S + (size_t)DEPTH * DB * 512;
constexpr size_t O_CONV_S = O_CONV_P + (size_t)DEPTH * NB * 3 * 512;
constexpr size_t O_K_P = O_CONV_S + (size_t)DEPTH * DB * 3 * 512;
constexpr size_t O_K_S = O_K_P + (size_t)DEPTH * MP * 1024;
constexpr size_t O_V_P = O_K_S + (size_t)DEPTH * MS * 1024;
constexpr size_t O_V_S = O_V_P + (size_t)DEPTH * MP * 1024;
constexpr size_t O_END = O_V_S + (size_t)DEPTH * MS * 1024;
static_assert(O_END == 51406848, "output size");

constexpr size_t MiB = 1u << 20;
constexpr size_t WS_CTL = 0, CTL_ZERO_BYTES = 1 * MiB;
constexpr size_t WS_WIN = 2 * MiB;
constexpr size_t WS_WOUT = 48 * MiB;
constexpr size_t WS_W1 = 64 * MiB;
constexpr size_t WS_W2 = 128 * MiB;
constexpr size_t WS_HB = 192 * MiB;
constexpr size_t WS_MIXB = 225 * MiB;
constexpr size_t WS_Y1 = 258 * MiB;
constexpr int PW = 2816;
constexpr size_t WS_QKVB = WS_Y1;
constexpr size_t WS_LSE = WS_Y1 + 51 * MiB;
constexpr size_t WS_SUMM = WS_Y1 + 53 * MiB;
constexpr size_t WS_PROJ = 324 * MiB;
constexpr size_t WS_OPART = 415 * MiB;
constexpr size_t WS_UB = WS_PROJ;
constexpr size_t WS_RWB = 464 * MiB;
constexpr size_t WS_YRAW = 577 * MiB;
constexpr size_t WS_HLOC = 594 * MiB;
constexpr size_t WS_CUMA = 611 * MiB;
constexpr size_t WS_CHKA = WS_HB;
constexpr size_t WS_CHKB = 628 * MiB;
constexpr size_t WS_XH = 678 * MiB;
constexpr size_t WS_YS = 712 * MiB;
constexpr size_t WS_RS = 713 * MiB;
constexpr size_t WS_BON = 714 * MiB;
constexpr size_t WS_END = 715 * MiB;
static_assert((size_t)NB * 128 * 8 * 2048 * 4 <= (size_t)MP * D * 2 && (size_t)NB * 128 * 8 * 3136 * 4 <= WS_END - WS_CHKB, "chunk matrices");
static_assert((size_t)MT_PAD * DFF * 2 <= WS_RWB - WS_UB, "U overlay");
static_assert((size_t)DEPTH * NIN * D * 2 <= WS_WOUT - WS_WIN && (size_t)MT_PAD * D * 2 <= WS_MIXB - WS_HB && (size_t)MT_PAD * PW * 4 <= WS_OPART - WS_PROJ && (size_t)3 * MP * 1024 * 2 <= WS_RWB - WS_OPART &&
              (size_t)MT * 3584 * 4 <= WS_YRAW - WS_RWB && (size_t)MT * 512 * 4 <= WS_HLOC - WS_YRAW && (size_t)MT_PAD * 3072 * 2 <= 51 * MiB && WS_SUMM + 1088 * 512 <= WS_PROJ, "ws map");

constexpr int CW_BAR = 4096;

constexpr int NWAVES = 8;
constexpr int LDS_BYTES = 163840;
constexpr int MISC_OFF = 163840 - 512;

#define GAS __attribute__((address_space(1)))
#define LAS __attribute__((address_space(3)))
typedef float f32x4 __attribute__((ext_vector_type(4)));
typedef float f32x2 __attribute__((ext_vector_type(2)));
typedef GAS unsigned gu32;

#define XB_TMO      128
#define XB_XCNT(j)  (256  + 64 * (j))
#define XB_XSUB(j)  (1280 + 64 * (j))
#define XB_XGEN(j)  (2304 + 64 * (j))
#define XB_TOP      3328
#define XB_TOPGEN   3392
#define XCD_BAR_WORDS 3456
#define XB_SPIN_CAP (1u << 22)

__device__ __forceinline__ unsigned xb_ld(unsigned* p)              { return __hip_atomic_load(p, __ATOMIC_RELAXED, __HIP_MEMORY_SCOPE_AGENT); }
__device__ __forceinline__ unsigned xb_add(unsigned* p, unsigned v) { return __hip_atomic_fetch_add(p, v, __ATOMIC_RELAXED, __HIP_MEMORY_SCOPE_AGENT); }
__device__ __forceinline__ unsigned xb_xcc_id() { return (unsigned)__builtin_amdgcn_s_getreg((3 << 11) | 20) & 0xFu; }
#define XB_SPIN(cond, bar) do { unsigned _sp = 0; while (cond) { __builtin_amdgcn_s_sleep(1); \
    if ((++_sp & 255u) == 0u) { if (xb_ld(&(bar)[XB_TMO])) break; if (_sp > XB_SPIN_CAP) { atomicAdd(&(bar)[XB_TMO], 1u); break; } } } } while (0)

struct XcdBarrier { unsigned* bar; unsigned x; volatile LAS unsigned* st; };

__device__ __forceinline__ XcdBarrier xcd_barrier_post(unsigned* bar, volatile LAS unsigned* st) {
    XcdBarrier b; b.bar = bar; b.x = xb_xcc_id(); b.st = st;
    if (threadIdx.x == 0) (void)xb_add(&bar[XB_XCNT(b.x)], 1u);
    return b;
}
__device__ __forceinline__ void xcd_barrier_complete(unsigned* bar, unsigned x, unsigned& nloc, unsigned& nx) {
    const unsigned G = gridDim.x * gridDim.y * gridDim.z;
    unsigned sum, cnt, mine, sp = 0u;
    for (;;) {
        sum = 0u; cnt = 0u; mine = 0u;
#pragma unroll
        for (unsigned j = 0; j < 16; ++j) { const unsigned c = xb_ld(&bar[XB_XCNT(j)]); sum += c; cnt += (c > 0u) ? 1u : 0u; mine = (j == x) ? c : mine; }
        if (sum == G) break;
        __builtin_amdgcn_s_sleep(1);
        if ((++sp & 255u) == 0u) { if (xb_ld(&bar[XB_TMO])) break; if (sp > XB_SPIN_CAP) { atomicAdd(&bar[XB_TMO], 1u); break; } }
    }
    nloc = mine > 0u ? mine : 1u; nx = cnt > 0u ? cnt : 1u;
}
__device__ __forceinline__ void xcd_barrier(const XcdBarrier& b) {
    asm volatile("s_waitcnt vmcnt(0)" ::: "memory");
    __syncthreads();
    if (threadIdx.x == 0) {
        unsigned* bar = b.bar;
        __builtin_amdgcn_s_waitcnt(0);
        unsigned nloc = b.st[0], nx = b.st[1];
        if (nloc == 0u) { xcd_barrier_complete(bar, b.x, nloc, nx); b.st[0] = nloc; b.st[1] = nx; }
        const unsigned old = xb_add(&bar[XB_XSUB(b.x)], 1u);
        const unsigned gen = old / nloc;
        if (old + 1u == (gen + 1u) * nloc) {
            __builtin_amdgcn_fence(__ATOMIC_RELEASE, "agent");
            asm volatile("s_waitcnt vmcnt(0)" ::: "memory");
            const unsigned og = xb_add(&bar[XB_TOP], 1u);
            const unsigned tg = og / nx;
            if (og + 1u == (tg + 1u) * nx) xb_add(&bar[XB_TOPGEN], 1u);
            else XB_SPIN(xb_ld(&bar[XB_TOPGEN]) == tg, bar);
            __builtin_amdgcn_fence(__ATOMIC_ACQUIRE, "agent");
            xb_add(&bar[XB_XGEN(b.x)], 1u);
            asm volatile("s_waitcnt vmcnt(0)" ::: "memory");
        } else {
            XB_SPIN(xb_ld(&bar[XB_XGEN(b.x)]) == gen, bar);
            __builtin_amdgcn_fence(__ATOMIC_ACQUIRE, "agent");
            asm volatile("s_waitcnt vmcnt(0)" ::: "memory");
        }
    }
    __syncthreads();
}

struct Params { const float* in[35]; float* out; unsigned char* ws; int ph_lo, ph_hi; };

__device__ __forceinline__ float wave_sum(float v) {
#pragma unroll
    for (int o = 1; o < 64; o <<= 1) v += __shfl_xor(v, o);
    return v;
}
__device__ __forceinline__ float wave_max(float v) {
#pragma unroll
    for (int o = 1; o < 64; o <<= 1) v = fmaxf(v, __shfl_xor(v, o));
    return v;
}
__device__ __forceinline__ float rdl(float x, int k) { return __int_as_float(__builtin_amdgcn_readlane(__float_as_int(x), k)); }
__device__ __forceinline__ float sigmoidf_(float x) { return 1.0f / (1.0f + expf(-x)); }
__device__ __forceinline__ float softplusf_(float x) { return fmaxf(x, 0.f) + log1pf(expf(-fabsf(x))); }
__device__ __forceinline__ float fexp_(float x) { return __builtin_amdgcn_exp2f(x * 1.4426950408889634f); }
__device__ __forceinline__ float fsigmoid_(float x) { return __builtin_amdgcn_rcpf(1.0f + fexp_(-x)); }
__device__ __forceinline__ float ftanh_(float x) { return 1.0f - 2.0f * __builtin_amdgcn_rcpf(1.0f + fexp_(2.0f * x)); }
__device__ __forceinline__ float fsoftplus_(float x) { return fmaxf(x, 0.f) + __builtin_amdgcn_logf(1.0f + fexp_(-fabsf(x))) * 0.6931471805599453f; }
__device__ __forceinline__ float gelu_tanh(float x) { return 0.5f * x * (1.0f + ftanh_(0.7978845608028654f * (x + 0.044715f * x * x * x))); }
#define WAVE_LDS_SYNC() asm volatile("s_waitcnt lgkmcnt(0)" ::: "memory")

__device__ __forceinline__ void seq_of(int s, int& row0, int& T) { if (s < NB) { row0 = s * SEQ; T = SEQ; } else { row0 = MP + (s - NB) * DS; T = DS; } }
__device__ __forceinline__ void row_to_seq(int r, int& s, int& t) { if (r < MP) { s = r >> 11; t = r & (SEQ - 1); } else { s = NB + ((r - MP) >> 2); t = (r - MP) & 3; } }

namespace pg8 {
#define PG8_LAS __attribute__((address_space(3)))
typedef unsigned short bf16_t;
typedef short bf16x8 __attribute__((ext_vector_type(8)));
typedef float f32x4 __attribute__((ext_vector_type(4)));
typedef unsigned u32x4 __attribute__((ext_vector_type(4)));
constexpr int BM = 256, BK = 64, HALF = 128, HTB = HALF * BK * 2  , STAGE_BYTES = 8 * HTB, NXCD = 8, WGM = 8;

__host__ __device__ __forceinline__ int lds_byte(int r, int c) { const int st = (r >> 4) * 2 + (c >> 5), rr = r & 15, cc = c & 31, ob = rr * 64 + cc * 2; return st * 1024 + (ob ^ (((ob >> 9) & 1) << 5)); }
__host__ __device__ __forceinline__ void stage_rc(int b, int& R, int& C) { const int st = b / 1024, sb = b % 1024, swz = sb ^ (((sb >> 9) & 1) << 5); R = (st >> 1) * 16 + swz / 64; C = (st & 1) * 32 + (swz % 64) / 2; }
__host__ __device__ __forceinline__ int perm32(int rho) { const int n = rho >> 4, i = rho & 15; return 8 * (i >> 2) + 4 * n + (i & 3); }

struct Unit { int pm, pn; };
struct Gemm { const bf16_t* A; const bf16_t* Bt; int M, N, K; };

struct StaticOrder {
    int nM, nN, nwg, G, c;
    __host__ __device__ void init(int M, int N, int G_, int c_) { nM = M / BM; nN = N / BM; nwg = nM * nN; G = G_; c = c_; }
    __host__ __device__ bool next(int i, Unit& u) const {
        const long L = (long)i * G + c; if (L >= nwg) return false;
        int wgid = (int)L; { const int q = nwg / NXCD, r = nwg % NXCD, xcd = wgid % NXCD, off = wgid / NXCD; wgid = (xcd < r ? xcd * (q + 1) : r * (q + 1) + (xcd - r) * q) + off; }
        const int nig = WGM * nN, gid = wgid / nig, fm = gid * WGM, gsz = (nM - fm) < WGM ? (nM - fm) : WGM;
        u.pm = fm + ((wgid % nig) % gsz); u.pn = (wgid % nig) / gsz; return true;
    }
    __device__ __forceinline__ void a_ready(const Unit&) const {}
    __device__ __forceinline__ void done(const Unit&) const {}
};
__device__ __forceinline__ unsigned cvt_pk_bf16(float lo, float hi) { unsigned r; asm volatile("v_cvt_pk_bf16_f32 %0, %1, %2" : "=v"(r) : "v"(lo), "v"(hi)); return r; }
typedef float f32x2 __attribute__((ext_vector_type(2)));

struct EpiF32 {
    static constexpr bool PERM = false, AFTER_DRAIN = false;
    float* C; int ldc;
    __device__ __forceinline__ void operator()(const f32x4 (&acc)[2][2][4][2], const Unit& u, int wr, int wc, int fr, int fq) const {
        const int row0 = u.pm * BM + wr * 64 + fr, col0 = u.pn * BM + wc * 32 + 4 * fq;
#pragma unroll
        for (int ai = 0; ai < 2; ++ai)
#pragma unroll
            for (int m = 0; m < 4; ++m) { float* rowp = C + (size_t)(row0 + ai * HALF + m * 16) * ldc + col0;
#pragma unroll
                for (int bj = 0; bj < 2; ++bj)
#pragma unroll
                    for (int n = 0; n < 2; ++n) *(f32x4*)(rowp + bj * HALF + n * 16) = acc[ai][bj][m][n]; }
    }
};
struct EpiF32P {
    static constexpr bool PERM = true, AFTER_DRAIN = false;
    float* C; int ldc;
    __device__ __forceinline__ void operator()(const f32x4 (&acc)[2][2][4][2], const Unit& u, int wr, int wc, int fr, int fq) const {
        const int row0 = u.pm * BM + wr * 64 + fr, col0 = u.pn * BM + wc * 32 + 8 * fq;
#pragma unroll
        for (int ai = 0; ai < 2; ++ai)
#pragma unroll
            for (int m = 0; m < 4; ++m) { float* rowp = C + (size_t)(row0 + ai * HALF + m * 16) * ldc + col0;
#pragma unroll
                for (int bj = 0; bj < 2; ++bj)
#pragma unroll
                    for (int n = 0; n < 2; ++n) *(f32x4*)(rowp + bj * HALF + n * 4) = acc[ai][bj][m][n]; }
    }
};
struct EpiIn {
    static constexpr bool PERM = true, AFTER_DRAIN = false;
    bf16_t* C; bf16_t* QKV; float* kp; float* ks; float* vp; float* vs; int mp, mt;
    const float* rs;
    __device__ __forceinline__ void operator()(const f32x4 (&acc)[2][2][4][2], const Unit& u, int wr, int wc, int fr, int fq) const {
        const int row0 = u.pm * BM + wr * 64 + fr;
        if (u.pn < 11) {
            const int col0 = u.pn * BM + wc * 32 + 8 * fq;
#pragma unroll
            for (int ai = 0; ai < 2; ++ai)
#pragma unroll
                for (int m = 0; m < 4; ++m) { bf16_t* rowp = C + (size_t)(row0 + ai * HALF + m * 16) * 2816 + col0; const float sc_ = rs ? rs[row0 + ai * HALF + m * 16] : 1.0f;
#pragma unroll
                    for (int bj = 0; bj < 2; ++bj) { const f32x4 v0 = acc[ai][bj][m][0] * sc_, v1 = acc[ai][bj][m][1] * sc_;
                        u32x4 w; w.x = cvt_pk_bf16(v0[0], v0[1]); w.y = cvt_pk_bf16(v0[2], v0[3]); w.z = cvt_pk_bf16(v1[0], v1[1]); w.w = cvt_pk_bf16(v1[2], v1[3]);
                        *(u32x4*)(rowp + bj * HALF) = w; } }
        } else {
            const int colq = (u.pn - 11) * BM + wc * 32 + 8 * fq;
            const int sect = colq >> 10, cc = colq & 1023;
#pragma unroll
            for (int ai = 0; ai < 2; ++ai)
#pragma unroll
                for (int m = 0; m < 4; ++m) { const int row = row0 + ai * HALF + m * 16; bf16_t* rowp = QKV + (size_t)row * 3072 + colq; const float sc_ = rs ? rs[row] : 1.0f;
                    float* fo = nullptr;
                    if (sect == 1) fo = row < mp ? kp + (size_t)row * 1024 + cc : (row < mt ? ks + (size_t)(row - mp) * 1024 + cc : nullptr);
                    if (sect == 2) fo = row < mp ? vp + (size_t)row * 1024 + cc : (row < mt ? vs + (size_t)(row - mp) * 1024 + cc : nullptr);
#pragma unroll
                    for (int bj = 0; bj < 2; ++bj) { const f32x4 v0 = acc[ai][bj][m][0] * sc_, v1 = acc[ai][bj][m][1] * sc_;
                        u32x4 w; w.x = cvt_pk_bf16(v0[0], v0[1]); w.y = cvt_pk_bf16(v0[2], v0[3]); w.z = cvt_pk_bf16(v1[0], v1[1]); w.w = cvt_pk_bf16(v1[2], v1[3]);
                        *(u32x4*)(rowp + bj * HALF) = w;
                        if (fo) { *(f32x4*)(fo + bj * HALF) = v0; *(f32x4*)(fo + bj * HALF + 4) = v1; } } }
        }
    }
};
template <bool RELU2> struct EpiBf16T {
    static constexpr bool PERM = true, AFTER_DRAIN = false;
    bf16_t* O; int ldc; const float* rs;
    __device__ __forceinline__ void operator()(const f32x4 (&acc)[2][2][4][2], const Unit& u, int wr, int wc, int fr, int fq) const {
        const int row0 = u.pm * BM + wr * 64 + fr, col0 = u.pn * BM + wc * 32 + 8 * fq;
#pragma unroll
        for (int ai = 0; ai < 2; ++ai)
#pragma unroll
            for (int m = 0; m < 4; ++m) { bf16_t* rowp = O + (size_t)(row0 + ai * HALF + m * 16) * ldc + col0; const float sc_ = rs ? rs[row0 + ai * HALF + m * 16] : 1.0f;
#pragma unroll
                for (int bj = 0; bj < 2; ++bj) { f32x4 v0 = acc[ai][bj][m][0] * sc_, v1 = acc[ai][bj][m][1] * sc_;
                    if (RELU2) { v0 = __builtin_elementwise_max(v0, (f32x4){0.f, 0.f, 0.f, 0.f}); v1 = __builtin_elementwise_max(v1, (f32x4){0.f, 0.f, 0.f, 0.f}); v0 = v0 * v0; v1 = v1 * v1; }
                    u32x4 w; w.x = cvt_pk_bf16(v0[0], v0[1]); w.y = cvt_pk_bf16(v0[2], v0[3]); w.z = cvt_pk_bf16(v1[0], v1[1]); w.w = cvt_pk_bf16(v1[2], v1[3]);
                    *(u32x4*)(rowp + bj * HALF) = w; } }
    }
};

template <class Epi, class Sched, bool ALIGN_EPI = false, bool SP2 = false>
__device__ __forceinline__ void gemm_phase(PG8_LAS unsigned char* lds, const Gemm g, const Sched& S, const Epi& E, const int tid) {
    const int wid = __builtin_amdgcn_readfirstlane(tid >> 6), lane = tid & 63, wr = wid >> 2, wc = wid & 3, fr = lane & 15, fq = lane >> 4;
    const int K = g.K, nt = K / BK;
    unsigned voffA[2], voffB[2];
#pragma unroll
    for (int i = 0; i < 2; ++i) { int R, C; stage_rc(tid * 16 + i * 8192, R, C); const int Rb = Epi::PERM ? ((R & ~31) + perm32(R & 31)) : R;
        voffA[i] = (unsigned)(R * K + C) * 2u; voffB[i] = (unsigned)(Rb * K + C) * 2u; }
    const size_t kstep = (size_t)(BK * 2);
    const size_t hstep = (size_t)HALF * K * 2;
    const size_t tstep = 2 * hstep;
    const unsigned ldsw = (unsigned)wid * 1024u;
    const int aoff = lds_byte(wr * 64 + fr, fq * 8), boff = lds_byte(wc * 32 + fr, fq * 8);
#define PG8_SA(b, h) (((b) * 2 + (h)) * HTB)
#define PG8_SB(b, h) ((4 + (b) * 2 + (h)) * HTB)
#define PG8_STAGE(bufoff, gbase, voff) do { _Pragma("unroll") for (int _i = 0; _i < 2; ++_i) \
        __builtin_amdgcn_global_load_lds((const unsigned*)((const char*)(gbase) + (voff)[_i]), (PG8_LAS unsigned*)(lds + (bufoff) + ldsw + _i * 8192), 16, 0, 0); } while (0)
#define PG8_LDA(dst, b, h) do { _Pragma("unroll") for (int m = 0; m < 4; ++m) _Pragma("unroll") for (int k = 0; k < 2; ++k) dst[m][k] = *(const PG8_LAS bf16x8*)(lds + PG8_SA(b, h) + aoff + m * 2048 + k * 1024); } while (0)
#define PG8_LDB(dst, b, h) do { _Pragma("unroll") for (int n = 0; n < 2; ++n) _Pragma("unroll") for (int k = 0; k < 2; ++k) dst[n][k] = *(const PG8_LAS bf16x8*)(lds + PG8_SB(b, h) + boff + n * 2048 + k * 1024); } while (0)
#define PG8_MMA(ai, bj, At, Bt) do { __builtin_amdgcn_s_setprio(1); _Pragma("unroll") for (int m = 0; m < 4; ++m) _Pragma("unroll") for (int n = 0; n < 2; ++n) _Pragma("unroll") for (int k = 0; k < 2; ++k) \
        acc[ai][bj][m][n] = __builtin_amdgcn_mfma_f32_16x16x32_bf16(Bt[n][k], At[m][k], acc[ai][bj][m][n], 0, 0, 0); __builtin_amdgcn_s_setprio(0); } while (0)
#define PG8_WAIT_V(n) asm volatile("s_waitcnt vmcnt(" #n ")" ::: "memory")
#define PG8_WAIT_L(n) asm volatile("s_waitcnt lgkmcnt(" #n ")" ::: "memory")
#define PG8_BAR __builtin_amdgcn_s_barrier()
#define PG8_SCHED __builtin_amdgcn_sched_barrier(0)
    Unit cur, nxt; int ui = 0;
    if (!S.next(0, cur)) return;
    f32x4 acc[2][2][4][2];
#pragma unroll
    for (int a = 0; a < 2; ++a)
#pragma unroll
        for (int b = 0; b < 2; ++b)
#pragma unroll
            for (int m = 0; m < 4; ++m)
#pragma unroll
                for (int n = 0; n < 2; ++n) acc[a][b][m][n] = (f32x4){0.f, 0.f, 0.f, 0.f};
    bf16x8 At[4][2], B0[2][2], B1[2][2];
    const char* cA = (const char*)g.A + (size_t)cur.pm * tstep; const char* cB = (const char*)g.Bt + (size_t)cur.pn * tstep;
    S.a_ready(cur);
    if constexpr (SP2) {
        PG8_STAGE(PG8_SB(0, 0), cB, voffB); PG8_STAGE(PG8_SB(0, 1), cB + hstep, voffB); PG8_STAGE(PG8_SA(0, 0), cA, voffA); PG8_STAGE(PG8_SA(0, 1), cA + hstep, voffA);
        if (wr == 1) PG8_BAR;
        PG8_WAIT_V(2); PG8_BAR;
        PG8_STAGE(PG8_SB(1, 0), cB + kstep, voffB); PG8_STAGE(PG8_SA(1, 0), cA + kstep, voffA); PG8_STAGE(PG8_SB(1, 1), cB + hstep + kstep, voffB);
        PG8_WAIT_V(6); PG8_BAR;
    } else {
        PG8_STAGE(PG8_SB(0, 0), cB, voffB); PG8_STAGE(PG8_SA(0, 0), cA, voffA); PG8_STAGE(PG8_SB(0, 1), cB + hstep, voffB); PG8_STAGE(PG8_SA(0, 1), cA + hstep, voffA);
        if (wr == 1) PG8_BAR;
        PG8_WAIT_V(4); PG8_BAR;
        PG8_STAGE(PG8_SB(1, 0), cB + kstep, voffB); PG8_STAGE(PG8_SA(1, 0), cA + kstep, voffA); PG8_STAGE(PG8_SB(1, 1), cB + hstep + kstep, voffB);
        PG8_WAIT_V(6); PG8_BAR;
    }
    for (;;) {
        const bool has_next = S.next(ui + 1, nxt);
        const char* nA = has_next ? (const char*)g.A + (size_t)nxt.pm * tstep : cA; const char* nB = has_next ? (const char*)g.Bt + (size_t)nxt.pn * tstep : cB;
        for (int t = 0; t < nt; t += 2) {
            const bool last = (t == nt - 2);
            const char* a1 = cA + (size_t)(t + 1) * kstep;
            const char* a2 = last ? nA : cA + (size_t)(t + 2) * kstep; const char* b2 = last ? nB : cB + (size_t)(t + 2) * kstep;
            const char* a3 = a2 + kstep; const char* b3 = b2 + kstep;
            if (last && has_next) S.a_ready(nxt);
            if constexpr (SP2) {
            PG8_LDB(B0, 0, 0); PG8_LDB(B1, 0, 1); PG8_SCHED; PG8_LDA(At, 0, 0); PG8_STAGE(PG8_SA(1, 1), a1 + hstep, voffA);
            PG8_WAIT_V(8); PG8_WAIT_L(0); PG8_BAR; PG8_MMA(0, 0, At, B0); PG8_MMA(0, 1, At, B1); PG8_BAR; PG8_SCHED;
            PG8_LDA(At, 0, 1); PG8_STAGE(PG8_SB(0, 0), b2, voffB); PG8_STAGE(PG8_SB(0, 1), b2 + hstep, voffB); PG8_STAGE(PG8_SA(0, 0), a2, voffA);
            PG8_WAIT_V(8); PG8_WAIT_L(0); PG8_BAR; PG8_MMA(1, 0, At, B0); PG8_MMA(1, 1, At, B1); PG8_BAR; PG8_SCHED;
            PG8_LDB(B0, 1, 0); PG8_LDB(B1, 1, 1); PG8_SCHED; PG8_LDA(At, 1, 0); PG8_STAGE(PG8_SA(0, 1), a2 + hstep, voffA);
            PG8_WAIT_V(8); PG8_WAIT_L(0); PG8_BAR; PG8_MMA(0, 0, At, B0); PG8_MMA(0, 1, At, B1); PG8_BAR; PG8_SCHED;
            PG8_LDA(At, 1, 1); PG8_STAGE(PG8_SB(1, 0), b3, voffB); PG8_STAGE(PG8_SB(1, 1), b3 + hstep, voffB); PG8_STAGE(PG8_SA(1, 0), a3, voffA);
            PG8_WAIT_V(8); PG8_WAIT_L(0); PG8_BAR; PG8_MMA(1, 0, At, B0); PG8_MMA(1, 1, At, B1); PG8_BAR; PG8_SCHED;
            } else {
            PG8_LDB(B0, 0, 0); PG8_SCHED; PG8_LDA(At, 0, 0); PG8_STAGE(PG8_SA(1, 1), a1 + hstep, voffA);
            PG8_WAIT_L(8); PG8_BAR; PG8_WAIT_L(0); PG8_MMA(0, 0, At, B0); PG8_BAR; PG8_SCHED;
            PG8_LDB(B1, 0, 1); PG8_STAGE(PG8_SB(0, 0), b2, voffB);
            PG8_BAR; PG8_WAIT_L(0); PG8_MMA(0, 1, At, B1); PG8_BAR;
            PG8_LDA(At, 0, 1); PG8_STAGE(PG8_SA(0, 0), a2, voffA);
            PG8_BAR; PG8_WAIT_L(0); PG8_MMA(1, 0, At, B0); PG8_BAR; PG8_SCHED;
            PG8_STAGE(PG8_SB(0, 1), b2 + hstep, voffB);
            PG8_WAIT_V(6); PG8_BAR; PG8_MMA(1, 1, At, B1); PG8_BAR;
            PG8_LDB(B0, 1, 0); PG8_SCHED; PG8_LDA(At, 1, 0); PG8_STAGE(PG8_SA(0, 1), a2 + hstep, voffA);
            PG8_WAIT_L(8); PG8_BAR; PG8_WAIT_L(0); PG8_MMA(0, 0, At, B0); PG8_BAR; PG8_SCHED;
            PG8_LDB(B1, 1, 1); PG8_STAGE(PG8_SB(1, 0), b3, voffB);
            PG8_BAR; PG8_WAIT_L(0); PG8_MMA(0, 1, At, B1); PG8_BAR;
            PG8_LDA(At, 1, 1); PG8_STAGE(PG8_SA(1, 0), a3, voffA);
            PG8_BAR; PG8_WAIT_L(0); PG8_MMA(1, 0, At, B0); PG8_BAR; PG8_SCHED;
            PG8_STAGE(PG8_SB(1, 1), b3 + hstep, voffB);
            PG8_WAIT_V(6); PG8_BAR; PG8_MMA(1, 1, At, B1); PG8_BAR;
            }
        }
        if constexpr (ALIGN_EPI) { if (wr == 0) PG8_BAR; }
        if constexpr (!Epi::AFTER_DRAIN) { E(acc, cur, wr, wc, fr, fq); S.done(cur); }
        if (!has_next) break;
#pragma unroll
        for (int a = 0; a < 2; ++a)
#pragma unroll
            for (int b = 0; b < 2; ++b)
#pragma unroll
                for (int m = 0; m < 4; ++m)
#pragma unroll
                    for (int n = 0; n < 2; ++n) acc[a][b][m][n] = (f32x4){0.f, 0.f, 0.f, 0.f};
        cur = nxt; cA = nA; cB = nB; ++ui;
        if constexpr (ALIGN_EPI) { if (wr == 1) PG8_BAR; }
    }
    PG8_WAIT_V(0);
    if constexpr (!ALIGN_EPI) { if (wr == 0) PG8_BAR; }
    PG8_BAR;
    if constexpr (Epi::AFTER_DRAIN) { E.fused(acc, cur, wr, wc, fr, fq, lds, wid, lane); S.done(cur); }
#undef PG8_SA
#undef PG8_SB
#undef PG8_STAGE
#undef PG8_LDA
#undef PG8_LDB
#undef PG8_MMA
#undef PG8_WAIT_V
#undef PG8_WAIT_L
#undef PG8_BAR
#undef PG8_SCHED
}
}


typedef unsigned short bf16;
struct BfRO { const unsigned short* p;
    __device__ __forceinline__ float operator[](size_t i) const { return __uint_as_float((unsigned)p[i] << 16); }
    __device__ __forceinline__ BfRO operator+(size_t o) const { return BfRO{p + o}; } };
typedef short bf16x8 __attribute__((ext_vector_type(8)));
typedef short s16x4 __attribute__((ext_vector_type(4)));
typedef float f32x16 __attribute__((ext_vector_type(16)));
constexpr int ATT_WLDS = 12800;
typedef unsigned v4u __attribute__((ext_vector_type(4)));
typedef unsigned v2u __attribute__((ext_vector_type(2)));
typedef float f32x2c_ __attribute__((ext_vector_type(2)));
typedef __bf16 bf16x2c_ __attribute__((ext_vector_type(2)));
__device__ __forceinline__ unsigned pk2(float lo, float hi) { const f32x2c_ v = {lo, hi}; return __builtin_bit_cast(unsigned, __builtin_convertvector(v, bf16x2c_)); }
__device__ __forceinline__ unsigned f2bf(float f) { return pk2(f, f) & 0xffffu; }
#define LDS_WAIT() asm volatile("s_waitcnt lgkmcnt(0)" ::: "memory")

__device__ __forceinline__ void p0_transpose_item(const float* W, int K, int N, bf16* WT, LAS float* scr, int item, int lane, const float* gain = nullptr) {
    const int nblk = N / 32, kb = item / nblk, nb = item % nblk, k0 = 64 * kb, n0 = 32 * nb;
    float wv[32];
#pragma unroll
    for (int i = 0; i < 32; ++i) wv[i] = W[(size_t)(k0 + 2 * i + (lane >> 5)) * N + n0 + (lane & 31)];
#pragma unroll
    for (int i = 0; i < 32; ++i) scr[(2 * i + (lane >> 5)) * 33 + (lane & 31)] = wv[i];
    LDS_WAIT(); asm volatile("" ::: "memory");
    const int c = lane & 7;
#pragma unroll
    for (int j = 0; j < 4; ++j) { const int n = (lane >> 3) + 8 * j; const LAS float* s = scr + (8 * c) * 33 + n;
        f32x4 ga = (f32x4){1.f, 1.f, 1.f, 1.f}, gb = ga; if (gain) { ga = *(const f32x4*)(gain + k0 + 8 * c); gb = *(const f32x4*)(gain + k0 + 8 * c + 4); }
        v4u o; o.x = pk2(s[0 * 33] * ga[0], s[1 * 33] * ga[1]); o.y = pk2(s[2 * 33] * ga[2], s[3 * 33] * ga[3]); o.z = pk2(s[4 * 33] * gb[0], s[5 * 33] * gb[1]); o.w = pk2(s[6 * 33] * gb[2], s[7 * 33] * gb[3]);
        *(GAS v4u*)(WT + (size_t)(n0 + n) * K + k0 + 8 * c) = o; }
    LDS_WAIT(); asm volatile("" ::: "memory");
}
__device__ __forceinline__ void ph_weights(const Params& P, int gw, int ngw, int wave, int lane, LAS float* lds) {
    LAS float* scr = lds + wave * 4096;
    constexpr int I_IN = (D / 64) * (NIN / 32), I_OUT = (D / 64) * (D / 32), I_1 = (D / 64) * (DFF / 32), I_2 = (DFF / 64) * (D / 32);
    constexpr int PER_L = I_IN + I_OUT + I_1 + I_2;
    for (int it = gw; it < DEPTH * PER_L; it += ngw) {
        const int l = it / PER_L; int r = it % PER_L;
        if (r < I_IN) { p0_transpose_item(P.in[13] + (size_t)l * D * NIN, D, NIN, (bf16*)(P.ws + WS_WIN) + (size_t)l * NIN * D, scr, r, lane, P.in[9] + (size_t)l * D); continue; } r -= I_IN;
        if (r < I_OUT) { p0_transpose_item(P.in[14] + (size_t)l * D * D, D, D, (bf16*)(P.ws + WS_WOUT) + (size_t)l * D * D, scr, r, lane); continue; } r -= I_OUT;
        if (r < I_1) { p0_transpose_item(P.in[33] + (size_t)l * D * DFF, D, DFF, (bf16*)(P.ws + WS_W1) + (size_t)l * DFF * D, scr, r, lane, P.in[11] + (size_t)l * D); continue; } r -= I_1;
        p0_transpose_item(P.in[34] + (size_t)l * DFF * D, DFF, D, (bf16*)(P.ws + WS_W2) + (size_t)l * D * DFF, scr, r, lane);
    }
}

struct SEpiIn { bf16* C; bf16* QKV; float* ks; float* vs; const float* rs;
    __device__ __forceinline__ void operator()(int row, int col, float s_) const { const float s = rs ? s_ * rs[MP + row] : s_;
        if (col < PW) C[(size_t)(MP + row) * PW + col] = (bf16)f2bf(s);
        else { const int cq = col - PW; QKV[(size_t)(MP + row) * 3072 + cq] = (bf16)f2bf(s);
            if (cq >= 2048) vs[(size_t)row * 1024 + (cq - 2048)] = s; else if (cq >= 1024) ks[(size_t)row * 1024 + (cq - 1024)] = s; } } };
struct SEpiF32 { float* C; int ldc;
    __device__ __forceinline__ void operator()(int row, int col, float s) const { C[(size_t)(MP + row) * ldc + col] = s; } };
struct SEpiBf16 { bf16* O; int ldc;
    __device__ __forceinline__ void operator()(int row, int col, float s) const { O[(size_t)(MP + row) * ldc + col] = (bf16)f2bf(s); } };
struct SEpiRelu2 { bf16* O; int ldc; const float* rs;
    __device__ __forceinline__ void operator()(int row, int col, float s) const { const float t = fmaxf(rs ? s * rs[MP + row] : s, 0.f); O[(size_t)(MP + row) * ldc + col] = (bf16)f2bf(t * t); } };
template <class E>
__device__ __forceinline__ void gemm_small(const bf16* A, const bf16* Bt, int N, int K, int u0, int ustride, int tid, int wave, int lane, LAS float* lds, const E& epi) {
    const int kw = K >> 3, i32 = lane & 31, hi = lane >> 5;
    for (int u = u0; u < (N >> 5); u += ustride) {
        const int n0 = u * 32;
        f32x16 acc;
#pragma unroll
        for (int r = 0; r < 16; ++r) acc[r] = 0.f;
        const bf16* ap = A + (size_t)i32 * K + wave * kw + hi * 8;
        const bf16* bp = Bt + (size_t)(n0 + i32) * K + wave * kw + hi * 8;
#pragma unroll 8
        for (int k = 0; k < kw; k += 16) { const bf16x8 a = *(const bf16x8*)(ap + k); const bf16x8 b = *(const bf16x8*)(bp + k); acc = __builtin_amdgcn_mfma_f32_32x32x16_bf16(a, b, acc, 0, 0, 0); }
#pragma unroll
        for (int r = 0; r < 16; ++r) lds[wave * 1024 + r * 64 + lane] = acc[r];
        __syncthreads();
#pragma unroll
        for (int q = 0; q < 2; ++q) { const int idx = tid + 512 * q; float s = 0.f;
#pragma unroll
            for (int w = 0; w < 8; ++w) s += lds[w * 1024 + idx];
            const int ri = idx >> 6, ln = idx & 63;
            epi((ri & 3) + 8 * (ri >> 2) + 4 * (ln >> 5), n0 + (ln & 31), s); }
        __syncthreads();
    }
}

__device__ __forceinline__ void gemm_small_kq(const bf16* A, const bf16* Bt, int K, int item, float* YS, int tid, int wave, int lane, LAS float* lds) {
    const int u = item >> 2, kq = item & 3, ksub = K >> 2, kw = ksub >> 3, i32 = lane & 31, hi = lane >> 5, n0 = u * 32;
    f32x16 acc;
#pragma unroll
    for (int r = 0; r < 16; ++r) acc[r] = 0.f;
    const bf16* ap = A + (size_t)i32 * K + kq * ksub + wave * kw + hi * 8;
    const bf16* bp = Bt + (size_t)(n0 + i32) * K + kq * ksub + wave * kw + hi * 8;
#pragma unroll 8
    for (int k = 0; k < kw; k += 16) { const bf16x8 a = *(const bf16x8*)(ap + k); const bf16x8 b = *(const bf16x8*)(bp + k); acc = __builtin_amdgcn_mfma_f32_32x32x16_bf16(a, b, acc, 0, 0, 0); }
#pragma unroll
    for (int r = 0; r < 16; ++r) lds[wave * 1024 + r * 64 + lane] = acc[r];
    __syncthreads();
#pragma unroll
    for (int q = 0; q < 2; ++q) { const int idx = tid + 512 * q; float sm = 0.f;
#pragma unroll
        for (int w = 0; w < 8; ++w) sm += lds[w * 1024 + idx];
        const int ri = idx >> 6, ln = idx & 63;
        YS[((size_t)kq * 32 + (ri & 3) + 8 * (ri >> 2) + 4 * (ln >> 5)) * 2048 + n0 + (ln & 31)] = sm; }
    __syncthreads();
}

__device__ __forceinline__ void ph_norm1(const Params& P, int gw, int ngw, int lane) {
    bf16* XH = (bf16*)(P.ws + WS_XH); float* RS = (float*)(P.ws + WS_RS);
    for (int r = gw; r < MT; r += ngw) {
        const float* x = r < MP ? P.in[0] + (size_t)r * D : P.in[1] + (size_t)(r - MP) * D;
        f32x4 v[8]; float ss = 0.f;
#pragma unroll
        for (int j = 0; j < 8; ++j) { v[j] = *(const f32x4*)(x + lane * 4 + j * 256); ss += v[j].x * v[j].x + v[j].y * v[j].y + v[j].z * v[j].z + v[j].w * v[j].w;
            *(v2u*)(XH + (size_t)r * D + lane * 4 + j * 256) = (v2u){pk2(v[j].x, v[j].y), pk2(v[j].z, v[j].w)}; }
        ss = wave_sum(ss);
        if (lane == 0) RS[r] = rsqrtf(ss * (1.f / D) + RMS_EPS);
    }
}

template <int EPI>
__device__ __forceinline__ void ph_gemm_naive(const float* A, int lda, const float* W, float* C, int ldc, int M, int N, int K, int bid, int nb, int tid, LAS float* lds) {
    LAS float* As = lds;
    LAS float* Bs = lds + 16 * 132;
    const int ty = tid >> 4, tx = tid & 15;
    const int ntm = (M + 127) / 128, ntn = N / 64;
    for (int tile = bid; tile < ntm * ntn; tile += nb) {
        const int tm = tile / ntn, tn = tile % ntn, m0 = tm * 128, n0 = tn * 64;
        float acc[4][4];
#pragma unroll
        for (int i = 0; i < 4; ++i)
#pragma unroll
            for (int j = 0; j < 4; ++j) acc[i][j] = 0.f;
        const int ar = m0 + (tid >> 2), ak = (tid & 3) * 4, bk = tid >> 5, bc = (tid & 31) * 2;
        for (int k0 = 0; k0 < K; k0 += 16) {
            f32x4 av = (f32x4){0.f, 0.f, 0.f, 0.f};
            if (ar < M) av = *(const f32x4*)(A + (size_t)ar * lda + k0 + ak);
            const f32x2 bv = *(const f32x2*)(W + (size_t)(k0 + bk) * N + n0 + bc);
            __syncthreads();
            As[(ak + 0) * 132 + (tid >> 2)] = av.x; As[(ak + 1) * 132 + (tid >> 2)] = av.y; As[(ak + 2) * 132 + (tid >> 2)] = av.z; As[(ak + 3) * 132 + (tid >> 2)] = av.w;
            Bs[bk * 64 + bc] = bv.x; Bs[bk * 64 + bc + 1] = bv.y;
            __syncthreads();
#pragma unroll
            for (int k = 0; k < 16; ++k) {
                const f32x4 a = *(const LAS f32x4*)(As + k * 132 + ty * 4);
                const f32x4 b = *(const LAS f32x4*)(Bs + k * 64 + tx * 4);
#pragma unroll
                for (int i = 0; i < 4; ++i)
#pragma unroll
                    for (int j = 0; j < 4; ++j) acc[i][j] += a[i] * b[j];
            }
        }
#pragma unroll
        for (int i = 0; i < 4; ++i) {
            const int row = m0 + ty * 4 + i;
            if (row < M) {
                f32x4 o = (f32x4){acc[i][0], acc[i][1], acc[i][2], acc[i][3]};
                if (EPI == 1) { o.x = fmaxf(o.x, 0.f); o.y = fmaxf(o.y, 0.f); o.z = fmaxf(o.z, 0.f); o.w = fmaxf(o.w, 0.f); o = o * o; }
                *(f32x4*)(C + (size_t)row * ldc + n0 + tx * 4) = o;
            }
        }
    }
}

template <int NJ> __device__ __forceinline__ void lora_pass(f32x2 (&acc)[18], const LAS float* act, const float* wcol) {
#pragma unroll 1
    for (int j0 = 0; j0 < NJ; j0 += 8) {
        float wv[8];
#pragma unroll
        for (int q = 0; q < 8; ++q) wv[q] = wcol[(size_t)(j0 + q) * 512];
        f32x4 xa[9], xb[9];
#pragma unroll
        for (int t4 = 0; t4 < 9; ++t4) xa[t4] = *(const LAS f32x4*)(act + j0 * 36 + 4 * t4);
        __builtin_amdgcn_sched_barrier(0);
#pragma unroll
        for (int q = 0; q < 8; q += 2) {
#pragma unroll
            for (int t4 = 0; t4 < 9; ++t4) xb[t4] = *(const LAS f32x4*)(act + (j0 + q + 1) * 36 + 4 * t4);
            { const f32x2 w2 = (f32x2){wv[q], wv[q]};
#pragma unroll
              for (int t4 = 0; t4 < 9; ++t4) { acc[2 * t4] += xa[t4].xy * w2; acc[2 * t4 + 1] += xa[t4].zw * w2; } }
            __builtin_amdgcn_sched_barrier(0);
            if (q + 2 < 8) {
#pragma unroll
                for (int t4 = 0; t4 < 9; ++t4) xa[t4] = *(const LAS f32x4*)(act + (j0 + q + 2) * 36 + 4 * t4);
            }
            { const f32x2 w2 = (f32x2){wv[q + 1], wv[q + 1]};
#pragma unroll
              for (int t4 = 0; t4 < 9; ++t4) { acc[2 * t4] += xb[t4].xy * w2; acc[2 * t4 + 1] += xb[t4].zw * w2; } }
            __builtin_amdgcn_sched_barrier(0);
        }
    }
}
constexpr int LA_P = 264;
__device__ __forceinline__ void lora_mfma64(f32x4 (&acc)[3][2], const LAS unsigned short* AH, const LAS unsigned short* AL, int kofs, const float* wsl_, int half, int lane) {
    const float* wsl = wsl_ + 32 * half;
    const int n = lane & 15, kq = lane >> 4;
    unsigned wlo = (unsigned)(kq * 8 * 512 + n);
    asm volatile("" : "+s"(wsl), "+v"(wlo));
    float wf[2][2][8];
#pragma unroll
    for (int nt = 0; nt < 2; ++nt)
#pragma unroll
        for (int ks = 0; ks < 2; ++ks)
#pragma unroll
            for (int i = 0; i < 8; ++i) wf[nt][ks][i] = (wsl + (32 * ks + i) * 512 + 16 * nt)[wlo];
    bf16x8 ah[2][3], al[2][3];
    __builtin_amdgcn_sched_barrier(0);
#pragma unroll
    for (int ks = 0; ks < 2; ++ks)
#pragma unroll
        for (int mt = 0; mt < 3; ++mt) { ah[ks][mt] = *(const LAS bf16x8*)(AH + (16 * mt + n) * LA_P + kofs + 32 * ks + 8 * kq); al[ks][mt] = *(const LAS bf16x8*)(AL + (16 * mt + n) * LA_P + kofs + 32 * ks + 8 * kq); }
    WAVE_LDS_SYNC();
    __builtin_amdgcn_sched_barrier(0);
#pragma unroll
    for (int ks = 0; ks < 2; ++ks) {
#pragma unroll
        for (int nt = 0; nt < 2; ++nt) {
            bf16x8 bh, bl;
#pragma unroll
            for (int i = 0; i < 8; ++i) { const float wv_ = wf[nt][ks][i]; const unsigned h_ = f2bf(wv_); bh[i] = (short)h_; bl[i] = (short)f2bf(wv_ - __uint_as_float(h_ << 16)); }
#pragma unroll
            for (int mt = 0; mt < 3; ++mt) {
                acc[mt][nt] = __builtin_amdgcn_mfma_f32_16x16x32_bf16(ah[ks][mt], bh, acc[mt][nt], 0, 0, 0);
                acc[mt][nt] = __builtin_amdgcn_mfma_f32_16x16x32_bf16(al[ks][mt], bh, acc[mt][nt], 0, 0, 0);
                acc[mt][nt] = __builtin_amdgcn_mfma_f32_16x16x32_bf16(ah[ks][mt], bl, acc[mt][nt], 0, 0, 0);
            }
        }
    }
    __builtin_amdgcn_sched_barrier(0);
#pragma unroll
    for (int mt = 0; mt < 3; ++mt)
#pragma unroll
        for (int nt = 0; nt < 2; ++nt) acc[mt][nt][0] += 0.0f;
    __builtin_amdgcn_sched_barrier(0);
}
__device__ __forceinline__ void lora_store(const f32x4 (&acc)[3][2], LAS float* RES, int wave, int half, int lane) {
    const int n = lane & 15, kq = lane >> 4;
#pragma unroll
    for (int mt = 0; mt < 3; ++mt)
#pragma unroll
        for (int r = 0; r < 4; ++r) { const int row = 16 * mt + 4 * kq + r;
            if (row < 33) {
#pragma unroll
                for (int nt = 0; nt < 2; ++nt) RES[row * 512 + 64 * wave + 32 * half + 16 * nt + n] = acc[mt][nt][r]; } }
}
__device__ __forceinline__ void ph_post_in(const Params& P, int l, int bid, int nb, int tid, LAS float* lds) {
    const BfRO PROJ{(const unsigned short*)(P.ws + WS_PROJ)};
    float* RWB = (float*)(P.ws + WS_RWB);
    float* out = P.out;
    const size_t gtid = (size_t)bid * 512 + tid, nthr = (size_t)nb * 512;
#pragma unroll 1
    for (size_t i = gtid; i < (size_t)NSEQ * RPROJ; i += nthr) {
        const int s = (int)(i / RPROJ), c = (int)(i % RPROJ); int row0, T; seq_of(s, row0, T);
        const float v = PROJ[(size_t)(row0 + T - 1) * PW + c];
        if (s < NB) out[O_SHIFT_P + ((size_t)l * NB + s) * RPROJ + c] = v; else out[O_SHIFT_S + ((size_t)l * DB + (s - NB)) * RPROJ + c] = v;
    }
#pragma unroll 1
    for (size_t i = gtid; i < (size_t)NSEQ * 3 * 512; i += nthr) {
        const int s = (int)(i / 1536), j = (int)((i % 1536) / 512), c = (int)(i % 512); int row0, T; seq_of(s, row0, T);
        const float v = PROJ[(size_t)(row0 + T - 3 + j) * PW + C_LX + c];
        if (s < NB) out[O_CONV_P + (((size_t)l * NB + s) * 3 + j) * 512 + c] = v; else out[O_CONV_S + (((size_t)l * DB + (s - NB)) * 3 + j) * 512 + c] = v;
    }
    constexpr int TT = 33, NTILE = (MT + TT - 1) / TT;
    LAS unsigned short* AH = (LAS unsigned short*)lds;
    LAS unsigned short* AL = AH + 48 * LA_P;
    LAS float* RES = (LAS float*)(AL + 48 * LA_P);
    static_assert(2 * 48 * LA_P * 2 + 33 * 512 * 4 <= 131072, "prep LDS");
    const float* mu = P.in[15] + (size_t)l * RPROJ;
    const float* w_up = P.in[17] + (size_t)l * 64 * 512; const float* a_up = P.in[19] + (size_t)l * 64 * 512; const float* g_up = P.in[20] + (size_t)l * 128 * 512;
    const int wave = __builtin_amdgcn_readfirstlane(tid >> 6), lane = tid & 63;
    for (int tile = bid; tile < NTILE; tile += nb) {
        int c = tid; asm volatile("" : "+v"(c));
        const int r0 = tile * TT;
        {
            const int j = tid & 255, th = tid >> 8;
            const float muj = mu[1536 + j];
            float pprev = 0.f;
            { const int r = r0 + th * 18; if (r > 0 && r < MT) pprev = PROJ[(size_t)(r - 1) * PW + 1536 + j]; }
#pragma unroll 9
            for (int i = 0; i < 18; ++i) {
                const int t = th * 18 + i, r = r0 + t;
                float av = 0.f;
                if (t < TT && r < MT) {
                    int s, ts; row_to_seq(r, s, ts);
                    const float p = PROJ[(size_t)r * PW + 1536 + j];
                    float pv = pprev;
                    if (ts == 0) pv = (s >= NB) ? P.in[3][((size_t)l * DB + (s - NB)) * RPROJ + 1536 + j] : 0.f;
                    const float m = p + (pv - p) * muj;
                    av = j < 64 ? ftanh_(m) : (j < 128 ? m : fsigmoid_(m));
                    pprev = p;
                }
                const unsigned hb = f2bf(av);
                AH[t * LA_P + j] = (unsigned short)hb; AL[t * LA_P + j] = (unsigned short)f2bf(av - __uint_as_float(hb << 16));
            }
            for (int i = tid; i < 12 * 256; i += 512) { AH[(36 + (i >> 8)) * LA_P + (i & 255)] = 0; AL[(36 + (i >> 8)) * LA_P + (i & 255)] = 0; }
        }
        __syncthreads();
        f32x4 acc[3][2];
#define LORA_ZERO() do { _Pragma("unroll") for (int mt = 0; mt < 3; ++mt) _Pragma("unroll") for (int nt = 0; nt < 2; ++nt) acc[mt][nt] = (f32x4){0.f, 0.f, 0.f, 0.f}; } while (0)
#pragma unroll 1
        for (int half = 0; half < 2; ++half) { LORA_ZERO(); lora_mfma64(acc, AH, AL, 0, w_up + 64 * wave, half, lane); lora_store(acc, RES, wave, half, lane); }
        __syncthreads();
        {
            const float w0c = P.in[16][l * 512 + c];
#pragma unroll
            for (int t = 0; t < TT; ++t) {
                if ((t & 7) == 0) __builtin_amdgcn_sched_barrier(0);
                const float z = w0c + RES[t * 512 + c];
                const float w_log = -fsoftplus_(-z) - 0.5f;
                if (r0 + t < MT) RWB[(size_t)(r0 + t) * 3584 + 512 + c] = fexp_(-fexp_(w_log));
            }
        }
        __syncthreads();
        asm volatile("" : "+v"(c));
#pragma unroll 1
        for (int half = 0; half < 2; ++half) { LORA_ZERO(); lora_mfma64(acc, AH, AL, 64, a_up + 64 * wave, half, lane); lora_store(acc, RES, wave, half, lane); }
        __syncthreads();
        float acc1[TT];
        {
            const float a0c = P.in[18][l * 512 + c];
#pragma unroll
            for (int t = 0; t < TT; ++t) acc1[t] = fsigmoid_(a0c + RES[t * 512 + c]);
        }
        __syncthreads();
        asm volatile("" : "+v"(c));
#pragma unroll 1
        for (int half = 0; half < 2; ++half) { LORA_ZERO(); lora_mfma64(acc, AH, AL, 128, g_up + 64 * wave, half, lane); lora_mfma64(acc, AH, AL, 192, g_up + (size_t)64 * 512 + 64 * wave, half, lane); lora_store(acc, RES, wave, half, lane); }
#undef LORA_ZERO
        __syncthreads();
        asm volatile("" : "+v"(c));
        {
            const float mur = mu[c], muk = mu[512 + c], muv = mu[1024 + c];
            const float kkc = P.in[21][l * 512 + c], kac = P.in[22][l * 512 + c];
            const float rkc = P.in[23][(size_t)l * 512 + c]; float* BON = (float*)(P.ws + WS_BON);
            float pv0 = 0.f, pv1 = 0.f, pv2 = 0.f;
            if (r0 > 0) { const BfRO pp = PROJ + (size_t)(r0 - 1) * PW; pv0 = pp[c]; pv1 = pp[512 + c]; pv2 = pp[1024 + c]; }
#pragma unroll
            for (int t = 0; t < TT; ++t) {
                if (t % 11 == 0) __builtin_amdgcn_sched_barrier(0);
                const int r = (r0 + t < MT) ? r0 + t : MT - 1; int s, ts; row_to_seq(r, s, ts);
                const BfRO pr = PROJ + (size_t)r * PW;
                const float p0 = pr[c], p1 = pr[512 + c], p2 = pr[1024 + c];
                float q0 = pv0, q1 = pv1, q2 = pv2;
                if (ts == 0) { q0 = 0.f; q1 = 0.f; q2 = 0.f;
                    if (s >= NB) { const float* st = P.in[3] + ((size_t)l * DB + (s - NB)) * RPROJ; q0 = st[c]; q1 = st[512 + c]; q2 = st[1024 + c]; } }
                pv0 = p0; pv1 = p1; pv2 = p2;
                const float rr = p0 + (q0 - p0) * mur, k = p1 + (q1 - p1) * muk, vv = p2 + (q2 - p2) * muv;
                const float a = acc1[t];
                const float kkv = k * kkc;
                const float ss = wave_sum(kkv * kkv);
                const float kkn = kkv * __builtin_amdgcn_rsqf(fmaxf(ss, 1e-24f));
                const float kpr = k * (1.0f + (a - 1.0f) * kac);
                const float bsum = wave_sum(rr * kpr * rkc);
                if (r0 + t < MT) { float* o = RWB + (size_t)r * 3584 + c;
                    o[0] = rr; o[1024] = kpr; o[1536] = vv; o[2048] = kkn; o[2560] = kkn * a; ((bf16*)(RWB + (size_t)r * 3584 + 3072))[c] = (bf16)f2bf(RES[t * 512 + c]);
                    if ((c & 63) == 0) BON[(size_t)r * 8 + (c >> 6)] = bsum; }
            }
        }
        __syncthreads();
    }
}

__device__ __forceinline__ float att_bias(const float* rel_bias, int dist, int h) {
    int b;
    if (dist < 16) b = dist;
    else { b = 16 + (int)(logf((float)dist / 16.0f) / 4.852030263919617f * 16.0f); b = b > 31 ? 31 : b; }
    return rel_bias[b * 8 + h];
}

__device__ __forceinline__ int qpop(unsigned* ctr, int lane) { unsigned v = 0u; if (lane == 0) v = atomicAdd(ctr, 1u); return (int)__builtin_amdgcn_readfirstlane(v); }
constexpr int CW_QUEUE = 1024;
constexpr int LRU_ITEMS = NB * 8 * 32 + DB * 8;
__device__ __forceinline__ void lru_item(int item, int& s, int& n, int& j, int& r0, int& nt) {
    if (item < NB * 8 * 32) { s = item >> 8; n = (item >> 5) & 7; j = item & 31; r0 = s * SEQ + j * 64; nt = 64; }
    else { const int q = item - NB * 8 * 32; s = NB + (q >> 3); n = q & 7; j = 0; r0 = MP + (q >> 3) * DS; nt = DS; }
}
__device__ __forceinline__ void ph_mix(const Params& P, int l, int bid, int nb, int wave, int lane, LAS float* lds) {
    const BfRO PROJ{(const unsigned short*)(P.ws + WS_PROJ)};
    bf16* MIX = (bf16*)(P.ws + WS_MIXB);
    const int gw = bid * NWAVES + wave, ngw = nb * NWAVES;
    LAS float* qs = (LAS float*)((LAS unsigned char*)lds + 32768 + wave * ATT_WLDS);
    LAS float* ps = qs + 128;
    const float* rel_bias = P.in[8];
    const bf16* QKVB = (const bf16*)(P.ws + WS_QKVB);
    unsigned* qc1 = (unsigned*)(P.ws + WS_CTL) + CW_QUEUE + (l * 3 + 1) * 64;
    for (int item = qpop(qc1, lane); item < MS * 8; item = qpop(qc1, lane)) {
        const int r = MP + (item >> 3), h = item & 7; int s, t; row_to_seq(r, s, t);
        const int b = s - NB;
        const float* knew = P.out + O_K_S + ((size_t)l * MS + b * DS) * 1024 + h * 128;
        const float* vnew = P.out + O_V_S + ((size_t)l * MS + b * DS) * 1024 + h * 128;
        const bf16* qrow = QKVB + (size_t)r * 3072 + h * 128;
        qs[lane] = __uint_as_float((unsigned)qrow[lane] << 16); qs[64 + lane] = __uint_as_float((unsigned)qrow[64 + lane] << 16);
        WAVE_LDS_SYNC();
        float sc[9]; float mx = -INFINITY;
#pragma unroll
        for (int g = 0; g < 3; ++g) {
            const int dil = g == 0 ? 1 : (g == 1 ? 4 : 16);
#pragma unroll
            for (int jj = 0; jj < 3; ++jj) {
                const int j = jj * 64 + lane;
                const float* krow = nullptr;
                if (j <= 128) { const int idx = CACHE_W + t - dil * j;
                    if (idx < CACHE_W) krow = P.in[6] + ((((size_t)l * DB + b) * CACHE_W + idx) * 8 + h) * 128;
                    else krow = knew + (size_t)(idx - CACHE_W) * 1024; }
                float sv = -INFINITY;
                if (krow) {
                    float acc = 0.f;
#pragma unroll
                    for (int i0 = 0; i0 < 32; i0 += 16) {
                        f32x4 kq[16];
#pragma unroll
                        for (int i = 0; i < 16; ++i) kq[i] = *(const f32x4*)(krow + 4 * (i0 + i));
#pragma unroll
                        for (int i = 0; i < 16; ++i) { const f32x4 qq = *(const LAS f32x4*)(qs + 4 * (i0 + i)); acc += kq[i].x * qq.x + kq[i].y * qq.y + kq[i].z * qq.z + kq[i].w * qq.w; } }
                    sv = acc * ATT_SCALE + att_bias(rel_bias, j * dil, h);
                }
                sc[g * 3 + jj] = sv; mx = fmaxf(mx, sv);
            }
        }
        mx = wave_max(mx);
        float sum = 0.f;
#pragma unroll
        for (int g = 0; g < 3; ++g)
#pragma unroll
            for (int jj = 0; jj < 3; ++jj) {
                const int j = jj * 64 + lane; const float sv = sc[g * 3 + jj];
                const float p = (sv == -INFINITY) ? 0.f : expf(sv - mx);
                sum += p;
                if (j <= 128) ps[g * 129 + j] = p;
            }
        sum = wave_sum(sum);
        const float inv = 1.0f / sum;
        WAVE_LDS_SYNC();
        float o0 = 0.f, o1 = 0.f;
        for (int g = 0; g < 3; ++g) {
            const int dil = g == 0 ? 1 : (g == 1 ? 4 : 16);
#pragma unroll 1
            for (int j0 = 0; j0 < 144; j0 += 24) {
                float pq[24]; f32x2 vq[24];
#pragma unroll
                for (int q = 0; q < 24; ++q) {
                    const int j = j0 + q; const bool in = j <= 128;
                    pq[q] = in ? ps[g * 129 + j] : 0.f;
                    const int idx = CACHE_W + t - dil * (in ? j : 0);
                    const float* vrow = (idx < CACHE_W) ? P.in[7] + ((((size_t)l * DB + b) * CACHE_W + idx) * 8 + h) * 128 : vnew + (size_t)(idx - CACHE_W) * 1024;
                    vq[q] = *(const f32x2*)(vrow + 2 * lane);
                }
#pragma unroll
                for (int q = 0; q < 24; ++q) { o0 += pq[q] * vq[q].x; o1 += pq[q] * vq[q].y; }
            }
        }
        *(unsigned*)(MIX + (size_t)r * D + 1024 + h * 128 + 2 * lane) = pk2(o0 * inv, o1 * inv);
        WAVE_LDS_SYNC();
    }
    {
        bf16* HLOC = (bf16*)(P.ws + WS_HLOC); bf16* CUMA = (bf16*)(P.ws + WS_CUMA); float* SUMM = (float*)(P.ws + WS_SUMM);
        unsigned* qc = (unsigned*)(P.ws + WS_CTL) + CW_QUEUE + (l * 3 + 0) * 64;
        LAS float* XC = (LAS float*)((LAS unsigned char*)lds + 32768 + wave * ATT_WLDS);
        LAS float* GR = XC + 1040; LAS float* GI = GR + 1024;
        const int tl = lane & 15, kg = lane >> 4;
        for (int item = qpop(qc, lane); item < LRU_ITEMS; item = qpop(qc, lane)) {
            int s, n, j, r0, nt; lru_item(item, s, n, j, r0, nt);
            const int c = n * 64 + lane;
            const float* wab = P.in[28] + ((size_t)l * 8 + n) * 4096; const float* wxb = P.in[30] + ((size_t)l * 8 + n) * 4096;
            const unsigned wlo = (unsigned)(kg * 64 + 4 * tl);
            float x1 = 0.f, x2 = 0.f, x3 = 0.f;
            if (j > 0) { x1 = PROJ[(size_t)(r0 - 3) * PW + C_LX + c]; x2 = PROJ[(size_t)(r0 - 2) * PW + C_LX + c]; x3 = PROJ[(size_t)(r0 - 1) * PW + C_LX + c]; }
            else if (s >= NB) { const float* cs = P.in[5] + (((size_t)l * DB + (s - NB)) * 3) * 512 + c; x1 = cs[0]; x2 = cs[512]; x3 = cs[1024]; }
            const float cw0 = P.in[26][(l * 4 + 0) * 512 + c], cw1 = P.in[26][(l * 4 + 1) * 512 + c], cw2 = P.in[26][(l * 4 + 2) * 512 + c], cw3 = P.in[26][(l * 4 + 3) * 512 + c];
            const float cb = P.in[27][l * 512 + c], ba = P.in[29][l * 512 + c], bx = P.in[31][l * 512 + c];
            const float sp = softplusf_(-P.in[32][l * 512 + c]);
            float hl = 0.f, ca = 1.f;
            float xn[16];
#pragma unroll
            for (int q = 0; q < 16; ++q) xn[q] = (q < nt) ? PROJ[(size_t)(r0 + q) * PW + C_LX + c] : 0.f;
#pragma unroll 1
            for (int t0 = 0; t0 < nt; t0 += 16) {
                f32x4 wva[8], wvx[8];
#define LRU_LDW(S0) do { _Pragma("unroll") for (int s4 = 0; s4 < 8; ++s4) { wva[s4] = *(const f32x4*)(wab + ((S0) + s4) * 256 + wlo); wvx[s4] = *(const f32x4*)(wxb + ((S0) + s4) * 256 + wlo); } } while (0)
                LRU_LDW(0);
#pragma unroll
                for (int q = 0; q < 16; ++q) { const float xb = xn[q]; XC[q * 65 + lane] = cb + cw0 * x1 + cw1 * x2 + cw2 * x3 + cw3 * xb; x1 = x2; x2 = x3; x3 = xb; }
                WAVE_LDS_SYNC();
                float av[16];
#pragma unroll
                for (int s4 = 0; s4 < 16; ++s4) av[s4] = XC[tl * 65 + 4 * s4 + kg];
                WAVE_LDS_SYNC();
                __builtin_amdgcn_sched_barrier(0);
                f32x4 ar[4], ai[4];
#pragma unroll
                for (int ct = 0; ct < 4; ++ct) { ar[ct] = (f32x4){0.f, 0.f, 0.f, 0.f}; ai[ct] = ar[ct]; }
#pragma unroll
                for (int s4 = 0; s4 < 8; ++s4)
#pragma unroll
                    for (int ct = 0; ct < 4; ++ct) { ar[ct] = __builtin_amdgcn_mfma_f32_16x16x4f32(av[s4], wva[s4][ct], ar[ct], 0, 0, 0); ai[ct] = __builtin_amdgcn_mfma_f32_16x16x4f32(av[s4], wvx[s4][ct], ai[ct], 0, 0, 0); }
                __builtin_amdgcn_sched_barrier(0);
                LRU_LDW(8);
                __builtin_amdgcn_sched_barrier(0);
#pragma unroll
                for (int s4 = 0; s4 < 8; ++s4)
#pragma unroll
                    for (int ct = 0; ct < 4; ++ct) { ar[ct] = __builtin_amdgcn_mfma_f32_16x16x4f32(av[8 + s4], wva[s4][ct], ar[ct], 0, 0, 0); ai[ct] = __builtin_amdgcn_mfma_f32_16x16x4f32(av[8 + s4], wvx[s4][ct], ai[ct], 0, 0, 0); }
                __builtin_amdgcn_sched_barrier(0);
#undef LRU_LDW
#pragma unroll
                for (int ct = 0; ct < 4; ++ct)
#pragma unroll
                    for (int e = 0; e < 4; ++e) { GR[(4 * kg + e) * 64 + 4 * tl + ct] = ar[ct][e]; GI[(4 * kg + e) * 64 + 4 * tl + ct] = ai[ct][e]; }
                WAVE_LDS_SYNC();
                __builtin_amdgcn_sched_barrier(0);
#pragma unroll
                for (int q = 0; q < 16; ++q) xn[q] = (t0 + 16 + q < nt) ? PROJ[(size_t)(r0 + t0 + 16 + q) * PW + C_LX + c] : 0.f;
#pragma unroll
                for (int q = 0; q < 16; ++q) {
                    if (t0 + q < nt) {
                        const float xcv = XC[q * 65 + lane];
                        const float gr = fsigmoid_(GR[q * 64 + lane] + ba), gi = fsigmoid_(GI[q * 64 + lane] + bx);
                        const float log_a = -8.0f * gr * sp;
                        const float a = expf(log_a);
                        const float u = sqrtf(-expm1f(2.0f * log_a)) * (gi * xcv);
                        hl = a * hl + u; ca = ca * a;
                        HLOC[(size_t)(r0 + t0 + q) * 512 + c] = (bf16)f2bf(hl); CUMA[(size_t)(r0 + t0 + q) * 512 + c] = (bf16)f2bf(ca);
                    }
                }
                WAVE_LDS_SYNC();
            }
            SUMM[(size_t)item * 128 + lane] = ca; SUMM[(size_t)item * 128 + 64 + lane] = hl;
        }
    }
    {
        bf16* OPART = (bf16*)(P.ws + WS_OPART); float* LSE = (float*)(P.ws + WS_LSE);
        LAS unsigned char* wl = (LAS unsigned char*)lds + 32768 + wave * ATT_WLDS;
        LAS float* btab = (LAS float*)wl;
        LAS float* fl = (LAS float*)(wl + 528);
        LAS unsigned char* vt = wl + 1024;
        const int i32 = lane & 31, hi = lane >> 5, i16 = lane & 15, q4 = i16 >> 2, p4 = i16 & 3, blk = (lane >> 4) & 1;
        const int xq = bid & 7;
        unsigned* qc2 = (unsigned*)(P.ws + WS_CTL) + CW_QUEUE + 512 + (l * 8 + xq) * 64;
        for (int item = qpop(qc2, lane); item < NB * 192; item = qpop(qc2, lane)) {
            const int bh = xq + 8 * (item / 192), rem = item % 192, g = rem >> 6, e = rem & 63;
            const int b = bh >> 3, h = bh & 7;
            const int dil = g == 0 ? 1 : (g == 1 ? 4 : 16), lgn = g == 0 ? 6 : (g == 1 ? 4 : 2);
            const int c = e >> lgn, l0 = (e & ((1 << lgn) - 1)) * 32;
            const bf16* base = QKVB + ((size_t)b * SEQ + c) * 3072 + h * 128;
            const size_t rstride = (size_t)dil * 3072;
            for (int d = lane; d < 129; d += 64) btab[d] = att_bias(rel_bias, d * dil, h) * 1.4426950408889634f;
            bf16x8 qf[8];
            { const bf16* qp = base + (size_t)(l0 + i32) * rstride + hi * 8;
#pragma unroll
              for (int ks = 0; ks < 8; ++ks) qf[ks] = *(const bf16x8*)(qp + ks * 16); }
            WAVE_LDS_SYNC();
            const int jmin = l0 >= 128 ? 0 : (128 - l0) >> 5;
            f32x16 sc[5];
            float mloc = -INFINITY;
            bf16x8 kf[1][8];
#define ATT_LDK(SET, J) do { const bf16* kp_ = base + (size_t)(l0 - 128 + 32 * (J) + i32) * rstride + 1024 + hi * 8; \
                _Pragma("unroll") for (int ks = 0; ks < 8; ++ks) kf[SET][ks] = *(const bf16x8*)(kp_ + ks * 16); } while (0)
#pragma unroll
            for (int j = 0; j < 5; ++j) {
                if (j >= jmin) {
                    ATT_LDK(0, j);
                    f32x16 acc;
#pragma unroll
                    for (int r = 0; r < 16; ++r) acc[r] = 0.f;
#pragma unroll
                    for (int ks = 0; ks < 8; ++ks) acc = __builtin_amdgcn_mfma_f32_32x32x16_bf16(kf[0][ks], qf[ks], acc, 0, 0, 0);
#pragma unroll
                    for (int r = 0; r < 16; ++r) {
                        const int kk = (r & 3) + 8 * (r >> 2) + 4 * hi;
                        const int delta = i32 + 128 - 32 * j - kk;
                        bool ok = true;
                        if (j == 0) ok = kk >= i32;
                        if (j == 4) ok = kk <= i32;
                        const float sv = ok ? acc[r] * (ATT_SCALE * 1.4426950408889634f) + btab[ok ? delta : 0] : -INFINITY;
                        acc[r] = sv; mloc = fmaxf(mloc, sv);
                    }
                    sc[j] = acc;
                } else {
#pragma unroll
                    for (int r = 0; r < 16; ++r) sc[j][r] = -INFINITY;
                }
            }
#undef ATT_LDK
            v4u vr[1][8];
#define ATT_LDV(SET, J) do { _Pragma("unroll") for (int i = 0; i < 8; ++i) vr[0][i] = *(const v4u*)(base + (size_t)(l0 - 128 + 32 * (J) + 4 * i + (lane >> 4)) * rstride + 2048 + i16 * 8); } while (0)
            if (jmin == 0) ATT_LDV(0, 0);
            const float m = fmaxf(mloc, __shfl_xor(mloc, 32));
            float lsum = 0.f;
            bf16x8 pf[5][2];
#pragma unroll
            for (int j = 0; j < 5; ++j) {
#pragma unroll
                for (int r = 0; r < 16; ++r) { const float p = __builtin_amdgcn_exp2f(sc[j][r] - m); sc[j][r] = p; lsum += p; }
#pragma unroll
                for (int s2 = 0; s2 < 2; ++s2) {
                    v4u w; w.x = pk2(sc[j][8 * s2 + 0], sc[j][8 * s2 + 1]); w.y = pk2(sc[j][8 * s2 + 2], sc[j][8 * s2 + 3]);
                    w.z = pk2(sc[j][8 * s2 + 4], sc[j][8 * s2 + 5]); w.w = pk2(sc[j][8 * s2 + 6], sc[j][8 * s2 + 7]);
                    pf[j][s2] = __builtin_bit_cast(bf16x8, w);
                }
            }
            const float lt = lsum + __shfl_xor(lsum, 32);
            if (hi == 0) fl[i32] = 1.0f / lt;
            f32x16 o[4];
#pragma unroll
            for (int db = 0; db < 4; ++db)
#pragma unroll
                for (int r = 0; r < 16; ++r) o[db][r] = 0.f;
#pragma unroll
            for (int j = 0; j < 5; ++j) {
                if (j >= jmin) {
                    WAVE_LDS_SYNC();
#pragma unroll
                    for (int i = 0; i < 8; ++i) *(LAS v4u*)(vt + (4 * i + (lane >> 4)) * 320 + i16 * 16) = vr[0][i];
                }
                if (j + 1 < 5 && j + 1 >= jmin) ATT_LDV((j + 1) & 1, j + 1);
                if (j >= jmin) {
                    WAVE_LDS_SYNC();
                    s16x4 vlo[8], vhv[8];
#pragma unroll
                    for (int db = 0; db < 4; ++db)
#pragma unroll
                        for (int s2 = 0; s2 < 2; ++s2) {
                            const LAS unsigned char* a0 = vt + (16 * s2 + 4 * hi + q4) * 320 + (32 * db + 16 * blk + 4 * p4) * 2;
                            vlo[db * 2 + s2] = __builtin_bit_cast(s16x4, __builtin_amdgcn_ds_read_tr16_b64_v4i16((LAS s16x4*)a0));
                            vhv[db * 2 + s2] = __builtin_bit_cast(s16x4, __builtin_amdgcn_ds_read_tr16_b64_v4i16((LAS s16x4*)(a0 + 8 * 320)));
                        }
                    WAVE_LDS_SYNC();
                    __builtin_amdgcn_sched_barrier(0);
#pragma unroll
                    for (int db = 0; db < 4; ++db)
#pragma unroll
                        for (int s2 = 0; s2 < 2; ++s2) {
                            const s16x4 lo = vlo[db * 2 + s2], hv = vhv[db * 2 + s2];
                            const bf16x8 vf = (bf16x8){lo[0], lo[1], lo[2], lo[3], hv[0], hv[1], hv[2], hv[3]};
                            o[db] = __builtin_amdgcn_mfma_f32_32x32x16_bf16(pf[j][s2], vf, o[db], 0, 0, 0);
                        }
                    __builtin_amdgcn_sched_barrier(0);
                }
            }
#undef ATT_LDV
            WAVE_LDS_SYNC();
            float li[16];
#pragma unroll
            for (int r = 0; r < 16; ++r) li[r] = fl[(r & 3) + 8 * (r >> 2) + 4 * hi];
#pragma unroll
            for (int db = 0; db < 4; ++db)
#pragma unroll
                for (int r = 0; r < 16; ++r) *(LAS unsigned short*)(vt + ((r & 3) + 8 * (r >> 2) + 4 * hi) * 272 + (32 * db + i32) * 2) = (unsigned short)f2bf(o[db][r] * li[r]);
            WAVE_LDS_SYNC();
            bf16* og = OPART + (size_t)g * MP * 1024;
#pragma unroll
            for (int i = 0; i < 8; ++i) { const int row = 4 * i + (lane >> 4);
                const v4u v = *(const LAS v4u*)(vt + row * 272 + i16 * 16);
                *(v4u*)(og + ((size_t)b * SEQ + (size_t)(l0 + row) * dil + c) * 1024 + h * 128 + i16 * 8) = v; }
            if (hi == 0) LSE[((size_t)g * MP + (size_t)b * SEQ + (size_t)(l0 + i32) * dil + c) * 8 + h] = (m + __builtin_amdgcn_logf(lt)) * 0.6931471805599453f;
            WAVE_LDS_SYNC();
        }
    }
}

template <int CTRL, int RM> __device__ __forceinline__ float dpp0(float x) { return __int_as_float(__builtin_amdgcn_update_dpp(0, __float_as_int(x), CTRL, RM, 0xF, false)); }
__device__ __forceinline__ float wave_total(float x) {
    x += dpp0<0xB1, 0xF>(x); x += dpp0<0x4E, 0xF>(x); x += dpp0<0x141, 0xF>(x); x += dpp0<0x140, 0xF>(x);
    x += dpp0<0x142, 0xA>(x); x += dpp0<0x143, 0xC>(x);
    return rdl(x, 63);
}
constexpr int SCAN_ITEMS = NSEQ * 8 * 8;
constexpr int SCAN_Q = 5 * 2048 + 256;
constexpr int SCAN_AB = SCAN_Q + 1024;
constexpr int SCAN_BUF = SCAN_AB + 32;
__device__ __forceinline__ void scan_stage_store(LAS float* buf, const f32x4 (&st)[6], int tid, int stt, int sk4) {
    LAS float* d = buf + stt * 64 + sk4;
#pragma unroll
    for (int a = 0; a < 5; ++a) *(LAS f32x4*)(d + a * 2048) = st[a];
    if (tid < 64) *(LAS f32x4*)(buf + 10240 + (tid >> 1) * 8 + (tid & 1) * 4) = st[5];
    f32x4 kn;
    kn.x = __shfl_down(st[0].x, 16); kn.y = __shfl_down(st[0].y, 16); kn.z = __shfl_down(st[0].z, 16); kn.w = __shfl_down(st[0].w, 16);
    float pa = st[2].x * kn.x + st[2].y * kn.y + st[2].z * kn.z + st[2].w * kn.w;
    float pb = st[3].x * kn.x + st[3].y * kn.y + st[3].z * kn.z + st[3].w * kn.w;
    pa += dpp0<0xB1, 0xF>(pa); pa += dpp0<0x4E, 0xF>(pa); pa += dpp0<0x141, 0xF>(pa); pa += dpp0<0x140, 0xF>(pa);
    pb += dpp0<0xB1, 0xF>(pb); pb += dpp0<0x4E, 0xF>(pb); pb += dpp0<0x141, 0xF>(pb); pb += dpp0<0x140, 0xF>(pb);
    if ((stt & 1) == 0) {
        *(LAS f32x4*)(buf + SCAN_Q + (stt >> 1) * 64 + sk4) = st[1] * kn;
        if (sk4 == 0) { buf[SCAN_AB + stt] = pa; buf[SCAN_AB + stt + 1] = pb; }
    }
}
template <int CTRL> __device__ __forceinline__ float dppa(float x) { return x + __int_as_float(__builtin_amdgcn_update_dpp(0, __float_as_int(x), CTRL, 0xF, 0xF, true)); }
__device__ __forceinline__ float row16_sum(float x) { x = dppa<0xB1>(x); x = dppa<0x4E>(x); x = dppa<0x141>(x); x = dppa<0x140>(x); return x; }
__device__ __forceinline__ void ph_scan(const Params& P, int l, int bid, int nb, int tid, int wave, int lane, LAS float* lds) {
    const float* RWB = (const float*)(P.ws + WS_RWB);
    bf16* YRAW = (bf16*)(P.ws + WS_YRAW);
    float* out = P.out;
    LAS float* Pw = lds + 2 * SCAN_BUF + wave * (16 * 68);
    const int stt = tid >> 4, sk4 = (tid & 15) * 4;
    const int rw = lane >> 4, kq4 = (lane & 15) * 4;
    for (int item = bid; item < SCAN_ITEMS; item += nb) {
        int s, h, rg;
        if (item < NB * 64) { s = item >> 6; h = (item >> 3) & 7; rg = item & 7; }
        else { const int q = item - NB * 64; s = NB + (q >> 6); h = (q >> 3) & 7; rg = q & 7; }
        int row0, T; seq_of(s, row0, T);
        const int v = rg * 8 + (wave & 1) * 4 + rw;
        f32x4 S = (f32x4){0.f, 0.f, 0.f, 0.f};
        if (s >= NB && wave < 2) S = *(const f32x4*)(P.in[2] + ((((size_t)l * DB + (s - NB)) * 8 + h) * 64 + v) * 64 + kq4);
        const int nchunk = (T + 31) >> 5;
        f32x4 st[6];
        {
            const bool ok = stt < T;
            const float* src = RWB + (size_t)(row0 + (ok ? stt : 0)) * 3584 + h * 64 + sk4;
            st[0] = *(const f32x4*)(src + 2048); st[1] = *(const f32x4*)(src + 512); st[2] = *(const f32x4*)(src + 2560); st[3] = *(const f32x4*)(src + 1024); st[4] = *(const f32x4*)(src);
            if (tid < 64) { const int vt = tid >> 1; st[5] = *(const f32x4*)(RWB + (size_t)(row0 + (vt < T ? vt : 0)) * 3584 + 1536 + h * 64 + rg * 8 + (tid & 1) * 4); }
            scan_stage_store(lds, st, tid, stt, sk4);
        }
        __syncthreads();
        for (int ch = 0; ch < nchunk; ++ch) {
            const LAS float* cur = lds + (ch & 1) * SCAN_BUF;
            const bool more = ch + 1 < nchunk;
            if (more) {
                const int t1 = (ch + 1) * 32;
                const bool ok = t1 + stt < T;
                const float* src = RWB + (size_t)(row0 + (ok ? t1 + stt : 0)) * 3584 + h * 64 + sk4;
                st[0] = *(const f32x4*)(src + 2048); st[1] = *(const f32x4*)(src + 512); st[2] = *(const f32x4*)(src + 2560); st[3] = *(const f32x4*)(src + 1024); st[4] = *(const f32x4*)(src);
                if (tid < 64) { const int vt = t1 + (tid >> 1); st[5] = *(const f32x4*)(RWB + (size_t)(row0 + (vt < T ? vt : 0)) * 3584 + 1536 + h * 64 + rg * 8 + (tid & 1) * 4); }
            }
            const int nsteps = (T - ch * 32) < 32 ? (T - ch * 32) : 32;
            if (wave < 2) {
                const LAS float* cl = cur + kq4;
                const LAS float* cvp = cur + 10240 + (wave & 1) * 4 + rw;
#define SCAN_DECL(X) f32x4 kk##X, qv##X, w0##X, b0##X, p0##X, r0##X, w1##X, b1##X, p1##X, r1##X; float v0##X, v1##X, al##X, be##X
#define SCAN_LD(T2, X) do { const int t_ = (T2); \
                    kk##X = *(const LAS f32x4*)(cl + t_ * 64); qv##X = *(const LAS f32x4*)(cur + SCAN_Q + (t_ >> 1) * 64 + kq4); \
                    w0##X = *(const LAS f32x4*)(cl + 2048 + t_ * 64); b0##X = *(const LAS f32x4*)(cl + 4096 + t_ * 64); p0##X = *(const LAS f32x4*)(cl + 6144 + t_ * 64); r0##X = *(const LAS f32x4*)(cl + 8192 + t_ * 64); \
                    w1##X = *(const LAS f32x4*)(cl + 2048 + t_ * 64 + 64); b1##X = *(const LAS f32x4*)(cl + 4096 + t_ * 64 + 64); p1##X = *(const LAS f32x4*)(cl + 6144 + t_ * 64 + 64); r1##X = *(const LAS f32x4*)(cl + 8192 + t_ * 64 + 64); \
                    v0##X = cvp[t_ * 8]; v1##X = cvp[t_ * 8 + 8]; al##X = cur[SCAN_AB + t_]; be##X = cur[SCAN_AB + t_ + 1]; } while (0)
#define LO(v) (v).xy
#define HI(v) (v).zw
#define SCAN_PAIR(T2, X) do { \
                    f32x2 e1 = Sa * LO(kk##X); e1 = Sb * HI(kk##X) + e1; f32x2 e2 = Sa * LO(qv##X); e2 = Sb * HI(qv##X) + e2; \
                    const float d1 = row16_sum(e1.x + e1.y), d2 = row16_sum(e2.x + e2.y); \
                    const float sa0 = -d1; const float sa1 = -d2 - v0##X * be##X - sa0 * al##X; \
                    const f32x2 vv0 = (f32x2){v0##X, v0##X}, vv1 = (f32x2){v1##X, v1##X}, ss0 = (f32x2){sa0, sa0}, ss1 = (f32x2){sa1, sa1}; \
                    Sa = Sa * LO(w0##X) + (LO(b0##X) * ss0 + LO(p0##X) * vv0); Sb = Sb * HI(w0##X) + (HI(b0##X) * ss0 + HI(p0##X) * vv0); \
                    f32x2 y0 = Sa * LO(r0##X); y0 = Sb * HI(r0##X) + y0; \
                    Sa = Sa * LO(w1##X) + (LO(b1##X) * ss1 + LO(p1##X) * vv1); Sb = Sb * HI(w1##X) + (HI(b1##X) * ss1 + HI(p1##X) * vv1); \
                    f32x2 y1 = Sa * LO(r1##X); y1 = Sb * HI(r1##X) + y1; \
                    Pw[((T2) & 15) * 68 + lane] = y0.x + y0.y; Pw[(((T2) & 15) + 1) * 68 + lane] = y1.x + y1.y; \
                    if ((((T2) + 2) & 15) == 0 || (T2) + 2 >= nsteps) { \
                        const int hb = (T2) & ~15, ns = (T2) + 2 - hb; \
                        WAVE_LDS_SYNC(); \
                        { const int t = lane >> 2, rr = lane & 3; \
                          const LAS f32x4* pp = (const LAS f32x4*)(Pw + t * 68 + rr * 16); \
                          const f32x4 a0 = pp[0], a1 = pp[1], a2 = pp[2], a3 = pp[3]; \
                          const float y = ((a0.x + a0.y) + (a0.z + a0.w)) + ((a1.x + a1.y) + (a1.z + a1.w)) + ((a2.x + a2.y) + (a2.z + a2.w)) + ((a3.x + a3.y) + (a3.z + a3.w)); \
                          if (t < ns) YRAW[(size_t)(row0 + ch * 32 + hb + t) * 512 + h * 64 + rg * 8 + (wave & 1) * 4 + rr] = (bf16)f2bf(y); } \
                        WAVE_LDS_SYNC(); } } while (0)
                f32x2 Sa = S.xy, Sb = S.zw;
                SCAN_DECL(A); SCAN_DECL(B);
                SCAN_LD(0, A);
#pragma unroll 1
                for (int t2 = 0; t2 < nsteps; t2 += 4) {
                    SCAN_LD(t2 + 2, B);
                    SCAN_PAIR(t2, A);
                    SCAN_LD((t2 + 4 < 32) ? t2 + 4 : t2, A);
                    SCAN_PAIR(t2 + 2, B);
                }
                S.xy = Sa; S.zw = Sb;
#undef SCAN_PAIR
#undef LO
#undef HI
#undef SCAN_DECL
            }
#undef SCAN_LD
            if (more) scan_stage_store(lds + ((ch + 1) & 1) * SCAN_BUF, st, tid, stt, sk4);
            __syncthreads();
        }
        if (wave < 2) {
            float* so = (s < NB) ? out + O_WKV_P + ((((size_t)l * NB + s) * 8 + h) * 64 + v) * 64
                                 : out + O_WKV_S + ((((size_t)l * DB + (s - NB)) * 8 + h) * 64 + v) * 64;
            *(f32x4*)(so + kq4) = S;
        }
    }
}
constexpr int S2_ARR = 16 * 64, S2_V = 5 * S2_ARR, S2_Q = S2_V + 128, S2_AB = S2_Q + 512, S2_BUF = S2_AB + 32;
struct Scan2St { f32x4 a[2][5]; f32x4 v; };
__device__ __forceinline__ void scan2_load(Scan2St& st, const float* RWB, int row0, int t0, int T, int h, int rg, int tid) {
    const int sk4 = (tid & 15) * 4;
#pragma unroll
    for (int i = 0; i < 2; ++i) { const int t = t0 + (tid >> 4) + 8 * i;
        const float* src = RWB + (size_t)(row0 + (t < T ? t : 0)) * 3584 + h * 64 + sk4;
        st.a[i][0] = *(const f32x4*)(src + 2048); st.a[i][1] = *(const f32x4*)(src + 512); st.a[i][2] = *(const f32x4*)(src + 2560); st.a[i][3] = *(const f32x4*)(src + 1024); st.a[i][4] = *(const f32x4*)(src); }
    if (tid < 32) { const int vt = t0 + (tid >> 1); st.v = *(const f32x4*)(RWB + (size_t)(row0 + (vt < T ? vt : 0)) * 3584 + 1536 + h * 64 + rg * 8 + (tid & 1) * 4); }
}
__device__ __forceinline__ void scan2_store(LAS float* buf, const Scan2St& st, int tid) {
    const int sk4 = (tid & 15) * 4;
#pragma unroll
    for (int i = 0; i < 2; ++i) { const int stt = (tid >> 4) + 8 * i;
        LAS float* d = buf + stt * 64 + sk4;
#pragma unroll
        for (int a = 0; a < 5; ++a) *(LAS f32x4*)(d + a * S2_ARR) = st.a[i][a];
        f32x4 kn;
        kn.x = __shfl_down(st.a[i][0].x, 16); kn.y = __shfl_down(st.a[i][0].y, 16); kn.z = __shfl_down(st.a[i][0].z, 16); kn.w = __shfl_down(st.a[i][0].w, 16);
        float pa = st.a[i][2].x * kn.x + st.a[i][2].y * kn.y + st.a[i][2].z * kn.z + st.a[i][2].w * kn.w;
        float pb = st.a[i][3].x * kn.x + st.a[i][3].y * kn.y + st.a[i][3].z * kn.z + st.a[i][3].w * kn.w;
        pa = row16_sum(pa); pb = row16_sum(pb);
        if ((stt & 1) == 0) {
            *(LAS f32x4*)(buf + S2_Q + (stt >> 1) * 64 + sk4) = st.a[i][1] * kn;
            if (sk4 == 0) { buf[S2_AB + stt] = pa; buf[S2_AB + stt + 1] = pb; }
        } }
    if (tid < 32) *(LAS f32x4*)(buf + S2_V + (tid >> 1) * 8 + (tid & 1) * 4) = st.v;
}
__device__ __forceinline__ void scan2_meet(volatile LAS unsigned* fl, int wave, unsigned seq, int lane) {
    WAVE_LDS_SYNC();
    if (lane == 0) fl[wave] = seq;
    while (fl[wave ^ 1] < seq) { }
    asm volatile("" ::: "memory");
}
__device__ __forceinline__ void ph_scan2(const Params& P, int l, int item0, int istride, int tid, int wave, int lane, LAS float* lds, volatile LAS unsigned* fl) {
    const float* RWB = (const float*)(P.ws + WS_RWB);
    bf16* YRAW = (bf16*)(P.ws + WS_YRAW);
    float* out = P.out;
    LAS float* Pw = lds + 2 * S2_BUF + wave * (16 * 68);
    const int rw = lane >> 4, kq4 = (lane & 15) * 4;
    unsigned seq = (unsigned)l * 1000000u + 1u;
    for (int item = item0; item < SCAN_ITEMS; item += istride) {
        int s, h, rg;
        if (item < NB * 64) { s = item >> 6; h = (item >> 3) & 7; rg = item & 7; }
        else { const int q = item - NB * 64; s = NB + (q >> 6); h = (q >> 3) & 7; rg = q & 7; }
        int row0, T; seq_of(s, row0, T);
        const int v = rg * 8 + wave * 4 + rw;
        f32x4 S = (f32x4){0.f, 0.f, 0.f, 0.f};
        if (s >= NB) S = *(const f32x4*)(P.in[2] + ((((size_t)l * DB + (s - NB)) * 8 + h) * 64 + v) * 64 + kq4);
        const int nchunk = (T + 15) >> 4;
        Scan2St st;
        scan2_load(st, RWB, row0, 0, T, h, rg, tid);
        scan2_store(lds, st, tid);
        scan2_meet(fl, wave, seq++, lane);
        for (int ch = 0; ch < nchunk; ++ch) {
            const LAS float* cur = lds + (ch & 1) * S2_BUF;
            const bool more = ch + 1 < nchunk;
            if (more) scan2_load(st, RWB, row0, (ch + 1) * 16, T, h, rg, tid);
            const int nsteps = (T - ch * 16) < 16 ? (T - ch * 16) : 16;
            const LAS float* cl = cur + kq4;
            const LAS float* cvp = cur + S2_V + wave * 4 + rw;
#define SCAN_DECL(X) f32x4 kk##X, qv##X, w0##X, b0##X, p0##X, r0##X, w1##X, b1##X, p1##X, r1##X; float v0##X, v1##X, al##X, be##X
#define SCAN_LD(T2, X) do { const int t_ = (T2); \
                kk##X = *(const LAS f32x4*)(cl + t_ * 64); qv##X = *(const LAS f32x4*)(cur + S2_Q + (t_ >> 1) * 64 + kq4); \
                w0##X = *(const LAS f32x4*)(cl + S2_ARR + t_ * 64); b0##X = *(const LAS f32x4*)(cl + 2 * S2_ARR + t_ * 64); p0##X = *(const LAS f32x4*)(cl + 3 * S2_ARR + t_ * 64); r0##X = *(const LAS f32x4*)(cl + 4 * S2_ARR + t_ * 64); \
                w1##X = *(const LAS f32x4*)(cl + S2_ARR + t_ * 64 + 64); b1##X = *(const LAS f32x4*)(cl + 2 * S2_ARR + t_ * 64 + 64); p1##X = *(const LAS f32x4*)(cl + 3 * S2_ARR + t_ * 64 + 64); r1##X = *(const LAS f32x4*)(cl + 4 * S2_ARR + t_ * 64 + 64); \
                v0##X = cvp[t_ * 8]; v1##X = cvp[t_ * 8 + 8]; al##X = cur[S2_AB + t_]; be##X = cur[S2_AB + t_ + 1]; } while (0)
#define LO(v) (v).xy
#define HI(v) (v).zw
#define SCAN_PAIR(T2, X) do { \
                f32x2 e1 = Sa * LO(kk##X); e1 = Sb * HI(kk##X) + e1; f32x2 e2 = Sa * LO(qv##X); e2 = Sb * HI(qv##X) + e2; \
                const float d1 = row16_sum(e1.x + e1.y), d2 = row16_sum(e2.x + e2.y); \
                const float sa0 = -d1; const float sa1 = -d2 - v0##X * be##X - sa0 * al##X; \
                const f32x2 vv0 = (f32x2){v0##X, v0##X}, vv1 = (f32x2){v1##X, v1##X}, ss0 = (f32x2){sa0, sa0}, ss1 = (f32x2){sa1, sa1}; \
                Sa = Sa * LO(w0##X) + (LO(b0##X) * ss0 + LO(p0##X) * vv0); Sb = Sb * HI(w0##X) + (HI(b0##X) * ss0 + HI(p0##X) * vv0); \
                f32x2 y0 = Sa * LO(r0##X); y0 = Sb * HI(r0##X) + y0; \
                Sa = Sa * LO(w1##X) + (LO(b1##X) * ss1 + LO(p1##X) * vv1); Sb = Sb * HI(w1##X) + (HI(b1##X) * ss1 + HI(p1##X) * vv1); \
                f32x2 y1 = Sa * LO(r1##X); y1 = Sb * HI(r1##X) + y1; \
                Pw[(T2) * 68 + lane] = y0.x + y0.y; Pw[((T2) + 1) * 68 + lane] = y1.x + y1.y; } while (0)
            f32x2 Sa = S.xy, Sb = S.zw;
            SCAN_DECL(A); SCAN_DECL(B);
            SCAN_LD(0, A);
#pragma unroll 1
            for (int t2 = 0; t2 < nsteps; t2 += 4) {
                SCAN_LD(t2 + 2, B);
                SCAN_PAIR(t2, A);
                SCAN_LD((t2 + 4 < 16) ? t2 + 4 : t2, A);
                SCAN_PAIR(t2 + 2, B);
            }
            S.xy = Sa; S.zw = Sb;
#undef SCAN_PAIR
#undef LO
#undef HI
#undef SCAN_LD
#undef SCAN_DECL
            WAVE_LDS_SYNC();
            {
                const int t = lane >> 2, rr = lane & 3;
                const LAS f32x4* pp = (const LAS f32x4*)(Pw + t * 68 + rr * 16);
                const f32x4 a0 = pp[0], a1 = pp[1], a2 = pp[2], a3 = pp[3];
                const float y = ((a0.x + a0.y) + (a0.z + a0.w)) + ((a1.x + a1.y) + (a1.z + a1.w)) + ((a2.x + a2.y) + (a2.z + a2.w)) + ((a3.x + a3.y) + (a3.z + a3.w));
                if (t < nsteps) YRAW[(size_t)(row0 + ch * 16 + t) * 512 + h * 64 + rg * 8 + wave * 4 + rr] = (bf16)f2bf(y);
            }
            if (more) scan2_store(lds + ((ch + 1) & 1) * S2_BUF, st, tid);
            scan2_meet(fl, wave, seq++, lane);
        }
        float* so = (s < NB) ? out + O_WKV_P + ((((size_t)l * NB + s) * 8 + h) * 64 + v) * 64
                             : out + O_WKV_S + ((((size_t)l * DB + (s - NB)) * 8 + h) * 64 + v) * 64;
        *(f32x4*)(so + kq4) = S;
    }
}
__device__ __forceinline__ f32x4 mfma4(float a, float b, f32x4 c) { return __builtin_amdgcn_mfma_f32_16x16x4f32(a, b, c, 0, 0, 0); }
template <int N> __device__ __forceinline__ float dpp_shr1(float x) {
    return __int_as_float(__builtin_amdgcn_update_dpp(0x3f800000, __float_as_int(x), 0x110 + N, 0xF, 0xF, false)); }
constexpr int CPRE_ITEMS = NB * 128 * 8;
__device__ __forceinline__ void ph_chunkpre(const Params& P, int l, int gw, int ngw, int wave, int lane, LAS float* lds) {
    const float* RWB = (const float*)(P.ws + WS_RWB);
    float* CHKA = (float*)(P.ws + WS_CHKA); float* CHKB = (float*)(P.ws + WS_CHKB);
    LAS float* M0 = lds + wave * 1152; LAS float* M1 = M0 + 272; LAS float* M2 = M1 + 272; LAS float* M3 = M2 + 272;
    const int tl = lane & 15, kg = lane >> 4;
    for (int it = gw; it < CPRE_ITEMS; it += ngw) {
        const int h = it & 7, ci = (it >> 3) & 127, s = it >> 10;
        const float* base = RWB + (size_t)(s * SEQ + ci * 16 + tl) * 3584 + h * 64 + 4 * kg;
        float w[16], kk[16], b[16], kp[16], r[16];
#pragma unroll
        for (int j = 0; j < 4; ++j) { const f32x4 v0 = *(const f32x4*)(base + 512 + 16 * j), v1 = *(const f32x4*)(base + 2048 + 16 * j), v2 = *(const f32x4*)(base + 2560 + 16 * j),
                                                  v3 = *(const f32x4*)(base + 1024 + 16 * j), v4 = *(const f32x4*)(base + 16 * j);
#pragma unroll
            for (int i = 0; i < 4; ++i) { w[4 * j + i] = v0[i]; kk[4 * j + i] = v1[i]; b[4 * j + i] = v2[i]; kp[4 * j + i] = v3[i]; r[4 * j + i] = v4[i]; } }
        f32x4 g1 = (f32x4){0.f, 0.f, 0.f, 0.f}, g2 = g1, g3 = g1, g4 = g1;
        float* ca = CHKA + (size_t)it * 2048; float* cb = CHKB + (size_t)it * 3136;
#pragma unroll
        for (int j = 0; j < 4; ++j) {
            f32x4 bwv, kwv, wcv, qvv, rhv;
#pragma unroll
            for (int i = 0; i < 4; ++i) { const int q = 4 * j + i;
                float x = w[q];
                x *= dpp_shr1<1>(x); x *= dpp_shr1<2>(x); x *= dpp_shr1<4>(x); x *= dpp_shr1<8>(x);
                const float wex = dpp_shr1<1>(x);
                const float wcq = __shfl(x, (lane & 48) | 15);
                const float inv = __builtin_amdgcn_rcpf(x);
                const float bt = b[q] * inv, kt = kp[q] * inv, qv = wex * kk[q], rho = x * r[q];
                g1 = mfma4(bt, qv, g1); g2 = mfma4(kt, qv, g2); g3 = mfma4(bt, rho, g3); g4 = mfma4(kt, rho, g4);
                qvv[i] = qv; rhv[i] = rho; bwv[i] = bt * wcq; kwv[i] = kt * wcq; wcv[i] = x; }
            const int k0 = 16 * j + 4 * kg;
            *(f32x4*)(ca + tl * 64 + k0) = qvv; *(f32x4*)(ca + 1024 + tl * 64 + k0) = rhv;
#pragma unroll
            for (int i = 0; i < 4; ++i) { cb[1024 + (k0 + i) * 16 + tl] = bwv[i]; cb[2048 + (k0 + i) * 16 + tl] = kwv[i]; }
            if (tl == 15) *(f32x4*)(cb + 3072 + k0) = wcv;
        }
        f32x4 Um, Ubm, Gym, Hym;
#pragma unroll
        for (int e = 0; e < 4; ++e) { const int i = 4 * kg + e; Um[e] = i < tl ? g1[e] : 0.f; Ubm[e] = i < tl ? g2[e] : 0.f; Gym[e] = i <= tl ? g3[e] : 0.f; Hym[e] = i <= tl ? g4[e] : 0.f; }
#define CP_ST(M, X) do { _Pragma("unroll") for (int e = 0; e < 4; ++e) (M)[(4 * kg + e) * 17 + tl] = (X)[e]; } while (0)
#define CP_D(s4) ((tl == 4 * (s4) + kg) ? 1.f : 0.f)
#define CP_MM(OUT, MA, MB, FA, FB) do { float av_[4], bv_[4]; \
            __builtin_amdgcn_sched_barrier(0); \
            _Pragma("unroll") for (int s4 = 0; s4 < 4; ++s4) { av_[s4] = (MA)[tl * 17 + 4 * s4 + kg]; bv_[s4] = (MB)[(4 * s4 + kg) * 17 + tl]; } \
            _Pragma("unroll") for (int s4 = 0; s4 < 4; ++s4) { if (FA) av_[s4] = CP_D(s4) - av_[s4]; if (FB) bv_[s4] = CP_D(s4) + bv_[s4]; } \
            __builtin_amdgcn_sched_barrier(0); \
            OUT = (f32x4){0.f, 0.f, 0.f, 0.f}; \
            _Pragma("unroll") for (int s4 = 0; s4 < 4; ++s4) OUT = mfma4(av_[s4], bv_[s4], OUT); \
            __builtin_amdgcn_sched_barrier(0); } while (0)
        f32x4 Tm;
        {
            CP_ST(M0, Um); WAVE_LDS_SYNC();
            f32x4 x2; CP_MM(x2, M0, M0, false, false);
            CP_ST(M1, x2); WAVE_LDS_SYNC();
            f32x4 x4; CP_MM(x4, M1, M1, false, false);
            CP_ST(M2, x4); WAVE_LDS_SYNC();
            f32x4 x8; CP_MM(x8, M2, M2, false, false);
            CP_ST(M3, x8); WAVE_LDS_SYNC();
            f32x4 p; CP_MM(p, M0, M1, true, true);
            CP_ST(M0, p); WAVE_LDS_SYNC();
            f32x4 p2; CP_MM(p2, M0, M2, false, true);
            CP_ST(M0, p2); WAVE_LDS_SYNC();
            CP_MM(Tm, M0, M3, false, true);
        }
#undef CP_MM
#undef CP_ST
#undef CP_D
        *(f32x4*)(cb + tl * 16 + 4 * kg) = Ubm; *(f32x4*)(cb + 256 + tl * 16 + 4 * kg) = Tm; *(f32x4*)(cb + 512 + tl * 16 + 4 * kg) = Gym; *(f32x4*)(cb + 768 + tl * 16 + 4 * kg) = Hym;
    }
}
constexpr int C2_Q = 0, C2_R = 1152, C2_BW = 2304, C2_T = 3840, C2_GY = 4224, C2_WC = 4608, C2S = 4672;
constexpr int C2_KW = 0, C2_UB = 1536, C2_HY = 1920, C2_V = 2304, C2H = 2880;
constexpr int C2_RING = 0, C2_HIN = 4 * C2S, C2_HP = C2_HIN + 2 * C2H, C2_HPB = 3072, C2_XST = C2_HP + 2 * C2_HPB, C2_XSA = C2_XST + 4096, C2_HPY = C2_XSA + 1024, C2_END = C2_HPY + 3 * 768;
static_assert(C2_END * 4 <= MISC_OFF, "cscan2 LDS");
struct C2SetS { f32x4 st[8]; };
struct C2SetHk { f32x4 k[2]; };
struct C2SetHm { f32x4 m[2]; };
__device__ __forceinline__ void c2_load_state(C2SetS& r, const float* CHKA, const float* CHKB, int itc, int u) {
    const float* a = CHKA + (size_t)itc * 2048 + 4 * u; const float* b = CHKB + (size_t)itc * 3136 + 4 * u;
    r.st[0] = *(const f32x4*)(a); r.st[1] = *(const f32x4*)(a + 512); r.st[2] = *(const f32x4*)(a + 1024); r.st[3] = *(const f32x4*)(a + 1536);
    r.st[4] = *(const f32x4*)(b + 1024); r.st[5] = *(const f32x4*)(b + 1536); r.st[6] = *(const f32x4*)(b + 256);
    if (u < 16) r.st[7] = *(const f32x4*)(b + 3072);
}
__device__ __forceinline__ void c2_store_state(LAS float* buf, const C2SetS& r, int u) {
#pragma unroll
    for (int i2 = 0; i2 < 2; ++i2) { const int i = u + 128 * i2;
        *(LAS f32x4*)(buf + C2_Q + (i >> 4) * 72 + (i & 15) * 4) = r.st[i2]; *(LAS f32x4*)(buf + C2_R + (i >> 4) * 72 + (i & 15) * 4) = r.st[2 + i2];
        *(LAS f32x4*)(buf + C2_BW + (i >> 2) * 24 + (i & 3) * 4) = r.st[4 + i2]; }
    { const int j = u & 63; *(LAS f32x4*)(buf + (u < 64 ? C2_T : C2_GY) + (j >> 2) * 24 + (j & 3) * 4) = r.st[6]; }
    if (u < 16) *(LAS f32x4*)(buf + C2_WC + 4 * u) = r.st[7];
}
__device__ __forceinline__ void c2_load_hk(C2SetHk& r, const float* CHKB, int itc, int u) {
    const float* b = CHKB + (size_t)itc * 3136;
    r.k[0] = *(const f32x4*)(b + 2048 + 4 * u); r.k[1] = *(const f32x4*)(b + 2560 + 4 * u);
}
__device__ __forceinline__ void c2_store_hk(LAS float* buf, const C2SetHk& r, int u) {
#pragma unroll
    for (int i2 = 0; i2 < 2; ++i2) { const int i = u + 128 * i2; *(LAS f32x4*)(buf + C2_KW + (i >> 2) * 24 + (i & 3) * 4) = r.k[i2]; }
}
__device__ __forceinline__ void c2_load_hm(C2SetHm& r, const float* CHKB, const float* vsrc, int itc, int u) {
    const float* b = CHKB + (size_t)itc * 3136;
    r.m[0] = *(const f32x4*)(b + (u < 64 ? 4 * u : 768 + 4 * (u - 64)));
    r.m[1] = *(const f32x4*)(vsrc + (size_t)(u >> 3) * 3584 + (u & 7) * 4);
}
__device__ __forceinline__ void c2_store_hm(LAS float* buf, const C2SetHm& r, int u) {
    { const int j = u & 63; *(LAS f32x4*)(buf + (u < 64 ? C2_UB : C2_HY) + (j >> 2) * 24 + (j & 3) * 4) = r.m[0]; }
    *(LAS f32x4*)(buf + C2_V + (u >> 3) * 36 + (u & 7) * 4) = r.m[1];
}
constexpr int C2_NBAR = 131;
#define c2_meet(fl, wave, seq, lane) do { asm volatile("s_waitcnt lgkmcnt(0)" ::: "memory"); __builtin_amdgcn_s_barrier(); asm volatile("" ::: "memory"); } while (0)
template <bool DOY, bool DOP>
__device__ __forceinline__ void c2_helper_step(LAS float* lds, int cy, int cp, int g, int tl, int kg, int lane, bf16* yout  ) {
    const LAS float* By = lds + C2_RING + (cy & 3) * C2S;
    const LAS float* Bn = lds + C2_HIN + (cp & 1) * C2H; LAS float* HPn = lds + C2_HP + (cp & 1) * C2_HPB + g * 1536;
    f32x4 ar[4], gy, yh, xs[4], xa;
    float vb[4]; f32x4 ua, ha, ka[4];
    __builtin_amdgcn_sched_barrier(0);
    if (DOY) {
#pragma unroll
        for (int tile = 0; tile < 4; ++tile) { xs[tile] = *(const LAS f32x4*)(lds + C2_XST + (((cy & 1) * 2 + g) * 4 + tile) * 256 + lane * 4);
            ar[tile] = *(const LAS f32x4*)(By + C2_R + tl * 72 + 16 * tile + 4 * kg); }
        xa = *(const LAS f32x4*)(lds + C2_XSA + ((cy & 1) * 2 + g) * 256 + lane * 4);
        gy = *(const LAS f32x4*)(By + C2_GY + tl * 24 + 4 * kg); yh = *(const LAS f32x4*)(lds + C2_HPY + (cy % 3) * 768 + g * 384 + tl * 24 + 4 * kg);
    }
    if (DOP) {
#pragma unroll
        for (int e = 0; e < 4; ++e) vb[e] = Bn[C2_V + (4 * kg + e) * 36 + 16 * g + tl];
        ua = *(const LAS f32x4*)(Bn + C2_UB + tl * 24 + 4 * kg); ha = *(const LAS f32x4*)(Bn + C2_HY + tl * 24 + 4 * kg);
#pragma unroll
        for (int tile = 0; tile < 4; ++tile) ka[tile] = *(const LAS f32x4*)(Bn + C2_KW + (16 * tile + tl) * 24 + 4 * kg);
    }
    __builtin_amdgcn_sched_barrier(0);
    const f32x4 z4 = (f32x4){0.f, 0.f, 0.f, 0.f};
    f32x4 y = z4, du = z4, dh = z4, dk[4] = {z4, z4, z4, z4};
    if (DOY) {
        f32x4 pr = z4;
#pragma unroll
        for (int tile = 0; tile < 4; ++tile)
#pragma unroll
            for (int reg = 0; reg < 4; ++reg) pr = mfma4(ar[tile][reg], xs[tile][reg], pr);
        y = pr + yh;
#pragma unroll
        for (int e = 0; e < 4; ++e) y = mfma4(gy[e], xa[e], y);
    }
    if (DOP) {
#pragma unroll
        for (int e = 0; e < 4; ++e) { du = mfma4(ua[e], vb[e], du); dh = mfma4(ha[e], vb[e], dh);
#pragma unroll
            for (int tile = 0; tile < 4; ++tile) dk[tile] = mfma4(ka[tile][e], vb[e], dk[tile]); }
    }
    __builtin_amdgcn_sched_barrier(0);
    if (DOY) {
#pragma unroll
        for (int e = 0; e < 4; ++e) yout[(size_t)e * 512] = (bf16)f2bf(y[e]);
    }
    if (DOP) {
        *(LAS f32x4*)(HPn + tl * 24 + 4 * kg) = du; *(LAS f32x4*)(lds + C2_HPY + (cp % 3) * 768 + g * 384 + tl * 24 + 4 * kg) = dh;
#pragma unroll
        for (int tile = 0; tile < 4; ++tile) *(LAS f32x4*)(HPn + 384 + tl * 72 + 16 * tile + 4 * kg) = dk[tile];
    }
    __builtin_amdgcn_sched_barrier(0);
}
__device__ __forceinline__ void ph_cscan2(const Params& P, int l, int bid, int wave, int lane, LAS float* lds, volatile LAS unsigned* fl) {
    const float* RWB = (const float*)(P.ws + WS_RWB);
    const float* CHKA = (const float*)(P.ws + WS_CHKA); const float* CHKB = (const float*)(P.ws + WS_CHKB);
    bf16* YRAW = (bf16*)(P.ws + WS_YRAW);
    const int bh = (bid & 7) + 8 * (bid >> 4), half = (bid >> 3) & 1;
    const int s = bh >> 3, h = bh & 7, row0 = s * SEQ;
    const int tl = lane & 15, kg = lane >> 4;
    const int it0 = (s * 128) * 8 + h;
    if (wave >= 6) {
        const int g = wave - 6, u = g * 64 + lane;
        const float* vsrc0 = RWB + (size_t)row0 * 3584 + 1536 + h * 64 + 32 * half;
        C2SetHm ha_, hb_, hc_, hd_, he_;
        c2_load_hm(ha_, CHKB, vsrc0, it0, u); c2_load_hm(hb_, CHKB, vsrc0 + (size_t)16 * 3584, it0 + 8, u);
        c2_store_hm(lds + C2_HIN, ha_, u); c2_store_hm(lds + C2_HIN + C2H, hb_, u);
        c2_load_hm(ha_, CHKB, vsrc0 + (size_t)32 * 3584, it0 + 16, u); c2_load_hm(hb_, CHKB, vsrc0 + (size_t)48 * 3584, it0 + 24, u); c2_load_hm(hc_, CHKB, vsrc0 + (size_t)64 * 3584, it0 + 32, u);
        c2_load_hm(hd_, CHKB, vsrc0 + (size_t)80 * 3584, it0 + 40, u); c2_load_hm(he_, CHKB, vsrc0 + (size_t)96 * 3584, it0 + 48, u);
        c2_meet(fl, wave, 0, lane);
        c2_helper_step<false, true>(lds, 0, 0, g, tl, kg, lane, nullptr);
        c2_meet(fl, wave, 0, lane);
#define C2_PROD(C, R) do { const int c_ = (C); \
            if (c_ + 2 < 128) c2_store_hm(lds + C2_HIN + (c_ & 1) * C2H, R, u); \
            WAVE_LDS_SYNC(); \
            { const int c7 = c_ + 7 < 128 ? c_ + 7 : 127; c2_load_hm(R, CHKB, vsrc0 + (size_t)(16 * c7) * 3584, it0 + 8 * c7, u); } \
            c2_helper_step<false, true>(lds, 0, c_ + 1, g, tl, kg, lane, nullptr); \
            c2_meet(fl, wave, 0, lane); } while (0)
#pragma unroll 1
        for (int c = 0; c < 125; c += 5) { C2_PROD(c, ha_); C2_PROD(c + 1, hb_); C2_PROD(c + 2, hc_); C2_PROD(c + 3, hd_); C2_PROD(c + 4, he_); }
        C2_PROD(125, ha_); C2_PROD(126, hb_);
#undef C2_PROD
        c2_meet(fl, wave, 0, lane);
        c2_meet(fl, wave, 0, lane);
    } else if (wave >= 4) {
        const int u = (wave - 4) * 64 + lane;
        C2SetS ra, rb, rc, rd, re;
        c2_load_state(ra, CHKA, CHKB, it0, u); c2_load_state(rb, CHKA, CHKB, it0 + 8, u);
        c2_store_state(lds + C2_RING, ra, u); c2_store_state(lds + C2_RING + C2S, rb, u);
        c2_load_state(ra, CHKA, CHKB, it0 + 16, u); c2_load_state(rb, CHKA, CHKB, it0 + 24, u); c2_load_state(rc, CHKA, CHKB, it0 + 32, u);
        c2_load_state(rd, CHKA, CHKB, it0 + 40, u); c2_load_state(re, CHKA, CHKB, it0 + 48, u);
        c2_meet(fl, wave, seq++, lane);
        c2_meet(fl, wave, seq++, lane);
#define C2_STAGE(C, R) do { const int c_ = (C); \
            if (c_ + 2 < 128) c2_store_state(lds + C2_RING + ((c_ + 2) & 3) * C2S, R, u); \
            WAVE_LDS_SYNC(); \
            { const int c7 = c_ + 7 < 128 ? c_ + 7 : 127; c2_load_state(R, CHKA, CHKB, it0 + 8 * c7, u); } \
            c2_meet(fl, wave, seq++, lane); } while (0)
#pragma unroll 1
        for (int c = 0; c < 125; c += 5) { C2_STAGE(c, ra); C2_STAGE(c + 1, rb); C2_STAGE(c + 2, rc); C2_STAGE(c + 3, rd); C2_STAGE(c + 4, re); }
        C2_STAGE(125, ra); C2_STAGE(126, rb); C2_STAGE(127, rc);
#undef C2_STAGE
        c2_meet(fl, wave, seq++, lane);
    } else if (wave >= 2) {
        const int g = wave - 2, u = g * 64 + lane;
        bf16* ycol = YRAW + (size_t)(row0 + 4 * kg) * 512 + h * 64 + 16 * (2 * half + g) + tl;
        const float* vsrc0 = RWB + (size_t)row0 * 3584 + 1536 + h * 64 + 32 * half;
        C2SetHk ha_, hb_, hc_, hd_, he_;
        c2_load_hk(ha_, CHKB, it0, u); c2_load_hk(hb_, CHKB, it0 + 8, u);
        c2_store_hk(lds + C2_HIN, ha_, u); c2_store_hk(lds + C2_HIN + C2H, hb_, u);
        c2_load_hk(ha_, CHKB, it0 + 16, u); c2_load_hk(hb_, CHKB, it0 + 24, u); c2_load_hk(hc_, CHKB, it0 + 32, u);
        c2_load_hk(hd_, CHKB, it0 + 40, u); c2_load_hk(he_, CHKB, it0 + 48, u);
        c2_meet(fl, wave, seq++, lane);
        c2_meet(fl, wave, seq++, lane);
#define C2_YST(C, R) do { const int c_ = (C); \
            if (c_ + 2 < 128) c2_store_hk(lds + C2_HIN + (c_ & 1) * C2H, R, u); \
            WAVE_LDS_SYNC(); \
            { const int c7 = c_ + 7 < 128 ? c_ + 7 : 127; c2_load_hk(R, CHKB, it0 + 8 * c7, u); } \
            if (c_ > 0) c2_helper_step<true, false>(lds, c_ - 1, 0, g, tl, kg, lane, ycol + (size_t)(c_ - 1) * 16 * 512); \
            c2_meet(fl, wave, seq++, lane); } while (0)
#pragma unroll 1
        for (int c = 0; c < 125; c += 5) { C2_YST(c, ha_); C2_YST(c + 1, hb_); C2_YST(c + 2, hc_); C2_YST(c + 3, hd_); C2_YST(c + 4, he_); }
        C2_YST(125, ha_); C2_YST(126, hb_); C2_YST(127, hc_);
#undef C2_YST
        c2_helper_step<true, false>(lds, 127, 0, g, tl, kg, lane, ycol + (size_t)127 * 16 * 512);
        c2_meet(fl, wave, seq++, lane);
    } else {
        const int g = wave, rg = 2 * half + g;
        f32x4 ST[4];
#pragma unroll
        for (int tile = 0; tile < 4; ++tile) ST[tile] = (f32x4){0.f, 0.f, 0.f, 0.f};
        c2_meet(fl, wave, seq++, lane);
        c2_meet(fl, wave, seq++, lane);
        f32x4 aq[4], tm, bw[4], wc[4];
#define C2_LDOPS(AQ, TM, BW, WC, BUF) do { const LAS float* B_ = (BUF); \
            _Pragma("unroll") for (int tile = 0; tile < 4; ++tile) AQ[tile] = *(const LAS f32x4*)(B_ + C2_Q + tl * 72 + 16 * tile + 4 * kg); \
            TM = *(const LAS f32x4*)(B_ + C2_T + tl * 24 + 4 * kg); \
            _Pragma("unroll") for (int tile = 0; tile < 4; ++tile) { WC[tile] = *(const LAS f32x4*)(B_ + C2_WC + 16 * tile + 4 * kg); BW[tile] = *(const LAS f32x4*)(B_ + C2_BW + (16 * tile + tl) * 24 + 4 * kg); } } while (0)
        C2_LDOPS(aq, tm, bw, wc, lds + C2_RING);
#pragma unroll 1
        for (int c = 0; c < 128; ++c) {
            const LAS float* HP = lds + C2_HP + (c & 1) * C2_HPB + g * 1536;
            f32x4 xu, vk[4], naq[4], ntm, nbw[4], nwc[4];
            __builtin_amdgcn_sched_barrier(0);
#pragma unroll
            for (int tile = 0; tile < 4; ++tile) *(LAS f32x4*)(lds + C2_XST + (((c & 1) * 2 + g) * 4 + tile) * 256 + lane * 4) = ST[tile];
            xu = *(const LAS f32x4*)(HP + tl * 24 + 4 * kg);
#pragma unroll
            for (int tile = 0; tile < 4; ++tile) vk[tile] = *(const LAS f32x4*)(HP + 384 + tl * 72 + 16 * tile + 4 * kg);
            __builtin_amdgcn_sched_barrier(0);
            f32x4 pq = (f32x4){0.f, 0.f, 0.f, 0.f}, pq2 = pq;
#pragma unroll
            for (int tile = 0; tile < 4; tile += 2)
#pragma unroll
                for (int reg = 0; reg < 4; ++reg) { pq = mfma4(aq[tile][reg], ST[tile][reg], pq); pq2 = mfma4(aq[tile + 1][reg], ST[tile + 1][reg], pq2); }
            __builtin_amdgcn_sched_barrier(0);
            C2_LDOPS(naq, ntm, nbw, nwc, lds + C2_RING + ((c + 1) & 3) * C2S);
            __builtin_amdgcn_sched_barrier(0);
            f32x4 sa = (f32x4){0.f, 0.f, 0.f, 0.f};
#pragma unroll
            for (int e = 0; e < 4; ++e) sa = mfma4(tm[e], -(pq[e] + pq2[e] + xu[e]), sa);
#pragma unroll
            for (int tile = 0; tile < 4; ++tile) ST[tile] = ST[tile] * wc[tile] + vk[tile];
            __builtin_amdgcn_sched_barrier(0);
            *(LAS f32x4*)(lds + C2_XSA + ((c & 1) * 2 + g) * 256 + lane * 4) = sa;
#pragma unroll
            for (int e = 0; e < 4; ++e)
#pragma unroll
                for (int tile = 0; tile < 4; ++tile) ST[tile] = mfma4(bw[tile][e], sa[e], ST[tile]);
            __builtin_amdgcn_sched_barrier(0);
#pragma unroll
            for (int tile = 0; tile < 4; ++tile) ST[tile][0] += 0.0f;
            asm volatile("" :: "v"(aq[0]), "v"(aq[1]), "v"(aq[2]), "v"(aq[3]), "v"(tm), "v"(xu));
            asm volatile("" :: "v"(bw[0]), "v"(bw[1]), "v"(bw[2]), "v"(bw[3]), "v"(wc[0]), "v"(wc[1]), "v"(wc[2]), "v"(wc[3]));
            asm volatile("" :: "v"(vk[0]), "v"(vk[1]), "v"(vk[2]), "v"(vk[3]));
            __builtin_amdgcn_sched_barrier(0);
            c2_meet(fl, wave, seq++, lane);
#pragma unroll
            for (int i = 0; i < 4; ++i) { aq[i] = naq[i]; bw[i] = nbw[i]; wc[i] = nwc[i]; }
            tm = ntm;
        }
#undef C2_LDOPS
        c2_meet(fl, wave, seq++, lane);
        float* so = P.out + O_WKV_P + ((((size_t)l * NB + s) * 8 + h) * 64 + 16 * rg + tl) * 64;
#pragma unroll
        for (int tile = 0; tile < 4; ++tile) *(f32x4*)(so + 16 * tile + 4 * kg) = ST[tile];
    }
}

__device__ __forceinline__ void ph_post(const Params& P, int l, int gw, int ngw, int lane) {
    const BfRO PROJ{(const unsigned short*)(P.ws + WS_PROJ)};
    const float* RWB = (const float*)(P.ws + WS_RWB);
    const BfRO YRAW{(const unsigned short*)(P.ws + WS_YRAW)};
    bf16* MIX = (bf16*)(P.ws + WS_MIXB);
    float* out = P.out;
    {
        const int h = gw & 7, c = h * 64 + lane;
        const float lg = P.in[24][l * 512 + c], lb = P.in[25][l * 512 + c]; const float* BON = (const float*)(P.ws + WS_BON);
#pragma unroll 1
        for (int item0 = gw; item0 < MT * 8; item0 += 8 * ngw) {
            float y[8], bs[8], vl[8], gl[8]; int rr[8];
#pragma unroll
            for (int q = 0; q < 8; ++q) { const int item = item0 + q * ngw; rr[q] = (item < MT * 8) ? (item >> 3) : (item0 >> 3);
                y[q] = YRAW[(size_t)rr[q] * 512 + c]; const float* base = RWB + (size_t)rr[q] * 3584 + c;
                bs[q] = BON[(size_t)rr[q] * 8 + h]; vl[q] = base[1536]; gl[q] = __uint_as_float((unsigned)((const bf16*)(RWB + (size_t)rr[q] * 3584 + 3072))[c] << 16); }
#pragma unroll
            for (int q = 0; q < 8; ++q) {
                const float mean = wave_total(y[q]) * (1.f / 64.f);
                const float d = y[q] - mean;
                const float var = wave_total(d * d) * (1.f / 64.f);
                const float yn = d * rsqrtf(var + GN_EPS) * lg + lb;
                const float bonus = bs[q] * vl[q];
                if (item0 + q * ngw < MT * 8) MIX[(size_t)rr[q] * D + c] = (bf16)f2bf((yn + bonus) * gl[q]);
            }
        }
    }
    {
        const bf16* OPART = (const bf16*)(P.ws + WS_OPART); const float* LSE = (const float*)(P.ws + WS_LSE);
#pragma unroll 8
        for (int item = gw; item < MP * 8; item += ngw) {
            const int r = item >> 3, h = item & 7;
            const float l0 = LSE[((size_t)0 * MP + r) * 8 + h], l1 = LSE[((size_t)1 * MP + r) * 8 + h], l2 = LSE[((size_t)2 * MP + r) * 8 + h];
            const size_t off = (size_t)r * 1024 + h * 128 + 2 * lane;
            const unsigned a0 = *(const unsigned*)(OPART + off), a1 = *(const unsigned*)(OPART + (size_t)MP * 1024 + off), a2 = *(const unsigned*)(OPART + (size_t)2 * MP * 1024 + off);
            const float mx = fmaxf(l0, fmaxf(l1, l2));
            const float w0 = fexp_(l0 - mx), w1 = fexp_(l1 - mx), w2 = fexp_(l2 - mx);
            const float inv = __builtin_amdgcn_rcpf(w0 + w1 + w2);
            const float x = (w0 * __uint_as_float(a0 << 16) + w1 * __uint_as_float(a1 << 16) + w2 * __uint_as_float(a2 << 16)) * inv;
            const float y = (w0 * __uint_as_float(a0 & 0xffff0000u) + w1 * __uint_as_float(a1 & 0xffff0000u) + w2 * __uint_as_float(a2 & 0xffff0000u)) * inv;
            *(unsigned*)(MIX + (size_t)r * D + 1024 + h * 128 + 2 * lane) = pk2(x, y);
        }
    }
    const BfRO HLOC{(const unsigned short*)(P.ws + WS_HLOC)}, CUMA{(const unsigned short*)(P.ws + WS_CUMA)}; const float* SUMM = (const float*)(P.ws + WS_SUMM);
    for (int item = gw; item < LRU_ITEMS; item += ngw) {
        int s, n, j, r0, nt; lru_item(item, s, n, j, r0, nt);
        const int c = n * 64 + lane;
        float H = (s >= NB) ? P.in[4][((size_t)l * DB + (s - NB)) * 512 + c] : 0.f;
        {
            float sa_[31], se_[31];
#pragma unroll
            for (int jj = 0; jj < 31; ++jj) { const bool in = jj < j; const float* sm = SUMM + (size_t)(item - j + (in ? jj : 0)) * 128; sa_[jj] = in ? sm[lane] : 1.f; se_[jj] = in ? sm[64 + lane] : 0.f; }
#pragma unroll
            for (int jj = 0; jj < 31; ++jj) H = sa_[jj] * H + se_[jj];
        }
        float hlast = 0.f;
#pragma unroll 1
        for (int t0 = 0; t0 < nt; t0 += 16) {
            float hl_[16], ca_[16], gb_[16];
#pragma unroll
            for (int q = 0; q < 16; ++q) { const int r = r0 + ((t0 + q < nt) ? t0 + q : 0);
                hl_[q] = HLOC[(size_t)r * 512 + c]; ca_[q] = CUMA[(size_t)r * 512 + c]; gb_[q] = PROJ[(size_t)r * PW + C_LG + c]; }
#pragma unroll
            for (int q = 0; q < 16; ++q) if (t0 + q < nt) {
                const float hh = hl_[q] + ca_[q] * H;
                MIX[(size_t)(r0 + t0 + q) * D + 512 + c] = (bf16)f2bf(hh * gelu_tanh(gb_[q]));
                hlast = hh;
            }
        }
        if (s < NB) { if (j == 31) out[O_LRUH_P + ((size_t)l * NB + s) * 512 + c] = hlast; }
        else out[O_LRUH_S + ((size_t)l * DB + (s - NB)) * 512 + c] = hlast;
    }
}

__device__ __forceinline__ void ph_norm2(const Params& P, int l, int gw, int ngw, int lane) {
    const float* gp = P.in[10] + (size_t)l * D; const float* gf = P.in[11] + (size_t)l * D;
    const bf16* Y1 = (const bf16*)(P.ws + WS_Y1);
    float* RS = (float*)(P.ws + WS_RS);
    bf16* XH = (bf16*)(P.ws + WS_XH);
    f32x4 g1v[8];
#pragma unroll
    for (int j = 0; j < 8; ++j) g1v[j] = *(const f32x4*)(gp + lane * 4 + j * 256);
    for (int r0_ = gw; r0_ < MT; r0_ += 2 * ngw) {
#pragma unroll
      for (int q_ = 0; q_ < 2; ++q_) {
        const int r = r0_ + q_ * ngw; if (r >= MT) break;
        const float* xin = r < MP ? P.in[0] + (size_t)r * D : P.in[1] + (size_t)(r - MP) * D;
        f32x4 y[8], x[8]; float ss = 0.f;
#pragma unroll
        for (int j = 0; j < 8; ++j) { { const v2u yb = *(const v2u*)(Y1 + (size_t)r * D + lane * 4 + j * 256); y[j] = (f32x4){__uint_as_float(yb.x << 16), __uint_as_float(yb.x & 0xffff0000u), __uint_as_float(yb.y << 16), __uint_as_float(yb.y & 0xffff0000u)}; } { const v2u xb = *(const v2u*)(XH + (size_t)r * D + lane * 4 + j * 256); x[j] = (f32x4){__uint_as_float(xb.x << 16), __uint_as_float(xb.x & 0xffff0000u), __uint_as_float(xb.y << 16), __uint_as_float(xb.y & 0xffff0000u)}; }
            ss += y[j].x * y[j].x + y[j].y * y[j].y + y[j].z * y[j].z + y[j].w * y[j].w; }
        ss = wave_sum(ss);
        const float rs = rsqrtf(ss * (1.f / D) + RMS_EPS);
        float s2 = 0.f;
#pragma unroll
        for (int j = 0; j < 8; ++j) { const f32x4 g = g1v[j]; x[j] = x[j] + y[j] * rs * g;
            s2 += x[j].x * x[j].x + x[j].y * x[j].y + x[j].z * x[j].z + x[j].w * x[j].w;
            *(v2u*)(XH + (size_t)r * D + lane * 4 + j * 256) = (v2u){pk2(x[j].x, x[j].y), pk2(x[j].z, x[j].w)}; }
        s2 = wave_sum(s2);
        const float rs2 = rsqrtf(s2 * (1.f / D) + RMS_EPS);
        if (lane == 0) RS[r] = rs2;
      }
    }
}
__device__ __forceinline__ void ph_norm3(const Params& P, int l, int gw, int ngw, int lane) {
    const float* gp = P.in[12] + (size_t)l * D;
    const bf16* Y1 = (const bf16*)(P.ws + WS_Y1);
    float* RS = (float*)(P.ws + WS_RS);
    float* X = P.out; bf16* XH = (bf16*)(P.ws + WS_XH);
    const float* gn = P.in[9] + (size_t)(l + 1 < DEPTH ? l + 1 : l) * D;
    f32x4 g1v[8];
#pragma unroll
    for (int j = 0; j < 8; ++j) g1v[j] = *(const f32x4*)(gp + lane * 4 + j * 256);
    for (int r0_ = gw; r0_ < MT; r0_ += 2 * ngw) {
#pragma unroll
      for (int q_ = 0; q_ < 2; ++q_) {
        const int r = r0_ + q_ * ngw; if (r >= MT) break;
        f32x4 y[8], x[8]; float ss = 0.f;
#pragma unroll
        for (int j = 0; j < 8; ++j) { if (r < MP) { const v2u yb = *(const v2u*)(Y1 + (size_t)r * D + lane * 4 + j * 256); y[j] = (f32x4){__uint_as_float(yb.x << 16), __uint_as_float(yb.x & 0xffff0000u), __uint_as_float(yb.y << 16), __uint_as_float(yb.y & 0xffff0000u)}; }
            else { const float* ys = (const float*)(P.ws + WS_YS) + (size_t)(r - MP) * 2048 + lane * 4 + j * 256;
                y[j] = (*(const f32x4*)ys + *(const f32x4*)(ys + 65536)) + (*(const f32x4*)(ys + 131072) + *(const f32x4*)(ys + 196608)); } { const v2u xb = *(const v2u*)(XH + (size_t)r * D + lane * 4 + j * 256); x[j] = (f32x4){__uint_as_float(xb.x << 16), __uint_as_float(xb.x & 0xffff0000u), __uint_as_float(xb.y << 16), __uint_as_float(xb.y & 0xffff0000u)}; }
            ss += y[j].x * y[j].x + y[j].y * y[j].y + y[j].z * y[j].z + y[j].w * y[j].w; }
        ss = wave_sum(ss);
        const float rs = rsqrtf(ss * (1.f / D) + RMS_EPS);
        float s2 = 0.f;
#pragma unroll
        for (int j = 0; j < 8; ++j) { const f32x4 g = g1v[j]; x[j] = x[j] + y[j] * rs * g;
            s2 += x[j].x * x[j].x + x[j].y * x[j].y + x[j].z * x[j].z + x[j].w * x[j].w;
            if (l + 1 < DEPTH) *(v2u*)(XH + (size_t)r * D + lane * 4 + j * 256) = (v2u){pk2(x[j].x, x[j].y), pk2(x[j].z, x[j].w)};
            else *(f32x4*)(X + (size_t)r * D + lane * 4 + j * 256) = x[j]; }
        if (l + 1 < DEPTH) {
            s2 = wave_sum(s2);
            const float rs2 = rsqrtf(s2 * (1.f / D) + RMS_EPS);
            if (lane == 0) RS[r] = rs2;
        }
      }
    }
}

constexpr int NPHASE = 1 + 10 * DEPTH;
__global__ void __launch_bounds__(NWAVES * 64, 2) mega_fwd(Params P) {
    extern __shared__ __attribute__((aligned(16))) unsigned char lds_raw[];
    LAS unsigned char* lds = (LAS unsigned char*)lds_raw;
    LAS float* ldsf = (LAS float*)lds;
    volatile LAS unsigned* MISC = (volatile LAS unsigned*)(lds + MISC_OFF);
    const int tid = threadIdx.x, lane = tid & 63, wave = __builtin_amdgcn_readfirstlane(tid >> 6);
    const int bid = blockIdx.x, nb = gridDim.x;
    const int gw = bid * NWAVES + wave, ngw = nb * NWAVES;
    for (int u = tid; u < 64; u += NWAVES * 64) ((LAS unsigned*)(lds + MISC_OFF))[u] = 0u;
    __syncthreads();
    XcdBarrier bar; bar.bar = (unsigned*)(P.ws + WS_CTL) + CW_BAR; bar.x = 0; bar.st = nullptr;
    const bool multi = (P.ph_hi - P.ph_lo) > 1;
    if (multi) bar = xcd_barrier_post((unsigned*)(P.ws + WS_CTL) + CW_BAR, MISC + 8);
    bf16* HB = (bf16*)(P.ws + WS_HB); bf16* MIXB = (bf16*)(P.ws + WS_MIXB); bf16* Y1B = (bf16*)(P.ws + WS_Y1);
    bf16* PROJ = (bf16*)(P.ws + WS_PROJ); bf16* UB = (bf16*)(P.ws + WS_UB);
    for (int ph = P.ph_lo; ph < P.ph_hi; ++ph) {
        int lane_v = lane, tid_v = tid;
        asm volatile("" : "+v"(lane_v), "+v"(tid_v));
        if (ph == 0) { ph_weights(P, gw, ngw, wave, lane_v, ldsf); ph_norm1(P, gw, ngw, lane_v); }
        else {
            const int l = (ph - 1) / 10, sub = (ph - 1) % 10;
            const int subop = sub < 2 ? sub : (sub == 2 ? 9 : sub - 1);
            switch (subop) {
                case 0: { const bf16* Ain = (const bf16*)(P.ws + WS_XH); const float* rsv = (const float*)(P.ws + WS_RS);
                          pg8::Gemm g{Ain, (const bf16*)(P.ws + WS_WIN) + (size_t)l * NIN * D, MP, NIN, D}; pg8::StaticOrder S; S.init(MP, NIN, nb, bid);
                          pg8::EpiIn E{PROJ, (bf16*)(P.ws + WS_QKVB), P.out + O_K_P + (size_t)l * MP * 1024, P.out + O_K_S + (size_t)l * MS * 1024, P.out + O_V_P + (size_t)l * MP * 1024, P.out + O_V_S + (size_t)l * MS * 1024, MP, MT, rsv};
                          pg8::gemm_phase<pg8::EpiIn, pg8::StaticOrder, true, true>(lds, g, S, E, tid_v);
                          if (bid >= 224) { SEpiIn SE{PROJ, (bf16*)(P.ws + WS_QKVB), P.out + O_K_S + (size_t)l * MS * 1024, P.out + O_V_S + (size_t)l * MS * 1024, rsv};
                              gemm_small(Ain + (size_t)MP * D, (const bf16*)(P.ws + WS_WIN) + (size_t)l * NIN * D, NIN, D, bid - 224, 32, tid_v, wave, lane_v, ldsf, SE); } } break;
                case 1: ph_post_in(P, l, bid, nb, tid_v, ldsf); break;
                case 9: ph_chunkpre(P, l, gw, ngw, wave, lane_v, ldsf); break;
                case 2: if (bid < 64) { __builtin_amdgcn_s_setprio(3); ph_cscan2(P, l, bid, wave, lane_v, ldsf, MISC + 20); __builtin_amdgcn_s_setprio(0); }
                        else if (bid >= 128 && wave < 2) ph_scan2(P, l, NB * 64 + (bid - 128), 128, tid_v, wave, lane_v, ldsf, MISC + 16);
                        asm volatile("" : "+v"(lane_v));
                        ph_mix(P, l, bid, nb, wave, lane_v, ldsf);
                        break;
                case 3: ph_post(P, l, gw, ngw, lane_v); break;
                case 4: { pg8::Gemm g{MIXB, (const bf16*)(P.ws + WS_WOUT) + (size_t)l * D * D, MP, D, D}; pg8::StaticOrder S; S.init(MP, D, nb, bid);
                          pg8::EpiBf16T<false> E{Y1B, D}; pg8::gemm_phase<pg8::EpiBf16T<false>, pg8::StaticOrder, true, true>(lds, g, S, E, tid_v);
                          SEpiBf16 SE{Y1B, D}; gemm_small(MIXB + (size_t)MP * D, (const bf16*)(P.ws + WS_WOUT) + (size_t)l * D * D, D, D, bid, nb, tid_v, wave, lane_v, ldsf, SE); } break;
                case 5: ph_norm2(P, l, gw, ngw, lane_v); break;
                case 6: { const bf16* XHc = (const bf16*)(P.ws + WS_XH); const float* rsv = (const float*)(P.ws + WS_RS);
                          pg8::Gemm g{XHc, (const bf16*)(P.ws + WS_W1) + (size_t)l * DFF * D, MP, DFF, D}; pg8::StaticOrder S; S.init(MP, DFF, nb, bid);
                          pg8::EpiBf16T<true> E{UB, DFF, rsv}; pg8::gemm_phase<pg8::EpiBf16T<true>, pg8::StaticOrder, true, true>(lds, g, S, E, tid_v);
                          SEpiRelu2 SE{UB, DFF, rsv}; gemm_small(XHc + (size_t)MP * D, (const bf16*)(P.ws + WS_W1) + (size_t)l * DFF * D, DFF, D, bid, nb, tid_v, wave, lane_v, ldsf, SE); } break;
                case 7: { pg8::Gemm g{UB, (const bf16*)(P.ws + WS_W2) + (size_t)l * D * DFF, MP, D, DFF}; pg8::StaticOrder S; S.init(MP, D, nb, bid);
                          pg8::EpiBf16T<false> E{Y1B, D}; pg8::gemm_phase<pg8::EpiBf16T<false>, pg8::StaticOrder, true, true>(lds, g, S, E, tid_v);
                          gemm_small_kq(UB + (size_t)MP * DFF, (const bf16*)(P.ws + WS_W2) + (size_t)l * D * DFF, DFF, bid, (float*)(P.ws + WS_YS), tid_v, wave, lane_v, ldsf); } break;
                case 8: ph_norm3(P, l, gw, ngw, lane_v); break;
            }
        }
        if (ph + 1 < P.ph_hi) xcd_barrier(bar);
    }
}

extern "C" void kernel_launch(void* const* d_in, const int* in_sizes, int n_in, void* d_out, int out_size, void* d_ws, size_t ws_size, hipStream_t stream) {
    static int grid = 0;
    if (grid == 0) {
        if (n_in != 35 || (size_t)out_size != O_END || ws_size < WS_END) {
            fprintf(stderr, "kernel_launch: unexpected shapes: n_in %d out %d ws %zu (need %zu)\n", n_in, out_size, ws_size, (size_t)WS_END); grid = -1; return; }
        int dev = 0, cus = 0, per_cu = 0;
        if (hipGetDevice(&dev) != hipSuccess || hipDeviceGetAttribute(&cus, hipDeviceAttributeMultiprocessorCount, dev) != hipSuccess) { grid = -1; return; }
        if (hipFuncSetAttribute((const void*)mega_fwd, hipFuncAttributeMaxDynamicSharedMemorySize, LDS_BYTES) != hipSuccess) { fprintf(stderr, "kernel_launch: hipFuncSetAttribute failed\n"); grid = -1; return; }
        if (hipOccupancyMaxActiveBlocksPerMultiprocessor(&per_cu, (const void*)mega_fwd, NWAVES * 64, LDS_BYTES) != hipSuccess || per_cu < 1) { fprintf(stderr, "kernel_launch: occupancy query says %d\n", per_cu); per_cu = 1; }
        (void)hipGetLastError();
        grid = cus;
    }
    if (grid < 0) return;
    (void)hipMemsetAsync((char*)d_ws + WS_CTL, 0, CTL_ZERO_BYTES, stream);
    Params p{};
    for (int i = 0; i < 35; ++i) p.in[i] = (const float*)d_in[i];
    p.out = (float*)d_out; p.ws = (unsigned char*)d_ws;
#if MK_MULTI
    for (int ph = 0; ph < NPHASE; ++ph) { p.ph_lo = ph; p.ph_hi = ph + 1; hipLaunchKernelGGL(mega_fwd, dim3(grid), dim3(NWAVES * 64), LDS_BYTES, stream, p); }
#else
    p.ph_lo = 0; p.ph_hi = NPHASE;
    hipLaunchKernelGGL(mega_fwd, dim3(grid), dim3(NWAVES * 64), LDS_BYTES, stream, p);
#endif
}
```
